# Optimizing an MI355X kernel written in HIP

```python
import jax, jax.numpy as jnp
from jax import lax
import numpy as np

D_MODEL = 2048
BATCH = 32
SEQ = 256
DEPTH = 4
DEC_BATCH = 4
DEC_SEQ = 4096
PAST_LEN = 512

GRID_W = 64
Q_BLOCK = 128
ROPE_THETA = 10000.0
NORM_EPS = 1e-6
N_MOD = 6
ATTN_HEADS = 4
ATTN_KV_HEADS = 2
HEAD_DIM = 128
LRU_WIDTH = 1024
LRU_BLOCKS = 8
LRU_BLOCK_W = LRU_WIDTH // LRU_BLOCKS
LRU_CONV_W = 4
LRU_C = 8.0
LRU_A_MIN = 0.9
LRU_A_MAX = 0.999
MLA_HEADS = 4
MLA_NOPE = 128
MLA_ROPE = 64
MLA_V = 128
MLA_KV_RANK = 512
ATTN_Q_COLS = ATTN_HEADS * HEAD_DIM
ATTN_KV_COLS = ATTN_KV_HEADS * HEAD_DIM
MLA_Q_COLS = MLA_HEADS * (MLA_NOPE + MLA_ROPE)
IN_SIZES = (ATTN_Q_COLS, ATTN_KV_COLS, ATTN_KV_COLS, LRU_WIDTH, LRU_WIDTH, MLA_Q_COLS, MLA_KV_RANK, MLA_ROPE)
D_IN = sum(IN_SIZES)
D_MIX = ATTN_HEADS * HEAD_DIM + LRU_WIDTH + MLA_HEADS * MLA_V
D_FF = 5632
FFN_CONV_W = 3

kernel_name = 'hybrid_gqa_rglru_mla_prefix_diffusion_step'


def rmsnorm(x, g):
    xf = x.astype(jnp.float32)
    xf = xf * lax.rsqrt(jnp.mean(xf * xf, axis=-1, keepdims=True) + NORM_EPS)
    return xf.astype(x.dtype) * g


def _rotate(x, pos):
    quarter = x.shape[-1] // 2
    inv_freq = ROPE_THETA ** (-jnp.arange(quarter, dtype=jnp.float32) / quarter)
    ang = pos.astype(jnp.float32)[:, None] * inv_freq[None, :]
    cos = jnp.cos(ang)[None, :, None, :].astype(x.dtype)
    sin = jnp.sin(ang)[None, :, None, :].astype(x.dtype)
    x1, x2 = x[..., :quarter], x[..., quarter:]
    return jnp.concatenate([x1 * cos - x2 * sin, x2 * cos + x1 * sin], axis=-1)


def axial_rope(x):
    n_tok = x.shape[1]
    rows = n_tok // GRID_W
    row = jnp.repeat(jnp.arange(rows, dtype=jnp.int32), GRID_W)
    col = jnp.tile(jnp.arange(GRID_W, dtype=jnp.int32), rows)
    half = x.shape[-1] // 2
    return jnp.concatenate([_rotate(x[..., :half], row), _rotate(x[..., half:], col)], axis=-1)


def attention(q, k, v):
    bsz, n_q, n_h, d_q = q.shape
    n_kv = k.shape[2]
    grp = n_h // n_kv
    d_v = v.shape[-1]
    scale = d_q ** -0.5
    n_blk = n_q // Q_BLOCK
    qb = q.reshape(bsz, n_blk, Q_BLOCK, n_kv, grp, d_q).transpose(1, 0, 2, 3, 4, 5)

    def one_block(q_blk):
        s = jnp.einsum('bqhgd,bkhd->bhgqk', q_blk, k, preferred_element_type=jnp.float32) * scale
        p = jax.nn.softmax(s, axis=-1).astype(v.dtype)
        return jnp.einsum('bhgqk,bkhd->bqhgd', p, v)

    o = lax.map(one_block, qb)
    return o.transpose(1, 0, 2, 3, 4, 5).reshape(bsz, n_q, n_h, d_v)


def dwconv(x, w, b, left):
    ksz = w.shape[0]
    n = x.shape[1]
    xp = jnp.pad(x, ((0, 0), (left, ksz - 1 - left), (0, 0)))
    y = xp[:, 0:n] * w[0]
    for j in range(1, ksz):
        y = y + xp[:, j:j + n] * w[j]
    return y + b


def _lin_combine(left, right):
    a_l, b_l = left
    a_r, b_r = right
    return a_l * a_r, a_r * b_l + b_r


def rglru(x, w_a, b_a, w_x, b_x, lam, h0, reverse):
    bsz, n, width = x.shape
    xb = x.reshape(bsz, n, LRU_BLOCKS, LRU_BLOCK_W)
    gate_r = jnp.einsum('bsnk,nkj->bsnj', xb, w_a).reshape(bsz, n, width) + b_a
    gate_i = jnp.einsum('bsnk,nkj->bsnj', xb, w_x).reshape(bsz, n, width) + b_x
    r = jax.nn.sigmoid(gate_r.astype(jnp.float32))
    i = jax.nn.sigmoid(gate_i.astype(jnp.float32))
    log_a = LRU_C * r * jax.nn.log_sigmoid(lam.astype(jnp.float32))
    a = jnp.exp(log_a)
    u = jnp.sqrt(-jnp.expm1(2.0 * log_a)) * (i * x.astype(jnp.float32))
    if reverse:
        a = jnp.flip(a, axis=1)
        u = jnp.flip(u, axis=1)
    u = u.at[:, 0].add(a[:, 0] * h0.astype(jnp.float32))
    _, h = lax.associative_scan(_lin_combine, (a, u), axis=1)
    if reverse:
        h = jnp.flip(h, axis=1)
    return h


def mixer(h, p, ctx):
    bsz, n, _ = h.shape
    offsets = np.cumsum(IN_SIZES)[:-1].tolist()
    proj = h @ p['w_in']
    q_a, k_a, v_a, x_r, g_r, q_m, ckv, k_r = jnp.split(proj, offsets, axis=-1)
    q_a = rmsnorm(q_a.reshape(bsz, n, ATTN_HEADS, HEAD_DIM), p['g_q'])
    k_a = rmsnorm(k_a.reshape(bsz, n, ATTN_KV_HEADS, HEAD_DIM), p['g_k'])
    v_a = v_a.reshape(bsz, n, ATTN_KV_HEADS, HEAD_DIM)
    q_m = q_m.reshape(bsz, n, MLA_HEADS, MLA_NOPE + MLA_ROPE)
    ckv = rmsnorm(ckv, p['g_kv'])
    x_r = dwconv(x_r, p['lru_conv_w'], p['lru_conv_b'], 1)
    if ctx is None:
        k_all, v_all, ckv_all, kr_all = k_a, v_a, ckv, k_r
        h0f = jnp.zeros((bsz, LRU_WIDTH), jnp.float32)
        h0b = jnp.zeros((bsz, LRU_WIDTH), jnp.float32)
    else:
        q_a = axial_rope(q_a)
        k_a = axial_rope(k_a)
        q_m = jnp.concatenate([q_m[..., :MLA_NOPE], axial_rope(q_m[..., MLA_NOPE:])], axis=-1)
        k_r = axial_rope(k_r[:, :, None, :])[:, :, 0, :]
        ctx_k, ctx_v, ctx_ckv, ctx_kr, ctx_state = ctx
        k_all = jnp.concatenate([ctx_k, k_a], axis=1)
        v_all = jnp.concatenate([ctx_v, v_a], axis=1)
        ckv_all = jnp.concatenate([ctx_ckv, ckv], axis=1)
        kr_all = jnp.concatenate([ctx_kr, k_r], axis=1)
        h0f = ctx_state[:, 0]
        h0b = ctx_state[:, 1]
    o_a = attention(q_a, k_all, v_all)
    hf = rglru(x_r, p['lru_w_a'][0], p['lru_b_a'][0], p['lru_w_x'][0], p['lru_b_x'][0], p['lru_lambda'][0], h0f, False)
    hb = rglru(x_r, p['lru_w_a'][1], p['lru_b_a'][1], p['lru_w_x'][1], p['lru_b_x'][1], p['lru_lambda'][1], h0b, True)
    y_r = (hf + hb).astype(h.dtype) * jax.nn.gelu(g_r)
    k_nope = jnp.einsum('bsr,rhd->bshd', ckv_all, p['w_uk'])
    v_m = jnp.einsum('bsr,rhd->bshd', ckv_all, p['w_uv'])
    k_m = jnp.concatenate([k_nope, jnp.broadcast_to(kr_all[:, :, None, :], k_nope.shape[:3] + (MLA_ROPE,))], axis=-1)
    o_m = attention(q_m, k_m, v_m)
    out = jnp.concatenate([o_a.reshape(bsz, n, -1), y_r, o_m.reshape(bsz, n, -1)], axis=-1) @ p['w_out']
    if ctx is None:
        final_state = jnp.stack([hf[:, -1], hb[:, 0]], axis=1).astype(h.dtype)
        return out, (k_a, v_a, ckv, k_r, final_state)
    return out, None


def conv_ffn(h, p):
    u = dwconv(h @ p['ffn_w_up'], p['ffn_conv_w'], p['ffn_conv_b'], 1)
    g, v = jnp.split(u, 2, axis=-1)
    return (jax.nn.silu(g) * v) @ p['ffn_w_down']


def layer(x, cond, p, ctx):
    mod = jax.nn.silu(cond) @ p['w_mod'] + p['b_mod']
    if mod.ndim == 2:
        mod = mod[:, None, :]
    sh_m, sc_m, gt_m, sh_f, sc_f, gt_f = jnp.split(mod, N_MOD, axis=-1)
    h = rmsnorm(x, p['g_pre_mix']) * (1.0 + sc_m) + sh_m
    m, st = mixer(h, p, ctx)
    x = x + gt_m * rmsnorm(m, p['g_post_mix'])
    h = rmsnorm(x, p['g_pre_ffn']) * (1.0 + sc_f) + sh_f
    x = x + gt_f * rmsnorm(conv_ffn(h, p), p['g_post_ffn'])
    return x, st


def setup_inputs(seed: int = 0) -> dict:
    key = jax.random.key(seed)
    keys = iter(jax.random.split(key, 48))
    f32 = jnp.float32

    def nrm(shape, scale):
        return scale * jax.random.normal(next(keys), shape, f32)

    def gain(shape):
        return 1.0 + nrm(shape, 0.05)

    a_init = jax.random.uniform(next(keys), (DEPTH, 2, LRU_WIDTH), f32, LRU_A_MIN, LRU_A_MAX)
    s_init = a_init ** (1.0 / LRU_C)
    lru_lambda = jnp.log(s_init) - jnp.log1p(-s_init)
    return {
        'x_prompt': nrm((BATCH, SEQ, D_MODEL), 1.0),
        'x_sample': nrm((DEC_BATCH, DEC_SEQ, D_MODEL), 1.0),
        'cache_attn_k': nrm((DEC_BATCH, DEPTH, PAST_LEN, ATTN_KV_HEADS, HEAD_DIM), 1.0),
        'cache_attn_v': nrm((DEC_BATCH, DEPTH, PAST_LEN, ATTN_KV_HEADS, HEAD_DIM), 1.0),
        'cache_mla_ckv': nrm((DEC_BATCH, DEPTH, PAST_LEN, MLA_KV_RANK), 1.0),
        'cache_mla_krope': nrm((DEC_BATCH, DEPTH, PAST_LEN, MLA_ROPE), 1.0),
        'state_lru': nrm((DEC_BATCH, DEPTH, 2, LRU_WIDTH), 0.5),
        'c': nrm((DEC_BATCH, D_MODEL), 1.0),
        'c_ctx': nrm((D_MODEL,), 1.0),
        'w_mod': nrm((DEPTH, D_MODEL, N_MOD * D_MODEL), 0.5 * D_MODEL ** -0.5),
        'b_mod': nrm((DEPTH, N_MOD * D_MODEL), 0.02),
        'g_pre_mix': gain((DEPTH, D_MODEL)),
        'g_post_mix': gain((DEPTH, D_MODEL)),
        'g_pre_ffn': gain((DEPTH, D_MODEL)),
        'g_post_ffn': gain((DEPTH, D_MODEL)),
        'w_in': nrm((DEPTH, D_MODEL, D_IN), D_MODEL ** -0.5),
        'g_q': gain((DEPTH, HEAD_DIM)),
        'g_k': gain((DEPTH, HEAD_DIM)),
        'lru_conv_w': nrm((DEPTH, LRU_CONV_W, LRU_WIDTH), LRU_CONV_W ** -0.5),
        'lru_conv_b': nrm((DEPTH, LRU_WIDTH), 0.02),
        'lru_w_a': nrm((DEPTH, 2, LRU_BLOCKS, LRU_BLOCK_W, LRU_BLOCK_W), LRU_BLOCK_W ** -0.5),
        'lru_b_a': nrm((DEPTH, 2, LRU_WIDTH), 0.02),
        'lru_w_x': nrm((DEPTH, 2, LRU_BLOCKS, LRU_BLOCK_W, LRU_BLOCK_W), LRU_BLOCK_W ** -0.5),
        'lru_b_x': nrm((DEPTH, 2, LRU_WIDTH), 0.02),
        'lru_lambda': lru_lambda,
        'g_kv': gain((DEPTH, MLA_KV_RANK)),
        'w_uk': nrm((DEPTH, MLA_KV_RANK, MLA_HEADS, MLA_NOPE), MLA_KV_RANK ** -0.5),
        'w_uv': nrm((DEPTH, MLA_KV_RANK, MLA_HEADS, MLA_V), MLA_KV_RANK ** -0.5),
        'w_out': nrm((DEPTH, D_MIX, D_MODEL), D_MIX ** -0.5),
        'ffn_w_up': nrm((DEPTH, D_MODEL, 2 * D_FF), D_MODEL ** -0.5),
        'ffn_conv_w': nrm((DEPTH, FFN_CONV_W, 2 * D_FF), FFN_CONV_W ** -0.5),
        'ffn_conv_b': nrm((DEPTH, 2 * D_FF), 0.02),
        'ffn_w_down': nrm((DEPTH, D_FF, D_MODEL), D_FF ** -0.5),
    }


def reference(x_prompt, x_sample, cache_attn_k, cache_attn_v, cache_mla_ckv, cache_mla_krope, state_lru,
              c, c_ctx, w_mod, b_mod, g_pre_mix, g_post_mix, g_pre_ffn, g_post_ffn, w_in, g_q, g_k,
              lru_conv_w, lru_conv_b, lru_w_a, lru_b_a, lru_w_x, lru_b_x, lru_lambda, g_kv, w_uk, w_uv,
              w_out, ffn_w_up, ffn_conv_w, ffn_conv_b, ffn_w_down):
    def layer_params(l):
        return {
            'w_mod': w_mod[l], 'b_mod': b_mod[l],
            'g_pre_mix': g_pre_mix[l], 'g_post_mix': g_post_mix[l],
            'g_pre_ffn': g_pre_ffn[l], 'g_post_ffn': g_post_ffn[l],
            'w_in': w_in[l], 'g_q': g_q[l], 'g_k': g_k[l],
            'lru_conv_w': lru_conv_w[l], 'lru_conv_b': lru_conv_b[l],
            'lru_w_a': lru_w_a[l], 'lru_b_a': lru_b_a[l],
            'lru_w_x': lru_w_x[l], 'lru_b_x': lru_b_x[l], 'lru_lambda': lru_lambda[l],
            'g_kv': g_kv[l], 'w_uk': w_uk[l], 'w_uv': w_uv[l], 'w_out': w_out[l],
            'ffn_w_up': ffn_w_up[l], 'ffn_conv_w': ffn_conv_w[l], 'ffn_conv_b': ffn_conv_b[l],
            'ffn_w_down': ffn_w_down[l],
        }

    xp = x_prompt
    ks, vs, ckvs, krs, sts = [], [], [], [], []
    for l in range(DEPTH):
        xp, (k_l, v_l, ckv_l, kr_l, st_l) = layer(xp, c_ctx, layer_params(l), None)
        ks.append(k_l)
        vs.append(v_l)
        ckvs.append(ckv_l)
        krs.append(kr_l)
        sts.append(st_l)

    xs = x_sample
    for l in range(DEPTH):
        ctx = (cache_attn_k[:, l], cache_attn_v[:, l], cache_mla_ckv[:, l], cache_mla_krope[:, l], state_lru[:, l])
        xs, _ = layer(xs, c, layer_params(l), ctx)

    new_attn_k = jnp.stack(ks, axis=1)
    new_attn_v = jnp.stack(vs, axis=1)
    new_mla_ckv = jnp.stack(ckvs, axis=1)
    new_mla_krope = jnp.stack(krs, axis=1)
    new_state_lru = jnp.stack(sts, axis=1)
    return (xp, xs, new_attn_k, new_attn_v, new_mla_ckv, new_mla_krope, new_state_lru)
```

```cpp
#include <hip/hip_runtime.h>
#include <cstdio>
#include <cstdint>
#ifndef MK_MULTI
#define MK_MULTI 0
#endif
__device__ __forceinline__ int ltid() { int t = (int)threadIdx.x; asm volatile("" : "+v"(t)); __builtin_assume(t >= 0 && t < 512); return t; }
#undef MK_MULTI
#define MK_MULTI 1
namespace pg8 {
#define PG8_LAS __attribute__((address_space(3)))
typedef unsigned short bf16_t;
typedef short bf16x8 __attribute__((ext_vector_type(8)));
typedef float f32x4 __attribute__((ext_vector_type(4)));
typedef unsigned u32x4 __attribute__((ext_vector_type(4)));
constexpr int BM = 256, BK = 64, HALF = 128, HTB = HALF * BK * 2  , STAGE_BYTES = 8 * HTB, NXCD = 8, WGM = 8;

__host__ __device__ __forceinline__ int lds_byte(int r, int c) { const int st = (r >> 4) * 2 + (c >> 5), rr = r & 15, cc = c & 31, ob = rr * 64 + cc * 2; return st * 1024 + (ob ^ (((ob >> 9) & 1) << 5)); }
__host__ __device__ __forceinline__ void stage_rc(int b, int& R, int& C) { const int st = b / 1024, sb = b % 1024, swz = sb ^ (((sb >> 9) & 1) << 5); R = (st >> 1) * 16 + swz / 64; C = (st & 1) * 32 + (swz % 64) / 2; }
__host__ __device__ __forceinline__ int perm32(int rho) { const int n = rho >> 4, i = rho & 15; return 8 * (i >> 2) + 4 * n + (i & 3); }

struct Unit { int pm, pn; };
struct Gemm { const bf16_t* A; const bf16_t* Bt; int M, N, K; };

struct StaticOrder {
    int nM, nN, nwg, G, c;
    __host__ __device__ void init(int M, int N, int G_, int c_) { nM = M / BM; nN = N / BM; nwg = nM * nN; G = G_; c = c_; }
    __host__ __device__ bool next(int i, Unit& u) const {
        const long L = (long)i * G + c; if (L >= nwg) return false;
        int wgid = (int)L; { const int q = nwg / NXCD, r = nwg % NXCD, xcd = wgid % NXCD, off = wgid / NXCD; wgid = (xcd < r ? xcd * (q + 1) : r * (q + 1) + (xcd - r) * q) + off; }
        const int nig = WGM * nN, gid = wgid / nig, fm = gid * WGM, gsz = (nM - fm) < WGM ? (nM - fm) : WGM;
        u.pm = fm + ((wgid % nig) % gsz); u.pn = (wgid % nig) / gsz; return true;
    }
    __device__ __forceinline__ void a_ready(const Unit&) const {}
    __device__ __forceinline__ void done(const Unit&) const {}
};

__device__ __forceinline__ unsigned cvt_pk_bf16(float lo, float hi) { unsigned r; asm volatile("v_cvt_pk_bf16_f32 %0, %1, %2" : "=v"(r) : "v"(lo), "v"(hi)); return r; }
typedef float f32x2 __attribute__((ext_vector_type(2)));
__device__ __forceinline__ f32x2 gelu_pk(f32x2 v) {
    const f32x2 av = __builtin_elementwise_abs(v), d = av * 0.2316418882f + 1.0f;
    f32x2 t; t.x = __builtin_amdgcn_rcpf(d.x); t.y = __builtin_amdgcn_rcpf(d.y);
    f32x2 q = t * 0.5307027145f + (-0.7265760135f); q = q * t + 0.7107068705f; q = q * t + (-0.142248368f); q = q * t + 0.127414796f; q = q * t;
    const f32x2 s = (v * v) * (-0.72134752044f);
    f32x2 e; e.x = __builtin_amdgcn_exp2f(s.x); e.y = __builtin_amdgcn_exp2f(s.y);
    const f32x2 m = v * (q * e), r = v - m;
    f32x2 o; o.x = v.x < 0.f ? m.x : r.x; o.y = v.y < 0.f ? m.y : r.y; return o;
}

template <int ACT  > struct EpiBf16 {
    static constexpr bool PERM = true, AFTER_DRAIN = false; static_assert(ACT == 0 || ACT == 1, "EpiBf16: ACT is 0 (none) or 1 (gelu_pk)");
    bf16_t* O; int ldc; const float* bias; int split_cols; size_t split_stride; float scale0;
    __device__ __forceinline__ void operator()(const f32x4 (&acc)[2][2][4][2], const Unit& u, int wr, int wc, int fr, int fq) const {
        const int row0 = u.pm * BM + wr * 64 + fr; int colt = u.pn * BM; bf16_t* base = O;
        float sc = 1.f; if (split_cols) { const int t = colt / split_cols; base += (size_t)t * split_stride; colt -= t * split_cols; if (t == 0) sc = scale0; }
        const int col0 = colt + wc * 32 + 8 * fq, bcol0 = u.pn * BM + wc * 32 + 8 * fq;
        f32x4 bv[2][2];
#pragma unroll
        for (int bj = 0; bj < 2; ++bj)
#pragma unroll
            for (int n = 0; n < 2; ++n) bv[bj][n] = bias ? *(const f32x4*)(bias + bcol0 + bj * HALF + 4 * n) : (f32x4){0.f, 0.f, 0.f, 0.f};
#pragma unroll
        for (int ai = 0; ai < 2; ++ai)
#pragma unroll
            for (int m = 0; m < 4; ++m) { bf16_t* rowp = base + (size_t)(row0 + ai * HALF + m * 16) * ldc + col0;
#pragma unroll
                for (int bj = 0; bj < 2; ++bj) { f32x4 v0 = acc[ai][bj][m][0] + bv[bj][0], v1 = acc[ai][bj][m][1] + bv[bj][1];
                    if (ACT == 1) { f32x2 a = gelu_pk((f32x2){v0[0], v0[1]}), b = gelu_pk((f32x2){v0[2], v0[3]}), c = gelu_pk((f32x2){v1[0], v1[1]}), d = gelu_pk((f32x2){v1[2], v1[3]});
                        v0 = (f32x4){a.x, a.y, b.x, b.y}; v1 = (f32x4){c.x, c.y, d.x, d.y}; }
                    v0 = v0 * sc; v1 = v1 * sc; u32x4 w; w.x = cvt_pk_bf16(v0[0], v0[1]); w.y = cvt_pk_bf16(v0[2], v0[3]); w.z = cvt_pk_bf16(v1[0], v1[1]); w.w = cvt_pk_bf16(v1[2], v1[3]);
                    *(u32x4*)(rowp + bj * HALF) = w; } }
    }
};
struct EpiF32 {
    static constexpr bool PERM = false, AFTER_DRAIN = false;
    float* C; int ldc; const float* bias;
    __device__ __forceinline__ void operator()(const f32x4 (&acc)[2][2][4][2], const Unit& u, int wr, int wc, int fr, int fq) const {
        const int row0 = u.pm * BM + wr * 64 + fr, col0 = u.pn * BM + wc * 32 + 4 * fq;
        f32x4 bv[2][2];
#pragma unroll
        for (int bj = 0; bj < 2; ++bj)
#pragma unroll
            for (int n = 0; n < 2; ++n) bv[bj][n] = bias ? *(const f32x4*)(bias + col0 + bj * HALF + n * 16) : (f32x4){0.f, 0.f, 0.f, 0.f};
#pragma unroll
        for (int ai = 0; ai < 2; ++ai)
#pragma unroll
            for (int m = 0; m < 4; ++m) { float* rowp = C + (size_t)(row0 + ai * HALF + m * 16) * ldc + col0;
#pragma unroll
                for (int bj = 0; bj < 2; ++bj)
#pragma unroll
                    for (int n = 0; n < 2; ++n) *(f32x4*)(rowp + bj * HALF + n * 16) = acc[ai][bj][m][n] + bv[bj][n]; }
    }
};
template <class Epi, class Sched, bool ALIGN_EPI = false, bool SP2 = false>
__device__ __forceinline__ void gemm_phase(PG8_LAS unsigned char* lds, const Gemm g, const Sched& S, const Epi& E) {
    const int tid = ltid(), wid = __builtin_amdgcn_readfirstlane(tid >> 6), lane = tid & 63, wr = wid >> 2, wc = wid & 3, fr = lane & 15, fq = lane >> 4;
    const int K = g.K, nt = K / BK;
    unsigned voffA[2], voffB[2];
#pragma unroll
    for (int i = 0; i < 2; ++i) { int R, C; stage_rc(tid * 16 + i * 8192, R, C); const int Rb = Epi::PERM ? ((R & ~31) + perm32(R & 31)) : R;
        voffA[i] = (unsigned)(R * K + C) * 2u; voffB[i] = (unsigned)(Rb * K + C) * 2u; }
    const size_t kstep = (size_t)(BK * 2);
    const size_t hstep = (size_t)HALF * K * 2;
    const size_t tstep = 2 * hstep;
    const unsigned ldsw = (unsigned)wid * 1024u;
    const int aoff = lds_byte(wr * 64 + fr, fq * 8), boff = lds_byte(wc * 32 + fr, fq * 8);
#define PG8_SA(b, h) (((b) * 2 + (h)) * HTB)
#define PG8_SB(b, h) ((4 + (b) * 2 + (h)) * HTB)
#define PG8_STAGE(bufoff, gbase, voff) do { _Pragma("unroll") for (int _i = 0; _i < 2; ++_i) \
        __builtin_amdgcn_global_load_lds((const unsigned*)((const char*)(gbase) + (voff)[_i]), (PG8_LAS unsigned*)(lds + (bufoff) + ldsw + _i * 8192), 16, 0, 0); } while (0)
#define PG8_LDA(dst, b, h) do { _Pragma("unroll") for (int m = 0; m < 4; ++m) _Pragma("unroll") for (int k = 0; k < 2; ++k) dst[m][k] = *(const PG8_LAS bf16x8*)(lds + PG8_SA(b, h) + aoff + m * 2048 + k * 1024); } while (0)
#define PG8_LDB(dst, b, h) do { _Pragma("unroll") for (int n = 0; n < 2; ++n) _Pragma("unroll") for (int k = 0; k < 2; ++k) dst[n][k] = *(const PG8_LAS bf16x8*)(lds + PG8_SB(b, h) + boff + n * 2048 + k * 1024); } while (0)
#define PG8_MMA(ai, bj, At, Bt) do { __builtin_amdgcn_s_setprio(1); _Pragma("unroll") for (int m = 0; m < 4; ++m) _Pragma("unroll") for (int n = 0; n < 2; ++n) _Pragma("unroll") for (int k = 0; k < 2; ++k) \
        acc[ai][bj][m][n] = __builtin_amdgcn_mfma_f32_16x16x32_bf16(Bt[n][k], At[m][k], acc[ai][bj][m][n], 0, 0, 0); __builtin_amdgcn_s_setprio(0); } while (0)
#define PG8_WAIT_V(n) asm volatile("s_waitcnt vmcnt(" #n ")" ::: "memory")
#define PG8_WAIT_L(n) asm volatile("s_waitcnt lgkmcnt(" #n ")" ::: "memory")
#define PG8_BAR __builtin_amdgcn_s_barrier()
#define PG8_SCHED __builtin_amdgcn_sched_barrier(0)
    Unit cur, nxt; int ui = 0;
    if (!S.next(0, cur)) return;
    f32x4 acc[2][2][4][2];
#pragma unroll
    for (int a = 0; a < 2; ++a)
#pragma unroll
        for (int b = 0; b < 2; ++b)
#pragma unroll
            for (int m = 0; m < 4; ++m)
#pragma unroll
                for (int n = 0; n < 2; ++n) acc[a][b][m][n] = (f32x4){0.f, 0.f, 0.f, 0.f};
    bf16x8 At[4][2], B0[2][2], B1[2][2];
    const char* cA = (const char*)g.A + (size_t)cur.pm * tstep; const char* cB = (const char*)g.Bt + (size_t)cur.pn * tstep;
    S.a_ready(cur);
    if constexpr (SP2) {
        PG8_STAGE(PG8_SB(0, 0), cB, voffB); PG8_STAGE(PG8_SB(0, 1), cB + hstep, voffB); PG8_STAGE(PG8_SA(0, 0), cA, voffA); PG8_STAGE(PG8_SA(0, 1), cA + hstep, voffA);
        if (wr == 1) PG8_BAR;
        PG8_WAIT_V(2); PG8_BAR;
        PG8_STAGE(PG8_SB(1, 0), cB + kstep, voffB); PG8_STAGE(PG8_SA(1, 0), cA + kstep, voffA); PG8_STAGE(PG8_SB(1, 1), cB + hstep + kstep, voffB);
        PG8_WAIT_V(6); PG8_BAR;
    } else {
        PG8_STAGE(PG8_SB(0, 0), cB, voffB); PG8_STAGE(PG8_SA(0, 0), cA, voffA); PG8_STAGE(PG8_SB(0, 1), cB + hstep, voffB); PG8_STAGE(PG8_SA(0, 1), cA + hstep, voffA);
        if (wr == 1) PG8_BAR;
        PG8_WAIT_V(4); PG8_BAR;
        PG8_STAGE(PG8_SB(1, 0), cB + kstep, voffB); PG8_STAGE(PG8_SA(1, 0), cA + kstep, voffA); PG8_STAGE(PG8_SB(1, 1), cB + hstep + kstep, voffB);
        PG8_WAIT_V(6); PG8_BAR;
    }
    for (;;) {
        const bool has_next = S.next(ui + 1, nxt);
        const char* nA = has_next ? (const char*)g.A + (size_t)nxt.pm * tstep : cA; const char* nB = has_next ? (const char*)g.Bt + (size_t)nxt.pn * tstep : cB;
        for (int t = 0; t < nt; t += 2) {
            const bool last = (t == nt - 2);
            const char* a1 = cA + (size_t)(t + 1) * kstep;
            const char* a2 = last ? nA : cA + (size_t)(t + 2) * kstep; const char* b2 = last ? nB : cB + (size_t)(t + 2) * kstep;
            const char* a3 = a2 + kstep; const char* b3 = b2 + kstep;
            if (last && has_next) S.a_ready(nxt);
            if constexpr (SP2) {
            PG8_LDB(B0, 0, 0); PG8_LDB(B1, 0, 1); PG8_SCHED; PG8_LDA(At, 0, 0); PG8_STAGE(PG8_SA(1, 1), a1 + hstep, voffA);
            PG8_WAIT_V(8); PG8_WAIT_L(0); PG8_BAR; PG8_MMA(0, 0, At, B0); PG8_MMA(0, 1, At, B1); PG8_BAR; PG8_SCHED;
            PG8_LDA(At, 0, 1); PG8_STAGE(PG8_SB(0, 0), b2, voffB); PG8_STAGE(PG8_SB(0, 1), b2 + hstep, voffB); PG8_STAGE(PG8_SA(0, 0), a2, voffA);
            PG8_WAIT_V(8); PG8_WAIT_L(0); PG8_BAR; PG8_MMA(1, 0, At, B0); PG8_MMA(1, 1, At, B1); PG8_BAR; PG8_SCHED;
            PG8_LDB(B0, 1, 0); PG8_LDB(B1, 1, 1); PG8_SCHED; PG8_LDA(At, 1, 0); PG8_STAGE(PG8_SA(0, 1), a2 + hstep, voffA);
            PG8_WAIT_V(8); PG8_WAIT_L(0); PG8_BAR; PG8_MMA(0, 0, At, B0); PG8_MMA(0, 1, At, B1); PG8_BAR; PG8_SCHED;
            PG8_LDA(At, 1, 1); PG8_STAGE(PG8_SB(1, 0), b3, voffB); PG8_STAGE(PG8_SB(1, 1), b3 + hstep, voffB); PG8_STAGE(PG8_SA(1, 0), a3, voffA);
            PG8_WAIT_V(8); PG8_WAIT_L(0); PG8_BAR; PG8_MMA(1, 0, At, B0); PG8_MMA(1, 1, At, B1); PG8_BAR; PG8_SCHED;
            } else {
            PG8_LDB(B0, 0, 0); PG8_SCHED; PG8_LDA(At, 0, 0); PG8_STAGE(PG8_SA(1, 1), a1 + hstep, voffA);
            PG8_WAIT_L(8); PG8_BAR; PG8_WAIT_L(0); PG8_MMA(0, 0, At, B0); PG8_BAR; PG8_SCHED;
            PG8_LDB(B1, 0, 1); PG8_STAGE(PG8_SB(0, 0), b2, voffB);
            PG8_BAR; PG8_WAIT_L(0); PG8_MMA(0, 1, At, B1); PG8_BAR;
            PG8_LDA(At, 0, 1); PG8_STAGE(PG8_SA(0, 0), a2, voffA);
            PG8_BAR; PG8_WAIT_L(0); PG8_MMA(1, 0, At, B0); PG8_BAR; PG8_SCHED;
            PG8_STAGE(PG8_SB(0, 1), b2 + hstep, voffB);
            PG8_WAIT_V(6); PG8_BAR; PG8_MMA(1, 1, At, B1); PG8_BAR;
            PG8_LDB(B0, 1, 0); PG8_SCHED; PG8_LDA(At, 1, 0); PG8_STAGE(PG8_SA(0, 1), a2 + hstep, voffA);
            PG8_WAIT_L(8); PG8_BAR; PG8_WAIT_L(0); PG8_MMA(0, 0, At, B0); PG8_BAR; PG8_SCHED;
            PG8_LDB(B1, 1, 1); PG8_STAGE(PG8_SB(1, 0), b3, voffB);
            PG8_BAR; PG8_WAIT_L(0); PG8_MMA(0, 1, At, B1); PG8_BAR;
            PG8_LDA(At, 1, 1); PG8_STAGE(PG8_SA(1, 0), a3, voffA);
            PG8_BAR; PG8_WAIT_L(0); PG8_MMA(1, 0, At, B0); PG8_BAR; PG8_SCHED;
            PG8_STAGE(PG8_SB(1, 1), b3 + hstep, voffB);
            PG8_WAIT_V(6); PG8_BAR; PG8_MMA(1, 1, At, B1); PG8_BAR;
            }
        }
        if constexpr (ALIGN_EPI) { if (wr == 0) PG8_BAR; }
        if constexpr (!Epi::AFTER_DRAIN) { E(acc, cur, wr, wc, fr, fq); S.done(cur); }
        if (!has_next) break;
#pragma unroll
        for (int a = 0; a < 2; ++a)
#pragma unroll
            for (int b = 0; b < 2; ++b)
#pragma unroll
                for (int m = 0; m < 4; ++m)
#pragma unroll
                    for (int n = 0; n < 2; ++n) acc[a][b][m][n] = (f32x4){0.f, 0.f, 0.f, 0.f};
        cur = nxt; cA = nA; cB = nB; ++ui;
        if constexpr (ALIGN_EPI) { if (wr == 1) PG8_BAR; }
    }
    PG8_WAIT_V(0);
    if constexpr (!ALIGN_EPI) { if (wr == 0) PG8_BAR; }
    PG8_BAR;
    if constexpr (Epi::AFTER_DRAIN) { E.fused(acc, cur, wr, wc, fr, fq, lds, wid, lane); S.done(cur); }
#undef PG8_SA
#undef PG8_SB
#undef PG8_STAGE
#undef PG8_LDA
#undef PG8_LDB
#undef PG8_MMA
#undef PG8_WAIT_V
#undef PG8_WAIT_L
#undef PG8_BAR
#undef PG8_SCHED
}
}

constexpr int DM = 2048, NB_C = 32, S_C = 256, NB_L = 4, S_L = 4096, PAST = 512, DEPTH = 4;
constexpr int M_C = NB_C * S_C;
constexpr int M_L = NB_L * S_L;
constexpr int MTOK = M_C + M_L;
constexpr int SKV_L = PAST + S_L;
constexpr int MKEY = M_C + NB_L * SKV_L;
constexpr int DIN = 4416, NPROJ = 4608;
constexpr int DFF = 5632, NUP = 2 * DFF;
constexpr int LRU_W = 1024;
constexpr int C_QA = 0, C_KA = 512, C_VA = 768, C_XR = 1024, C_GR = 2048, C_QM = 3072, C_CKV = 3840, C_KR = 4352;
constexpr float NORM_EPS = 1e-6f;
constexpr size_t O_Y = 0, O_K = 50331648, O_V = 58720256, O_CKV = 67108864, O_KR = 83886080, O_ST = 85983232, O_END = 86245376;
enum { I_XP = 0, I_XS, I_CK, I_CV, I_CCKV, I_CKR, I_ST, I_C, I_CCTX, I_WMOD, I_BMOD, I_GPM, I_GPOM, I_GPF, I_GPOF, I_WIN, I_GQ, I_GK, I_LCW, I_LCB, I_LWA, I_LBA, I_LWX, I_LBX, I_LLAM, I_GKV, I_WUK, I_WUV, I_WOUT, I_WUP, I_FCW, I_FCB, I_WDN, N_IN };

constexpr size_t MiB = 1u << 20;
constexpr size_t WS_CTL = 0, CTL_ZERO_BYTES = 2 * MiB;
constexpr size_t WS_MOD = 1 * MiB;
constexpr size_t WS_ROPE = 2 * MiB;
constexpr size_t WS_WIN = 3 * MiB, WS_WOUT = 75 * MiB, WS_WUP = 107 * MiB, WS_WDN = 283 * MiB, WS_WKV = 371 * MiB, WS_WG = 375 * MiB;
constexpr size_t WS_H = 379 * MiB, WS_KAL = 475 * MiB, WS_VAL = 484 * MiB, WS_KAC = 493 * MiB, WS_VAC = 497 * MiB, WS_CKV = 501 * MiB, WS_KR = 527 * MiB;
constexpr size_t WS_R1 = 531 * MiB;
constexpr size_t WS_PROJ = WS_R1, WS_QA = WS_R1 + 216 * MiB, WS_QM = WS_R1 + 240 * MiB, WS_XC = WS_R1 + 276 * MiB, WS_AU = WS_R1 + 324 * MiB, WS_HF = WS_R1 + 708 * MiB,
                 WS_KVM = WS_R1 + 804 * MiB, WS_MIX = WS_R1 + 856 * MiB, WS_SUMM = WS_R1 + 952 * MiB;
constexpr size_t WS_MODP = WS_AU;
constexpr size_t WS_MO = WS_R1;
constexpr size_t WS_U = WS_R1, WS_ACT = WS_R1 + 528 * MiB;
constexpr size_t WS_DBG = WS_R1 + 953 * MiB;
constexpr size_t WS_END = WS_DBG + 8 * MiB;
static_assert(WS_ACT + (size_t)MTOK * DFF * 2 <= WS_DBG && WS_SUMM + MiB <= WS_DBG, "ws map");
constexpr int CW_TMO = 0, CW_CODE = 1, CW_BAR = 4096, CW_CHK = 65536;

constexpr int RING_BYTES = 143360, LDSCTL_OFF = RING_BYTES, MISC_OFF = LDSCTL_OFF + 320, LDS_BYTES = 147456;
static_assert(MISC_OFF + 128 <= LDS_BYTES, "LDS map");
constexpr int NWAVES = 8, NTHREADS = 512;

#define GAS __attribute__((address_space(1)))
#define LAS __attribute__((address_space(3)))
typedef unsigned short bf16;
typedef unsigned v4u __attribute__((ext_vector_type(4)));
typedef float f32x4 __attribute__((ext_vector_type(4)));
typedef short bf16x8 __attribute__((ext_vector_type(8)));
typedef float f32x16 __attribute__((ext_vector_type(16)));
typedef short s16x4 __attribute__((ext_vector_type(4)));
#define LDS_WAIT() asm volatile("s_waitcnt lgkmcnt(0)" ::: "memory")
#define VM_WAIT() asm volatile("s_waitcnt vmcnt(0)" ::: "memory")
__device__ __forceinline__ unsigned f2bf(float f) { unsigned u = __builtin_bit_cast(unsigned, f); return (u + 0x7fffu + ((u >> 16) & 1u)) >> 16; }
__device__ __forceinline__ unsigned pk2(float lo, float hi) { return f2bf(lo) | (f2bf(hi) << 16); }
__device__ __forceinline__ float bf2f(unsigned short b) { return __builtin_bit_cast(float, (unsigned)b << 16); }
__device__ __forceinline__ void ld8bf(const bf16* p, float (&x)[8]) { const v4u w = *(const v4u*)p;
    x[0] = __builtin_bit_cast(float, w.x << 16); x[1] = __builtin_bit_cast(float, w.x & 0xffff0000u); x[2] = __builtin_bit_cast(float, w.y << 16); x[3] = __builtin_bit_cast(float, w.y & 0xffff0000u);
    x[4] = __builtin_bit_cast(float, w.z << 16); x[5] = __builtin_bit_cast(float, w.z & 0xffff0000u); x[6] = __builtin_bit_cast(float, w.w << 16); x[7] = __builtin_bit_cast(float, w.w & 0xffff0000u); }
__device__ __forceinline__ void st8bf(bf16* p, const float (&x)[8]) { v4u w; w.x = pk2(x[0], x[1]); w.y = pk2(x[2], x[3]); w.z = pk2(x[4], x[5]); w.w = pk2(x[6], x[7]); *(v4u*)p = w; }
__device__ __forceinline__ void ld8f(const float* p, float (&x)[8]) { const f32x4 a = *(const f32x4*)p, b = *(const f32x4*)(p + 4); x[0] = a.x; x[1] = a.y; x[2] = a.z; x[3] = a.w; x[4] = b.x; x[5] = b.y; x[6] = b.z; x[7] = b.w; }
__device__ __forceinline__ void st8f(float* p, const float (&x)[8]) { *(f32x4*)p = (f32x4){x[0], x[1], x[2], x[3]}; *(f32x4*)(p + 4) = (f32x4){x[4], x[5], x[6], x[7]}; }
__device__ __forceinline__ float wave_sum(float v) {
#pragma unroll
    for (int o = 1; o < 64; o <<= 1) v += __shfl_xor(v, o);
    return v;
}
__device__ __forceinline__ float sigmoidf_(float x) { return __builtin_amdgcn_rcpf(1.0f + __expf(-x)); }
__device__ __forceinline__ float siluf_(float x) { return x * sigmoidf_(x); }
__device__ __forceinline__ float gelu_tanh(float x) { const float z = 0.7978845608028654f * (x + 0.044715f * x * x * x); const float t = 1.0f - 2.0f * __builtin_amdgcn_rcpf(__expf(2.0f * z) + 1.0f); return 0.5f * x * (1.0f + t); }

#define XB_TMO      128
#define XB_XCNT(j)  (256  + 64 * (j))
#define XB_XSUB(j)  (1280 + 64 * (j))
#define XB_XGEN(j)  (2304 + 64 * (j))
#define XB_TOP      3328
#define XB_TOPGEN   3392
#define XCD_BAR_WORDS 3456
#define XB_SPIN_CAP (1u << 18)

__device__ __forceinline__ unsigned xb_ld(unsigned* p)              { return __hip_atomic_load(p, __ATOMIC_RELAXED, __HIP_MEMORY_SCOPE_AGENT); }
__device__ __forceinline__ unsigned xb_add(unsigned* p, unsigned v) { return __hip_atomic_fetch_add(p, v, __ATOMIC_RELAXED, __HIP_MEMORY_SCOPE_AGENT); }
__device__ __forceinline__ unsigned xb_xcc_id() { return (unsigned)__builtin_amdgcn_s_getreg((3 << 11) | 20) & 0xFu; }
#define XB_SPIN(cond, bar) do { unsigned _sp = 0; while (cond) { __builtin_amdgcn_s_sleep(1); \
    if ((++_sp & 255u) == 0u) { if (xb_ld(&(bar)[XB_TMO])) break; if (_sp > XB_SPIN_CAP) { atomicAdd(&(bar)[XB_TMO], 1u); break; } } } } while (0)

struct XcdBarrier {
    unsigned* bar; unsigned x;
    volatile LAS unsigned* st;
};

__device__ __forceinline__ XcdBarrier xcd_barrier_post(unsigned* bar, volatile LAS unsigned* st) {
    XcdBarrier b; b.bar = bar; b.x = xb_xcc_id(); b.st = st;
    if (threadIdx.x == 0) (void)xb_add(&bar[XB_XCNT(b.x)], 1u);
    return b;
}
__device__ __forceinline__ void xcd_barrier_complete(unsigned* bar, unsigned x, unsigned& nloc, unsigned& nx) {
    const unsigned G = gridDim.x * gridDim.y * gridDim.z;
    unsigned sum, cnt, mine, sp = 0u;
    for (;;) {
        sum = 0u; cnt = 0u; mine = 0u;
#pragma unroll
        for (unsigned j = 0; j < 16; ++j) { const unsigned c = xb_ld(&bar[XB_XCNT(j)]); sum += c; cnt += (c > 0u) ? 1u : 0u; mine = (j == x) ? c : mine; }
        if (sum == G) break;
        __builtin_amdgcn_s_sleep(1);
        if ((++sp & 255u) == 0u) { if (xb_ld(&bar[XB_TMO])) break; if (sp > XB_SPIN_CAP) { atomicAdd(&bar[XB_TMO], 1u); break; } }
    }
    nloc = mine > 0u ? mine : 1u; nx = cnt > 0u ? cnt : 1u;
}

__device__ __forceinline__ void xcd_barrier(const XcdBarrier& b) {
    asm volatile("s_waitcnt vmcnt(0)" ::: "memory");
    __syncthreads();
    if (threadIdx.x == 0) {
        unsigned* bar = b.bar;
        __builtin_amdgcn_s_waitcnt(0);
        unsigned nloc = b.st[0], nx = b.st[1];
        if (nloc == 0u) { xcd_barrier_complete(bar, b.x, nloc, nx); b.st[0] = nloc; b.st[1] = nx; }
        const unsigned old = xb_add(&bar[XB_XSUB(b.x)], 1u);
        const unsigned gen = old / nloc;
        if (old + 1u == (gen + 1u) * nloc) {
            __builtin_amdgcn_fence(__ATOMIC_RELEASE, "agent");
            asm volatile("s_waitcnt vmcnt(0)" ::: "memory");
            const unsigned og = xb_add(&bar[XB_TOP], 1u);
            const unsigned tg = og / nx;
            if (og + 1u == (tg + 1u) * nx) xb_add(&bar[XB_TOPGEN], 1u);
            else XB_SPIN(xb_ld(&bar[XB_TOPGEN]) == tg, bar);
            __builtin_amdgcn_fence(__ATOMIC_ACQUIRE, "agent");
            xb_add(&bar[XB_XGEN(b.x)], 1u);
            asm volatile("s_waitcnt vmcnt(0)" ::: "memory");
        } else {
            XB_SPIN(xb_ld(&bar[XB_XGEN(b.x)]) == gen, bar);
            __builtin_amdgcn_fence(__ATOMIC_ACQUIRE, "agent");
            asm volatile("s_waitcnt vmcnt(0)" ::: "memory");
        }
    }
    __syncthreads();
}

namespace att {
typedef __attribute__((ext_vector_type(4))) unsigned u32x4;
constexpr int NW = 8, QBLK = 32, KVBLK = 64;
constexpr int SHM_V = KVBLK * 128 * 2, SHM_K = KVBLK * 128 * 2, SHM_KR = KVBLK * 64 * 2;
constexpr int OFF_V = 0, OFF_K = 2 * SHM_V, OFF_KR = OFF_K + 2 * SHM_K, OFF_WS = OFF_KR + 2 * SHM_KR, OFF_QR = OFF_WS + NW * 64 * 4;
template <int QL> constexpr int lds_attn() { return OFF_QR + NW * QL * 1024; }
#define KSWZ(row, colB) ((row) * 256 + ((colB) ^ (((row) & 7) << 4)))
#define KRSWZ(row, colB) ((row) * 128 + ((colB) ^ (((row) & 7) << 4)))
#define SBAR() __builtin_amdgcn_sched_barrier(0)
constexpr float THR = 8.f;
__device__ __forceinline__ int crow(int r, int hi) { return (r & 3) + 8 * (r >> 2) + 4 * hi; }
__device__ __forceinline__ unsigned cvtpk(float lo, float hi) { unsigned r; asm volatile("v_cvt_pk_bf16_f32 %0, %1, %2" : "=v"(r) : "v"(lo), "v"(hi)); return r; }

template <int DQK> __device__ __forceinline__ void partialSM(f32x16& p0, f32x16& p1, float& m_reg, float& mn, float& alpha) {
  constexpr float SCALE = (DQK == 128) ? 0.088388347648318440f : 0.072168783648703220f;
  constexpr float C = SCALE * 1.4426950408889634f;
  float pmax = p0[0];
#pragma unroll
  for (int r = 1; r < 16; ++r) pmax = fmaxf(pmax, p0[r]);
#pragma unroll
  for (int r = 0; r < 16; ++r) pmax = fmaxf(pmax, p1[r]);
  { auto rr = __builtin_amdgcn_permlane32_swap(__float_as_uint(pmax), __float_as_uint(pmax), false, false);
    pmax = fmaxf(__uint_as_float(rr[0]), __uint_as_float(rr[1])); }
  if (__builtin_expect(__all(pmax - m_reg <= THR / SCALE), 1)) { mn = m_reg; alpha = 1.f; }
  else { mn = fmaxf(m_reg, pmax); alpha = __builtin_amdgcn_exp2f((m_reg - mn) * C); m_reg = mn; }
  float mnC = -mn * C;
#pragma unroll
  for (int r = 0; r < 16; ++r) p0[r] = fmaf(p0[r], C, mnC);
#pragma unroll
  for (int r = 0; r < 16; ++r) p1[r] = fmaf(p1[r], C, mnC);
#pragma unroll
  for (int r = 0; r < 16; ++r) p0[r] = __builtin_amdgcn_exp2f(p0[r]);
}
__device__ __forceinline__ void finishSM(f32x16& p0, f32x16& p1, float alpha, float& l_reg, bf16x8& pa0, bf16x8& pa1, bf16x8& pa2, bf16x8& pa3) {
#pragma unroll
  for (int r = 0; r < 16; ++r) p1[r] = __builtin_amdgcn_exp2f(p1[r]);
  float ps = 0;
#pragma unroll
  for (int r = 0; r < 16; ++r) ps += p0[r];
#pragma unroll
  for (int r = 0; r < 16; ++r) ps += p1[r];
  { auto rr = __builtin_amdgcn_permlane32_swap(__float_as_uint(ps), __float_as_uint(ps), false, false);
    ps = __uint_as_float(rr[0]) + __uint_as_float(rr[1]); }
  l_reg = l_reg * alpha + ps;
#define PK4(P, BASE, OUT) do { unsigned a0 = cvtpk(P[BASE + 0], P[BASE + 1]), a1 = cvtpk(P[BASE + 2], P[BASE + 3]);   \
    unsigned b0 = cvtpk(P[BASE + 4], P[BASE + 5]), b1 = cvtpk(P[BASE + 6], P[BASE + 7]);                              \
    auto r0 = __builtin_amdgcn_permlane32_swap(a0, b0, false, false); auto r1 = __builtin_amdgcn_permlane32_swap(a1, b1, false, false); \
    u32x4 w = {r0[0], r1[0], r0[1], r1[1]}; OUT = *reinterpret_cast<bf16x8*>(&w); } while (0)
  PK4(p0, 0, pa0); PK4(p0, 8, pa1); PK4(p1, 0, pa2); PK4(p1, 8, pa3);
#undef PK4
}
template <int DR, int NQR> __device__ __forceinline__ void qkt(f32x16& p0, f32x16& p1, const char* Ks, const char* KRs, const bf16x8* qr, const char* qrl, int r32, int hi) {
  p0 = f32x16{}; p1 = f32x16{};
#pragma unroll
  for (int d0 = 0; d0 < 8; ++d0) { int cb = (d0 * 16 + hi * 8) * 2;
    bf16x8 b0 = *reinterpret_cast<const bf16x8*>(Ks + KSWZ(r32, cb));
    bf16x8 b1 = *reinterpret_cast<const bf16x8*>(Ks + KSWZ(32 + r32, cb));
    bf16x8 qf; if constexpr (true) { if (d0 < NQR) qf = qr[d0]; else qf = *reinterpret_cast<const bf16x8*>(qrl + (d0 - NQR) * 1024); }
    p0 = __builtin_amdgcn_mfma_f32_32x32x16_bf16(b0, qf, p0, 0, 0, 0);
    p1 = __builtin_amdgcn_mfma_f32_32x32x16_bf16(b1, qf, p1, 0, 0, 0); }
  if constexpr (DR > 0) {
#pragma unroll
    for (int d0 = 0; d0 < DR / 16; ++d0) { int cb = (d0 * 16 + hi * 8) * 2;
      bf16x8 b0 = *reinterpret_cast<const bf16x8*>(KRs + KRSWZ(r32, cb));
      bf16x8 b1 = *reinterpret_cast<const bf16x8*>(KRs + KRSWZ(32 + r32, cb));
      const bf16x8 qf = *reinterpret_cast<const bf16x8*>(qrl + (8 - NQR + d0) * 1024);
      p0 = __builtin_amdgcn_mfma_f32_32x32x16_bf16(b0, qf, p0, 0, 0, 0);
      p1 = __builtin_amdgcn_mfma_f32_32x32x16_bf16(b1, qf, p1, 0, 0, 0); }
  }
}
__device__ __forceinline__ int v_st(int k, int c) { const int kk = (k & ~0xC) | ((k & 4) << 1) | ((k & 8) >> 1); return ((kk >> 3) * 4 + (c >> 5)) * 512 + ((kk & 7) * 32 + (c & 31)) * 2; }
__device__ __forceinline__ int v_rd_base(int lane) { return ((lane & 3) << 3) | (((lane >> 2) & 3) << 6) | (((lane >> 4) & 1) << 5) | (((lane >> 5) & 1) << 8); }
constexpr int v_rd_off(int d0, int ks, int half) { return d0 * 512 + ks * 4096 + half * 2048; }
template <int OFF> __device__ __forceinline__ s16x4 tr_read(int vb) {
  s16x4 r; asm volatile("ds_read_b64_tr_b16 %0, %1 offset:%2" : "=&v"(r) : "v"(vb), "i"(OFF) : "memory"); return r;
}
template <int D0> __device__ __forceinline__ void pv_one(f32x16& od, int vb, bf16x8 pa0, bf16x8 pa1, bf16x8 pa2, bf16x8 pa3) {
  const s16x4 l0 = tr_read<v_rd_off(D0, 0, 0)>(vb), h0 = tr_read<v_rd_off(D0, 0, 1)>(vb), l1 = tr_read<v_rd_off(D0, 1, 0)>(vb), h1 = tr_read<v_rd_off(D0, 1, 1)>(vb);
  const s16x4 l2 = tr_read<v_rd_off(D0, 2, 0)>(vb), h2 = tr_read<v_rd_off(D0, 2, 1)>(vb), l3 = tr_read<v_rd_off(D0, 3, 0)>(vb), h3 = tr_read<v_rd_off(D0, 3, 1)>(vb);
  asm volatile("s_waitcnt lgkmcnt(0)" ::: "memory"); SBAR();
#define PK(L, H) (bf16x8){L[0], L[1], L[2], L[3], H[0], H[1], H[2], H[3]}
  od = __builtin_amdgcn_mfma_f32_32x32x16_bf16(pa0, PK(l0, h0), od, 0, 0, 0);
  od = __builtin_amdgcn_mfma_f32_32x32x16_bf16(pa1, PK(l1, h1), od, 0, 0, 0);
  od = __builtin_amdgcn_mfma_f32_32x32x16_bf16(pa2, PK(l2, h2), od, 0, 0, 0);
  od = __builtin_amdgcn_mfma_f32_32x32x16_bf16(pa3, PK(l3, h3), od, 0, 0, 0);
#undef PK
}
__device__ __forceinline__ void pv_d0(f32x16* o, int vb, bf16x8 pa0, bf16x8 pa1, bf16x8 pa2, bf16x8 pa3) {
  pv_one<0>(o[0], vb, pa0, pa1, pa2, pa3); pv_one<1>(o[1], vb, pa0, pa1, pa2, pa3); pv_one<2>(o[2], vb, pa0, pa1, pa2, pa3); pv_one<3>(o[3], vb, pa0, pa1, pa2, pa3);
}

template <int DR, int SD, int NQR, int LDQ, int LDK, int LDKR, int LDV, int LDO>
__device__ __forceinline__ void attn_body(const bf16* __restrict__ Qb, const bf16* __restrict__ Kh, const bf16* __restrict__ KRh, const bf16* __restrict__ Vh,
                                          bf16* __restrict__ Ob, int seq, char* lds) {
  constexpr int DQK = 128 + DR, NQ = NQR, QL = (8 - NQR) + DR / 16;
  static_assert(lds_attn<QL>() <= RING_BYTES, "attention LDS");
  const int tid = ltid(), wid = tid >> 6, lane = tid & 63, r32 = lane & 31, hi = lane >> 5;
  char* V_lds = lds + OFF_V; char* K_lds = lds + OFF_K; char* KR_lds = lds + OFF_KR;
  float* ws = (float*)(lds + OFF_WS) + wid * 64; float* li_l = ws; float* al_l = ws + 32;
  float m_reg = -1e30f, l_reg = 0; f32x16 o[4] = {}; bf16x8 qr[NQ];
  const bf16* Qw = Qb + (long)(wid * QBLK + r32) * LDQ + hi * 8;
#pragma unroll
  for (int d0 = 0; d0 < NQ; ++d0) qr[d0] = *reinterpret_cast<const bf16x8*>(Qw + d0 * 16);
  char* qrl = lds + OFF_QR + wid * (QL * 1024) + lane * 16;
#pragma unroll
  for (int d0 = 0; d0 < QL; ++d0) *reinterpret_cast<bf16x8*>(qrl + d0 * 1024) = *reinterpret_cast<const bf16x8*>(Qw + (NQR + d0) * 16);
  const int sr = tid >> 4, sc = (tid & 15) * 8, vst0 = v_st(sr, sc), vst1 = v_st(32 + sr, sc);
  const int rr = tid >> 3, rc = (tid & 7) * 8;
  const int vb0 = (int)(uintptr_t)V_lds + v_rd_base(lane);
  struct { bf16x8 vs0, vs1, ks0, ks1, kr; } sr_[SD];
#define SLOAD(i, k0) do { sr_[i].vs0 = *reinterpret_cast<const bf16x8*>(&Vh[(long)((k0) + sr) * LDV + sc]); sr_[i].vs1 = *reinterpret_cast<const bf16x8*>(&Vh[(long)((k0) + 32 + sr) * LDV + sc]); \
    sr_[i].ks0 = *reinterpret_cast<const bf16x8*>(&Kh[(long)((k0) + sr) * LDK + sc]); sr_[i].ks1 = *reinterpret_cast<const bf16x8*>(&Kh[(long)((k0) + 32 + sr) * LDK + sc]); \
    if constexpr (DR > 0) sr_[i].kr = *reinterpret_cast<const bf16x8*>(&KRh[(long)((k0) + rr) * LDKR + rc]); } while (0)
#define SWRITE(b, i) do { *(bf16x8*)(V_lds + (b) * SHM_V + vst0) = sr_[i].vs0;          \
    *(bf16x8*)(V_lds + (b) * SHM_V + vst1) = sr_[i].vs1; int kc = sc * 2;               \
    *(bf16x8*)(K_lds + (b) * SHM_K + KSWZ(sr, kc)) = sr_[i].ks0;                       \
    *(bf16x8*)(K_lds + (b) * SHM_K + KSWZ(32 + sr, kc)) = sr_[i].ks1;                  \
    if constexpr (DR > 0) *(bf16x8*)(KR_lds + (b) * SHM_KR + KRSWZ(rr, rc * 2)) = sr_[i].kr; } while (0)
#define SWAIT() do { if constexpr (SD == 1) asm volatile("s_waitcnt vmcnt(0)" ::: "memory"); else if constexpr (DR > 0) asm volatile("s_waitcnt vmcnt(5)" ::: "memory"); else asm volatile("s_waitcnt vmcnt(4)" ::: "memory"); } while (0)
#define RESC(a) do { if (__any((a) < 1.f)) { if (hi == 0) al_l[r32] = (a); asm volatile("s_waitcnt lgkmcnt(0)" ::: "memory"); \
    _Pragma("unroll") for (int d = 0; d < 4; ++d) _Pragma("unroll") for (int r = 0; r < 16; ++r) o[d][r] *= al_l[crow(r, hi)]; } } while (0)
  f32x16 pA0, pA1, pB0, pB1; float mnA, mnB, alA, alB; bf16x8 pa0, pa1, pa2, pa3; const int NT = seq / KVBLK;
  constexpr int SE = 0, SO = SD - 1;
  SLOAD(SE, 0); asm volatile("s_waitcnt vmcnt(0)" ::: "memory"); SWRITE(0, SE); __syncthreads();
  qkt<DR, NQR>(pA0, pA1, K_lds, KR_lds, qr, qrl, r32, hi); partialSM<DQK>(pA0, pA1, m_reg, mnA, alA);
  SLOAD(SO, KVBLK); if constexpr (SD == 2) { if (2 < NT) SLOAD(SE, 2 * KVBLK); }
  SWAIT(); SWRITE(1, SO); __syncthreads();
  for (int j = 1; j + 1 < NT; j += 2) {
    SBAR(); qkt<DR, NQR>(pB0, pB1, K_lds + SHM_K, KR_lds + SHM_KR, qr, qrl, r32, hi);
    finishSM(pA0, pA1, alA, l_reg, pa0, pa1, pa2, pa3); SBAR();
    SLOAD(SO, (j + SD) * KVBLK); SBAR();
    pv_d0(o, vb0, pa0, pa1, pa2, pa3); partialSM<DQK>(pB0, pB1, m_reg, mnB, alB);
    __syncthreads(); SWAIT(); SWRITE(0, SE);
    RESC(alB); __syncthreads();
    SBAR(); qkt<DR, NQR>(pA0, pA1, K_lds, KR_lds, qr, qrl, r32, hi);
    finishSM(pB0, pB1, alB, l_reg, pa0, pa1, pa2, pa3); SBAR();
    if (SD == 1 || j + 3 < NT) SLOAD(SE, (j + 1 + SD) * KVBLK); SBAR();
    pv_d0(o, vb0 + (int)SHM_V, pa0, pa1, pa2, pa3); partialSM<DQK>(pA0, pA1, m_reg, mnA, alA);
    __syncthreads(); SWAIT(); SWRITE(1, SO);
    RESC(alA); __syncthreads();
  }
  SBAR(); qkt<DR, NQR>(pB0, pB1, K_lds + SHM_K, KR_lds + SHM_KR, qr, qrl, r32, hi);
  finishSM(pA0, pA1, alA, l_reg, pa0, pa1, pa2, pa3); SBAR();
  pv_d0(o, vb0, pa0, pa1, pa2, pa3); partialSM<DQK>(pB0, pB1, m_reg, mnB, alB);
  __syncthreads(); RESC(alB);
  finishSM(pB0, pB1, alB, l_reg, pa0, pa1, pa2, pa3); SBAR();
  pv_d0(o, vb0 + (int)SHM_V, pa0, pa1, pa2, pa3);
  if (hi == 0) li_l[r32] = l_reg; asm volatile("s_waitcnt lgkmcnt(0)" ::: "memory");
  float rli[16];
#pragma unroll
  for (int r = 0; r < 16; ++r) rli[r] = __builtin_amdgcn_rcpf(li_l[crow(r, hi)]);
  bf16* Ow = Ob + (long)(wid * QBLK) * LDO;
#pragma unroll
  for (int r = 0; r < 16; ++r) { int orow = crow(r, hi);
#pragma unroll
    for (int d0 = 0; d0 < 4; ++d0) Ow[(long)orow * LDO + d0 * 32 + r32] = (bf16)f2bf(o[d0][r] * rli[r]); }
  __syncthreads();
#undef SLOAD
#undef SWRITE
#undef SWAIT
#undef RESC
}
}
#ifndef MLA_NQR
#define MLA_NQR 6
#endif
#ifndef MLA_SD
#define MLA_SD 1
#endif

struct Args { const float* in[N_IN]; float* out; unsigned char* ws; int ph_lo, ph_hi; };
constexpr int PH_PER_LAYER = 11, PH_PRE = 3, PH_TOTAL = PH_PRE + DEPTH * PH_PER_LAYER;
typedef const __attribute__((address_space(4))) Args* KArgs;
__device__ __forceinline__ KArgs launder(KArgs p) { asm volatile("" : "+s"(p)); return p; }

__device__ __forceinline__ void transpose_item(const float* W, int K, int N, bf16* WT, LAS float* scr, int item, int lane) {
    const int nblk = N / 32, kb = item / nblk, nb = item % nblk, k0 = 64 * kb, n0 = 32 * nb;
#pragma unroll 8
    for (int i = 0; i < 32; ++i) { const int kk = 2 * i + (lane >> 5); scr[kk * 33 + (lane & 31)] = W[(size_t)(k0 + kk) * N + n0 + (lane & 31)]; }
    LDS_WAIT(); asm volatile("" ::: "memory");
    const int c = lane & 7;
#pragma unroll
    for (int j = 0; j < 4; ++j) { const int n = (lane >> 3) + 8 * j; const LAS float* s = scr + (8 * c) * 33 + n;
        v4u o; o.x = pk2(s[0 * 33], s[1 * 33]); o.y = pk2(s[2 * 33], s[3 * 33]); o.z = pk2(s[4 * 33], s[5 * 33]); o.w = pk2(s[6 * 33], s[7 * 33]);
        *(v4u*)(WT + (size_t)(n0 + n) * K + k0 + 8 * c) = o; }
    LDS_WAIT(); asm volatile("" ::: "memory");
}

__device__ __forceinline__ void phase_prologue(KArgs a, char* lds, int gw, int NGW, int wave, int lane) {
    unsigned char* ws = a->ws;
    LAS float* scr = (LAS float*)(lds + wave * 16384);
    constexpr int I_IN = 32 * 138, I_OUT = 32 * 64, I_UP = 32 * 352, I_DN = 88 * 64, I_KV = 2 * 128, I_G = 256;
    constexpr int I_LAYER = I_IN + I_OUT + I_UP + I_DN + I_KV + I_G;
    for (int it = gw; it < DEPTH * I_LAYER; it += NGW) {
        const int l = it / I_LAYER; int r = it % I_LAYER;
        if (r < I_IN) { transpose_item(a->in[I_WIN] + (size_t)l * DM * DIN, DM, DIN, (bf16*)(ws + WS_WIN) + (size_t)l * NPROJ * DM, scr, r, lane); continue; } r -= I_IN;
        if (r < I_OUT) { transpose_item(a->in[I_WOUT] + (size_t)l * DM * DM, DM, DM, (bf16*)(ws + WS_WOUT) + (size_t)l * DM * DM, scr, r, lane); continue; } r -= I_OUT;
        if (r < I_UP) { transpose_item(a->in[I_WUP] + (size_t)l * DM * NUP, DM, NUP, (bf16*)(ws + WS_WUP) + (size_t)l * NUP * DM, scr, r, lane); continue; } r -= I_UP;
        if (r < I_DN) { transpose_item(a->in[I_WDN] + (size_t)l * DFF * DM, DFF, DM, (bf16*)(ws + WS_WDN) + (size_t)l * DM * DFF, scr, r, lane); continue; } r -= I_DN;
        if (r < I_KV) { const int which = r / 128;
            transpose_item(a->in[which ? I_WUV : I_WUK] + (size_t)l * 512 * 512, 512, 512, (bf16*)(ws + WS_WKV) + (size_t)l * 1024 * 512 + (size_t)which * 512 * 512, scr, r % 128, lane); continue; } r -= I_KV;
        { const int mat = r / 8, sub = r % 8;
          const int ty = mat & 1, dir = (mat >> 1) & 1, n = mat >> 2;
          const float* src = a->in[ty ? I_LWX : I_LWA] + ((size_t)((l * 2 + dir) * 8 + n)) * 128 * 128;
          transpose_item(src, 128, 128, (bf16*)(ws + WS_WG) + (size_t)l * 32 * 16384 + (size_t)mat * 16384, scr, sub, lane); }
    }
    { const int gt = gw * 64 + lane, NT = NGW * 64; constexpr int PER = (NPROJ - DIN) * DM / 8;
      for (int i = gt; i < DEPTH * PER; i += NT) { const int l = i / PER, j = i % PER; *((v4u*)((bf16*)(ws + WS_WIN) + (size_t)l * NPROJ * DM + (size_t)DIN * DM) + j) = (v4u){0u, 0u, 0u, 0u}; } }
    { float* MODP = (float*)(ws + WS_MODP);
      for (int it = gw; it < DEPTH * 32 * 48; it += NGW) {
        const int l = it / (32 * 48), kc = (it / 48) % 32, jb = it % 48, j = jb * 256 + 4 * lane, k = kc * 64 + lane;
        float cv[5];
#pragma unroll
        for (int cr = 0; cr < 4; ++cr) cv[cr] = siluf_(a->in[I_C][cr * DM + k]);
        cv[4] = siluf_(a->in[I_CCTX][k]);
        f32x4 acc[5];
#pragma unroll
        for (int cr = 0; cr < 5; ++cr) acc[cr] = (f32x4){0.f, 0.f, 0.f, 0.f};
        const float* wp = a->in[I_WMOD] + ((size_t)l * DM + (size_t)kc * 64) * 12288 + j;
#pragma unroll 4
        for (int kk = 0; kk < 64; ++kk) { const f32x4 w = *(const f32x4*)(wp + (size_t)kk * 12288);
#pragma unroll
            for (int cr = 0; cr < 5; ++cr) { const float s = __shfl(cv[cr], kk); acc[cr] += w * s; } }
        if (kc == 0) { const f32x4 b = *(const f32x4*)(a->in[I_BMOD] + (size_t)l * 12288 + j);
#pragma unroll
            for (int cr = 0; cr < 5; ++cr) acc[cr] += b; }
#pragma unroll
        for (int cr = 0; cr < 5; ++cr) *(f32x4*)(MODP + (((size_t)(l * 32 + kc) * 5 + cr)) * 12288 + j) = acc[cr];
      } }
    { const int gt = gw * 64 + lane;
      if (gt < 64 * 32 + 64 * 16) { const bool big = gt < 2048; const int e = big ? gt : gt - 2048, nf = big ? 32 : 16, pos = e / nf, f = e % nf;
        const float inv = exp2f(-(float)f / (float)nf * 13.287712379549449f);
        const float ang = (float)pos * inv;
        double rev = (double)ang * 0.15915494309189535; rev -= floor(rev);
        const float rf = (float)rev; const float sn = __builtin_amdgcn_sinf(rf), cs = __builtin_amdgcn_cosf(rf);
        float2* tab = (float2*)(ws + WS_ROPE + (big ? 0 : 32768)); tab[e] = make_float2(cs, sn); } }
}

__device__ __forceinline__ void phase_mod_reduce(KArgs a, int gtid, int NTHR) {
    const float* MODP = (const float*)(a->ws + WS_MODP); float* MOD = (float*)(a->ws + WS_MOD);
    for (int i = gtid; i < DEPTH * 5 * 12288 / 4; i += NTHR) { const int l = i / (5 * 3072), rem = i % (5 * 3072);
        f32x4 s = (f32x4){0.f, 0.f, 0.f, 0.f};
#pragma unroll 8
        for (int kc = 0; kc < 32; ++kc) s += *((const f32x4*)(MODP + ((size_t)(l * 32 + kc) * 5) * 12288) + rem);
        *((f32x4*)(MOD + (size_t)l * 5 * 12288) + rem) = s; }
}

__device__ __forceinline__ void row_update(const float* xsrc, const float* msrc, float* xdst, const float* g_post, const float* gate,
                                           const float* g_pre, const float* sc, const float* sh, bf16* hdst, int lane) {
    f32x4 x[8];
#pragma unroll
    for (int j = 0; j < 8; ++j) x[j] = *((const f32x4*)xsrc + lane + 64 * j);
    if (msrc) {
        f32x4 m[8]; float ss = 0.f;
#pragma unroll
        for (int j = 0; j < 8; ++j) { m[j] = *((const f32x4*)msrc + lane + 64 * j); ss += (m[j].x * m[j].x + m[j].y * m[j].y) + (m[j].z * m[j].z + m[j].w * m[j].w); }
        const float rs = rsqrtf(wave_sum(ss) * (1.0f / DM) + NORM_EPS);
#pragma unroll
        for (int j = 0; j < 8; ++j) { const f32x4 g = *((const f32x4*)g_post + lane + 64 * j), gt = *((const f32x4*)gate + lane + 64 * j); x[j] = x[j] + gt * (m[j] * rs * g); }
    }
    if (xdst) {
#pragma unroll
        for (int j = 0; j < 8; ++j) *((f32x4*)xdst + lane + 64 * j) = x[j];
    }
    if (hdst) {
        float ss = 0.f;
#pragma unroll
        for (int j = 0; j < 8; ++j) ss += (x[j].x * x[j].x + x[j].y * x[j].y) + (x[j].z * x[j].z + x[j].w * x[j].w);
        const float rs = rsqrtf(wave_sum(ss) * (1.0f / DM) + NORM_EPS);
#pragma unroll
        for (int j = 0; j < 8; ++j) { const f32x4 g = *((const f32x4*)g_pre + lane + 64 * j), s1 = *((const f32x4*)sc + lane + 64 * j), s0 = *((const f32x4*)sh + lane + 64 * j);
            const f32x4 h = x[j] * rs * g * (1.0f + s1) + s0;
            *((unsigned long long*)hdst + lane + 64 * j) = (unsigned long long)pk2(h.x, h.y) | ((unsigned long long)pk2(h.z, h.w) << 32); }
    }
}
__device__ __forceinline__ int cond_row(int r) { return r < M_C ? 4 : (r - M_C) / S_L; }
__device__ __forceinline__ const float* mod_ptr(KArgs a, int l, int cr, int which) { return (const float*)(a->ws + WS_MOD) + ((size_t)(l * 5 + cr) * 6 + which) * DM; }

__device__ __forceinline__ void phase_first_norm(KArgs a, int gw, int NGW, int lane) {
    for (int r = gw; r < MTOK; r += NGW) {
        const float* xs = r < M_C ? a->in[I_XP] + (size_t)r * DM : a->in[I_XS] + (size_t)(r - M_C) * DM; const int cr = cond_row(r);
        row_update(xs, nullptr, a->out + (size_t)r * DM, nullptr, nullptr, a->in[I_GPM], mod_ptr(a, 0, cr, 1), mod_ptr(a, 0, cr, 0), (bf16*)(a->ws + WS_H) + (size_t)r * DM, lane);
    }
}
__device__ __forceinline__ void phase_residual(KArgs a, int l, int which, int gw, int NGW, int lane) {
    const float* MO = (const float*)(a->ws + WS_MO);
    for (int r = gw; r < MTOK; r += NGW) {
        const int cr = cond_row(r); float* xr = a->out + (size_t)r * DM; bf16* hr = (bf16*)(a->ws + WS_H) + (size_t)r * DM;
        if (which == 0) row_update(xr, MO + (size_t)r * DM, xr, a->in[I_GPOM] + l * DM, mod_ptr(a, l, cr, 2), a->in[I_GPF] + l * DM, mod_ptr(a, l, cr, 4), mod_ptr(a, l, cr, 3), hr, lane);
        else if (l + 1 < DEPTH) row_update(xr, MO + (size_t)r * DM, xr, a->in[I_GPOF] + l * DM, mod_ptr(a, l, cr, 5), a->in[I_GPM] + (l + 1) * DM, mod_ptr(a, l + 1, cr, 1), mod_ptr(a, l + 1, cr, 0), hr, lane);
        else row_update(xr, MO + (size_t)r * DM, xr, a->in[I_GPOF] + l * DM, mod_ptr(a, l, cr, 5), nullptr, nullptr, nullptr, nullptr, lane);
    }
}

__device__ __forceinline__ void rope8(float (&y)[8], int pxor, bool first, const float2* tab) {
#pragma unroll
    for (int i = 0; i < 8; ++i) { const float yp = __shfl_xor(y[i], pxor); const float2 cs = tab[i]; y[i] = first ? y[i] * cs.x - yp * cs.y : y[i] * cs.x + yp * cs.y; }
}

__device__ __forceinline__ void phase_postproj(KArgs a, int l, int gw, int NGW, int lane) {
    unsigned char* ws = a->ws;
    const bf16* PROJ = (const bf16*)(ws + WS_PROJ);
    const float2* R128 = (const float2*)(ws + WS_ROPE); const float2* R64 = (const float2*)(ws + WS_ROPE + 32768);
    bf16* QA = (bf16*)(ws + WS_QA); bf16* QM = (bf16*)(ws + WS_QM); bf16* XC = (bf16*)(ws + WS_XC);
    bf16* KAL = (bf16*)(ws + WS_KAL); bf16* VAL = (bf16*)(ws + WS_VAL); bf16* KAC = (bf16*)(ws + WS_KAC); bf16* VAC = (bf16*)(ws + WS_VAC);
    bf16* CKV = (bf16*)(ws + WS_CKV); bf16* KR = (bf16*)(ws + WS_KR);
    for (int job = gw; job < MTOK + NB_L * PAST; job += NGW) {
        if (job >= MTOK) {
            const int cb = (job - MTOK) / PAST, p = (job - MTOK) % PAST; float x[8];
            const size_t crow_ = ((size_t)(cb * DEPTH + l) * PAST + p);
            if (lane < 32) { ld8f(a->in[I_CK] + crow_ * 256 + 8 * lane, x); st8bf(KAL + ((size_t)cb * SKV_L + p) * 256 + 8 * lane, x);
                             ld8f(a->in[I_CV] + crow_ * 256 + 8 * lane, x); st8bf(VAL + ((size_t)cb * SKV_L + p) * 256 + 8 * lane, x); }
            const size_t krow = (size_t)M_C + (size_t)cb * SKV_L + p;
            ld8f(a->in[I_CCKV] + crow_ * 512 + 8 * lane, x); st8bf(CKV + krow * 512 + 8 * lane, x);
            if (lane < 8) { ld8f(a->in[I_CKR] + crow_ * 64 + 8 * lane, x); st8bf(KR + krow * 64 + 8 * lane, x); }
            continue;
        }
        const int r = job; const bool lat = r >= M_C;
        const int b = lat ? (r - M_C) / S_L : r / S_C, t = lat ? (r - M_C) % S_L : r % S_C, slen = lat ? S_L : S_C;
        const int prow = t >> 6, pcol = t & 63;
        const bf16* pr = PROJ + (size_t)r * NPROJ;
        const size_t krow = lat ? (size_t)M_C + (size_t)b * SKV_L + PAST + t : (size_t)r;
        const size_t orow = ((size_t)(b * DEPTH + l) * S_C + t);
        float x[8];
        { ld8bf(pr + C_QA + 8 * lane, x); float ss = 0.f;
#pragma unroll
          for (int i = 0; i < 8; ++i) ss += x[i] * x[i];
          ss += __shfl_xor(ss, 1); ss += __shfl_xor(ss, 2); ss += __shfl_xor(ss, 4); ss += __shfl_xor(ss, 8);
          const float rs = rsqrtf(ss * (1.0f / 128.0f) + NORM_EPS); float g[8]; ld8f(a->in[I_GQ] + l * 128 + 8 * (lane & 15), g);
#pragma unroll
          for (int i = 0; i < 8; ++i) x[i] = x[i] * rs * g[i];
          if (lat) { const int s = lane & 15; rope8(x, 4, (s & 7) < 4, R128 + ((s >> 3) ? pcol : prow) * 32 + 8 * (s & 3)); }
          st8bf(QA + (size_t)r * 512 + 8 * lane, x); }
        { ld8bf(pr + C_KA + 8 * lane, x); float ss = 0.f;
#pragma unroll
          for (int i = 0; i < 8; ++i) ss += x[i] * x[i];
          ss += __shfl_xor(ss, 1); ss += __shfl_xor(ss, 2); ss += __shfl_xor(ss, 4); ss += __shfl_xor(ss, 8);
          const float rs = rsqrtf(ss * (1.0f / 128.0f) + NORM_EPS); float g[8]; ld8f(a->in[I_GK] + l * 128 + 8 * (lane & 15), g);
          float y[8];
#pragma unroll
          for (int i = 0; i < 8; ++i) y[i] = x[i] * rs * g[i];
          if (lat) { const int s = lane & 15; rope8(y, 4, (s & 7) < 4, R128 + ((s >> 3) ? pcol : prow) * 32 + 8 * (s & 3)); }
          if (lane < 32) {
              if (lat) st8bf(KAL + ((size_t)b * SKV_L + PAST + t) * 256 + 8 * lane, y);
              else { st8bf(KAC + (size_t)r * 256 + 8 * lane, y); st8f(a->out + O_K + orow * 256 + 8 * lane, y); }
          } else { const int c = 8 * (lane - 32);
              if (lat) st8bf(VAL + ((size_t)b * SKV_L + PAST + t) * 256 + c, x);
              else { st8bf(VAC + (size_t)r * 256 + c, x); st8f(a->out + O_V + orow * 256 + c, x); }
          } }
#pragma unroll
        for (int k = 0; k < 2; ++k) { const int c = 8 * lane + 512 * k; float acc[8]; ld8f(a->in[I_LCB] + l * LRU_W + c, acc);
#pragma unroll
          for (int j = 0; j < 4; ++j) { const int tt = t + j - 1; if (tt >= 0 && tt < slen) { float xv[8], w[8]; ld8bf(pr + (ptrdiff_t)(j - 1) * NPROJ + C_XR + c, xv); ld8f(a->in[I_LCW] + ((size_t)l * 4 + j) * LRU_W + c, w);
#pragma unroll
              for (int i = 0; i < 8; ++i) acc[i] += w[i] * xv[i]; } }
          st8bf(XC + (size_t)r * LRU_W + c, acc); }
#pragma unroll
        for (int ps = 0; ps < 2; ++ps) { const int s = 64 * ps + lane; const bool act = (ps == 0) || lane < 32; const int s24 = s % 24;
#pragma unroll
          for (int i = 0; i < 8; ++i) x[i] = 0.f;
          if (act) ld8bf(pr + C_QM + 8 * s, x);
          if (lat) { float y[8];
#pragma unroll
              for (int i = 0; i < 8; ++i) y[i] = x[i];
              const int sr = (s24 - 16) & 7; rope8(y, 2, (sr & 3) < 2, R64 + ((sr >> 2) ? pcol : prow) * 16 + 8 * (sr & 1));
              if (s24 >= 16) {
#pragma unroll
                  for (int i = 0; i < 8; ++i) x[i] = y[i]; } }
          if (act) st8bf(QM + (size_t)r * 768 + 8 * s, x); }
        { ld8bf(pr + C_CKV + 8 * lane, x); float ss = 0.f;
#pragma unroll
          for (int i = 0; i < 8; ++i) ss += x[i] * x[i];
          const float rs = rsqrtf(wave_sum(ss) * (1.0f / 512.0f) + NORM_EPS); float g[8]; ld8f(a->in[I_GKV] + l * 512 + 8 * lane, g);
#pragma unroll
          for (int i = 0; i < 8; ++i) x[i] = x[i] * rs * g[i];
          st8bf(CKV + krow * 512 + 8 * lane, x); if (!lat) st8f(a->out + O_CKV + orow * 512 + 8 * lane, x); }
        { const int ll = lane & 7; ld8bf(pr + C_KR + 8 * ll, x);
          if (lat) rope8(x, 2, (ll & 3) < 2, R64 + ((ll >> 2) ? pcol : prow) * 16 + 8 * (ll & 1));
          if (lane < 8) { st8bf(KR + krow * 64 + 8 * lane, x); if (!lat) st8f(a->out + O_KR + orow * 64 + 8 * lane, x); } }
    }
}

__device__ __forceinline__ void phase_lru_gates(KArgs a, int l, int gw, int NGW, int lane) {
    unsigned char* ws = a->ws; const bf16* XC = (const bf16*)(ws + WS_XC); const bf16* WG = (const bf16*)(ws + WS_WG) + (size_t)l * 32 * 16384;
    float* AB = (float*)(ws + WS_AU);
    const int r32 = lane & 31, hi = lane >> 5;
    for (int u = gw; u < 16 * (MTOK / 32); u += NGW) {
        const int nd = u / (MTOK / 32), rb = u % (MTOK / 32), n = nd >> 1, dir = nd & 1;
        bf16x8 af[8];
        const bf16* ap = XC + (size_t)(rb * 32 + r32) * LRU_W + n * 128 + hi * 8;
#pragma unroll
        for (int ks = 0; ks < 8; ++ks) af[ks] = *(const bf16x8*)(ap + ks * 16);
        float* Ad = AB + (size_t)(dir * 2 + 0) * MTOK * LRU_W; float* Ud = AB + (size_t)(dir * 2 + 1) * MTOK * LRU_W;
#pragma unroll 1
        for (int nb = 0; nb < 4; ++nb) {
            f32x16 acc0 = f32x16{}, acc1 = f32x16{};
            const bf16* bp0 = WG + (size_t)((n * 2 + dir) * 2 + 0) * 16384 + (size_t)(nb * 32 + r32) * 128 + hi * 8; const bf16* bp1 = bp0 + 16384;
#pragma unroll
            for (int ks = 0; ks < 8; ++ks) { const bf16x8 b0 = *(const bf16x8*)(bp0 + ks * 16), b1 = *(const bf16x8*)(bp1 + ks * 16);
                acc0 = __builtin_amdgcn_mfma_f32_32x32x16_bf16(af[ks], b0, acc0, 0, 0, 0); acc1 = __builtin_amdgcn_mfma_f32_32x32x16_bf16(af[ks], b1, acc1, 0, 0, 0); }
            const int c = n * 128 + nb * 32 + r32;
            const float ba = a->in[I_LBA][(l * 2 + dir) * LRU_W + c], bx = a->in[I_LBX][(l * 2 + dir) * LRU_W + c], lam = a->in[I_LLAM][(l * 2 + dir) * LRU_W + c];
            const float lsg = -log1pf(__expf(-lam)) * 8.0f;
#pragma unroll
            for (int r = 0; r < 16; ++r) { const int tok = rb * 32 + att::crow(r, hi);
                const float rg = sigmoidf_(acc0[r] + ba), ig = sigmoidf_(acc1[r] + bx);
                const float la = lsg * rg, av = __expf(la), xv = bf2f(XC[(size_t)tok * LRU_W + c]);
                const float uv = sqrtf(fmaxf(-expm1f(2.0f * la), 0.f)) * (ig * xv);
                Ad[(size_t)tok * LRU_W + c] = av; Ud[(size_t)tok * LRU_W + c] = uv; }
        }
    }
}
__device__ __forceinline__ void phase_lru_summ(KArgs a, int gtid, int NTHR) {
    const float* AB = (const float*)(a->ws + WS_AU); float2* SUMM = (float2*)(a->ws + WS_SUMM);
    for (int i = gtid; i < 2 * 64 * LRU_W; i += NTHR) {
        const int dir = i / (64 * LRU_W), tile = (i / LRU_W) % 64, c = i % LRU_W; const size_t row0 = (size_t)M_C + (size_t)tile * 256;
        const float* Ad = AB + (size_t)(dir * 2 + 0) * MTOK * LRU_W + c; const float* Ud = AB + (size_t)(dir * 2 + 1) * MTOK * LRU_W + c;
        float P = 1.f, h = 0.f;
#pragma unroll 8
        for (int s = 0; s < 256; ++s) { const size_t rr = row0 + (dir ? 255 - s : s); const float av = Ad[rr * LRU_W], uv = Ud[rr * LRU_W]; h = av * h + uv; P *= av; }
        SUMM[i] = make_float2(P, h);
    }
}
__device__ __forceinline__ void phase_lru_final(KArgs a, int l, int gtid, int NTHR) {
    unsigned char* ws = a->ws; const float* AB = (const float*)(ws + WS_AU); const float2* SUMM = (const float2*)(ws + WS_SUMM);
    float* HF = (float*)(ws + WS_HF); const bf16* PROJ = (const bf16*)(ws + WS_PROJ); bf16* MIX = (bf16*)(ws + WS_MIX);
    for (int i = gtid; i < 96 * LRU_W; i += NTHR) {
        const int tile = i / LRU_W, c = i % LRU_W; const bool lat = tile >= 32; const size_t row0 = (size_t)tile * 256;
        const float* Af = AB + (size_t)0 * MTOK * LRU_W + c; const float* Uf = AB + (size_t)1 * MTOK * LRU_W + c;
        const float* Ab = AB + (size_t)2 * MTOK * LRU_W + c; const float* Ub = AB + (size_t)3 * MTOK * LRU_W + c;
        float h = 0.f;
        if (lat) { const int b = (tile - 32) / 16, j = (tile - 32) % 16; h = a->in[I_ST][((size_t)(b * DEPTH + l) * 2 + 0) * LRU_W + c];
            for (int jj = 0; jj < j; ++jj) { const float2 s = SUMM[(size_t)(0 * 64 + b * 16 + jj) * LRU_W + c]; h = s.x * h + s.y; } }
#pragma unroll 8
        for (int s = 0; s < 256; ++s) { const size_t rr = row0 + s; h = Af[rr * LRU_W] * h + Uf[rr * LRU_W]; HF[rr * LRU_W + c] = h; }
        if (!lat) a->out[O_ST + ((size_t)(tile * DEPTH + l) * 2 + 0) * LRU_W + c] = h;
        h = 0.f;
        if (lat) { const int b = (tile - 32) / 16, j = (tile - 32) % 16; h = a->in[I_ST][((size_t)(b * DEPTH + l) * 2 + 1) * LRU_W + c];
            for (int jj = 15; jj > j; --jj) { const float2 s = SUMM[(size_t)(1 * 64 + b * 16 + jj) * LRU_W + c]; h = s.x * h + s.y; } }
#pragma unroll 8
        for (int s = 255; s >= 0; --s) { const size_t rr = row0 + s; h = Ab[rr * LRU_W] * h + Ub[rr * LRU_W];
            const float g = bf2f(PROJ[rr * NPROJ + C_GR + c]); const float y = (HF[rr * LRU_W + c] + h) * gelu_tanh(g);
            MIX[rr * DM + 512 + c] = (bf16)f2bf(y); }
        if (!lat) a->out[O_ST + ((size_t)(tile * DEPTH + l) * 2 + 1) * LRU_W + c] = h;
    }
}

__device__ __forceinline__ void phase_attention_gqa(KArgs a, char* lds, int wg, int G) {
    unsigned char* ws = a->ws;
    const bf16* QA = (const bf16*)(ws + WS_QA); const bf16* KAL = (const bf16*)(ws + WS_KAL); const bf16* VAL = (const bf16*)(ws + WS_VAL); const bf16* KAC = (const bf16*)(ws + WS_KAC); const bf16* VAC = (const bf16*)(ws + WS_VAC);
    bf16* MIX = (bf16*)(ws + WS_MIX);
    for (int u = wg; u < 384; u += G) {
        const bool lat = u < 256; int b, head, seq; size_t row0;
        if (lat) { const int x = u & 7, idx = u >> 3, qb = idx & 15; seq = SKV_L; b = x >> 1; head = (x & 1) * 2 + (idx >> 4); row0 = (size_t)M_C + (size_t)b * S_L + (size_t)qb * 256; }
        else { const int v = u - 256; b = v >> 2; head = v & 3; seq = S_C; row0 = (size_t)b * S_C; }
        const int kvh = head >> 1;
        const bf16* Kp = lat ? KAL + (size_t)b * SKV_L * 256 + kvh * 128 : KAC + (size_t)b * S_C * 256 + kvh * 128;
        const bf16* Vp = lat ? VAL + (size_t)b * SKV_L * 256 + kvh * 128 : VAC + (size_t)b * S_C * 256 + kvh * 128;
        att::attn_body<0, 2, 8, 512, 256, 64, 256, DM>(QA + row0 * 512 + head * 128, Kp, nullptr, Vp, MIX + row0 * DM + head * 128, seq, lds);
    }
}
__device__ __forceinline__ void phase_attention_mla(KArgs a, char* lds, int wg, int G) {
    unsigned char* ws = a->ws;
    const bf16* QM = (const bf16*)(ws + WS_QM); const bf16* KVM = (const bf16*)(ws + WS_KVM); const bf16* KR = (const bf16*)(ws + WS_KR); bf16* MIX = (bf16*)(ws + WS_MIX);
    for (int u = wg; u < 384; u += G) {
        const bool lat = u < 256; int b, head, seq; size_t row0, key0;
        if (lat) { const int x = u & 7, idx = u >> 3, qb = idx & 15, p = x * 2 + (idx >> 4); seq = SKV_L; b = p >> 2; head = p & 3; row0 = (size_t)M_C + (size_t)b * S_L + (size_t)qb * 256; key0 = (size_t)M_C + (size_t)b * SKV_L; }
        else { const int v = u - 256; b = v >> 2; head = v & 3; seq = S_C; row0 = (size_t)b * S_C; key0 = row0; }
        att::attn_body<64, MLA_SD, MLA_NQR, 768, 1024, 64, 1024, DM>(QM + row0 * 768 + head * 192, KVM + key0 * 1024 + head * 128, KR + key0 * 64, KVM + key0 * 1024 + 512 + head * 128,
                                                                  MIX + row0 * DM + 1536 + head * 128, seq, lds);
    }
}

__device__ __forceinline__ void phase_ffn_act(KArgs a, int l, int gtid, int NTHR) {
    const bf16* U = (const bf16*)(a->ws + WS_U); bf16* ACT = (bf16*)(a->ws + WS_ACT);
    const float* cw = a->in[I_FCW] + (size_t)l * 3 * NUP; const float* cb = a->in[I_FCB] + (size_t)l * NUP;
    constexpr int CG = DFF / 8;
    for (long i = gtid; i < (long)MTOK * CG; i += NTHR) {
        const int r = (int)(i / CG), c = (int)(i % CG) * 8; const bool lat = r >= M_C; const int t = lat ? (r - M_C) % S_L : r % S_C, slen = lat ? S_L : S_C;
        float g[8], v[8]; ld8f(cb + c, g); ld8f(cb + DFF + c, v);
#pragma unroll
        for (int j = 0; j < 3; ++j) { const int tt = t + j - 1; if (tt >= 0 && tt < slen) { float xg[8], xv[8], wg_[8], wv[8]; const bf16* ur = U + (size_t)(r + j - 1) * NUP;
            ld8bf(ur + c, xg); ld8bf(ur + DFF + c, xv); ld8f(cw + (size_t)j * NUP + c, wg_); ld8f(cw + (size_t)j * NUP + DFF + c, wv);
#pragma unroll
            for (int e = 0; e < 8; ++e) { g[e] += wg_[e] * xg[e]; v[e] += wv[e] * xv[e]; } } }
        float o[8];
#pragma unroll
        for (int e = 0; e < 8; ++e) o[e] = siluf_(g[e]) * v[e];
        st8bf(ACT + (size_t)r * DFF + c, o);
    }
}

#ifndef EN_AT2
#define EN_AT2 1
#endif
#ifndef EN_P0
#define EN_P0 1
#endif
#ifndef EN_P1
#define EN_P1 1
#endif
#ifndef EN_G1
#define EN_G1 1
#endif
#ifndef EN_PP
#define EN_PP 1
#endif
#ifndef EN_LG
#define EN_LG 1
#endif
#ifndef EN_LS
#define EN_LS 1
#endif
#ifndef EN_AT
#define EN_AT 1
#endif
#ifndef EN_LF
#define EN_LF 1
#endif
#ifndef EN_G2
#define EN_G2 1
#endif
#ifndef EN_R1
#define EN_R1 1
#endif
#ifndef EN_G3
#define EN_G3 1
#endif
#ifndef EN_FA
#define EN_FA 1
#endif
#ifndef EN_G4
#define EN_G4 1
#endif
#ifndef EN_R2
#define EN_R2 1
#endif
__global__ void __launch_bounds__(NTHREADS, 2) fwd_kernel(Args args) {
    extern __shared__ __attribute__((aligned(16))) unsigned char lds_raw[];
    const KArgs ka = (KArgs)__builtin_amdgcn_kernarg_segment_ptr();
    const int G = gridDim.x, bx = blockIdx.x;
    const int vcu = (G % 8 == 0) ? (bx % 8) * (G / 8) + bx / 8 : bx;
    const int NGW = G * NWAVES, NTHR = G * NTHREADS;
#define PH_IDS const int tid = ltid(), lane = tid & 63, wave = __builtin_amdgcn_readfirstlane(tid >> 6), gw = vcu * NWAVES + wave, gtid = vcu * NTHREADS + tid; (void)lane; (void)wave; (void)gw; (void)gtid; const KArgs a = launder(ka)
    LAS unsigned char* ldsL = (LAS unsigned char*)lds_raw; char* lds = (char*)lds_raw;
    volatile LAS unsigned* MISC = (volatile LAS unsigned*)(ldsL + MISC_OFF);
    for (int u = threadIdx.x; u < (LDS_BYTES - LDSCTL_OFF) / 4; u += NTHREADS) ((LAS unsigned*)(ldsL + LDSCTL_OFF))[u] = 0u;
    __syncthreads();
    unsigned* ctl = (unsigned*)(ka->ws + WS_CTL);
#if MK_MULTI
#define GRID_BAR() do { } while (0)
#else
    XcdBarrier bar = xcd_barrier_post(ctl + CW_BAR, MISC + 8);
#define GRID_BAR() xcd_barrier(bar)
#endif
    const int lo = ka->ph_lo, hi = ka->ph_hi;
#define IN(k) (lo <= (k) && (k) < hi)
#define SEAM(k) do { if (IN(k) && IN((k) + 1)) GRID_BAR(); else __syncthreads(); } while (0)
    if (EN_P0 && IN(0)) { PH_IDS; phase_prologue(a, lds, gw, NGW, wave, lane); } SEAM(0);
    if (EN_P0 && IN(1)) { PH_IDS; phase_mod_reduce(a, gtid, NTHR); } SEAM(1);
    if (EN_P1 && IN(2)) { PH_IDS; phase_first_norm(a, gw, NGW, lane); } SEAM(2);

    for (int l = 0; l < DEPTH; ++l) {
        const int pb = PH_PRE + l * PH_PER_LAYER;
        if (EN_G1 && IN(pb + 0)) {
            unsigned char* ws = launder(ka)->ws;
            pg8::Gemm g{(const bf16*)(ws + WS_H), (const bf16*)(ws + WS_WIN) + (size_t)l * NPROJ * DM, MTOK, NPROJ, DM}; pg8::StaticOrder S; S.init(MTOK, NPROJ, G, bx);
            pg8::EpiBf16<0> E{(bf16*)(ws + WS_PROJ), NPROJ, nullptr, 0, 0, 1.f};
            pg8::gemm_phase<pg8::EpiBf16<0>, pg8::StaticOrder, true, true>(ldsL, g, S, E);
        } SEAM(pb + 0);
        if (EN_PP && IN(pb + 1)) { PH_IDS; phase_postproj(a, l, gw, NGW, lane); } SEAM(pb + 1);
        if (EN_LG && IN(pb + 2)) {
            { PH_IDS; phase_lru_gates(a, l, gw, NGW, lane); }
            __syncthreads();
            unsigned char* ws = launder(ka)->ws;
            pg8::Gemm g{(const bf16*)(ws + WS_CKV), (const bf16*)(ws + WS_WKV) + (size_t)l * 1024 * 512, MKEY, 1024, 512}; pg8::StaticOrder S; S.init(MKEY, 1024, G, bx);
            pg8::EpiBf16<0> E{(bf16*)(ws + WS_KVM), 1024, nullptr, 0, 0, 1.f};
            pg8::gemm_phase<pg8::EpiBf16<0>, pg8::StaticOrder, true, true>(ldsL, g, S, E);
        } SEAM(pb + 2);
        if (IN(pb + 3)) { if (EN_LS) { PH_IDS; phase_lru_summ(a, gtid, NTHR); } __syncthreads();
            if (EN_AT) { PH_IDS; phase_attention_gqa(a, lds, bx, G); }
            if (EN_AT2) { PH_IDS; phase_attention_mla(a, lds, bx, G); } } SEAM(pb + 3);
        if (EN_LF && IN(pb + 4)) { PH_IDS; phase_lru_final(a, l, gtid, NTHR); } SEAM(pb + 4);
        if (EN_G2 && IN(pb + 5)) {
            unsigned char* ws = launder(ka)->ws;
            pg8::Gemm g{(const bf16*)(ws + WS_MIX), (const bf16*)(ws + WS_WOUT) + (size_t)l * DM * DM, MTOK, DM, DM}; pg8::StaticOrder S; S.init(MTOK, DM, G, bx);
            pg8::EpiF32 E{(float*)(ws + WS_MO), DM, nullptr};
            pg8::gemm_phase<pg8::EpiF32, pg8::StaticOrder, true, true>(ldsL, g, S, E);
        } SEAM(pb + 5);
        if (EN_R1 && IN(pb + 6)) { PH_IDS; phase_residual(a, l, 0, gw, NGW, lane); } SEAM(pb + 6);
        if (EN_G3 && IN(pb + 7)) {
            unsigned char* ws = launder(ka)->ws;
            pg8::Gemm g{(const bf16*)(ws + WS_H), (const bf16*)(ws + WS_WUP) + (size_t)l * NUP * DM, MTOK, NUP, DM}; pg8::StaticOrder S; S.init(MTOK, NUP, G, bx);
            pg8::EpiBf16<0> E{(bf16*)(ws + WS_U), NUP, nullptr, 0, 0, 1.f};
            pg8::gemm_phase<pg8::EpiBf16<0>, pg8::StaticOrder, true, true>(ldsL, g, S, E);
        } SEAM(pb + 7);
        if (EN_FA && IN(pb + 8)) { PH_IDS; phase_ffn_act(a, l, gtid, NTHR); } SEAM(pb + 8);
        if (EN_G4 && IN(pb + 9)) {
            unsigned char* ws = launder(ka)->ws;
            pg8::Gemm g{(const bf16*)(ws + WS_ACT), (const bf16*)(ws + WS_WDN) + (size_t)l * DM * DFF, MTOK, DM, DFF}; pg8::StaticOrder S; S.init(MTOK, DM, G, bx);
            pg8::EpiF32 E{(float*)(ws + WS_MO), DM, nullptr};
            pg8::gemm_phase<pg8::EpiF32, pg8::StaticOrder, true, true>(ldsL, g, S, E);
        } SEAM(pb + 9);
        if (EN_R2 && IN(pb + 10)) { PH_IDS; phase_residual(a, l, 1, gw, NGW, lane); } SEAM(pb + 10);
    }
#undef IN
#undef SEAM
}

extern "C" void kernel_launch(void* const* d_in, const int* in_sizes, int n_in, void* d_out, int out_size, void* d_ws, size_t ws_size, hipStream_t stream) {
    static int grid = 0;
    if (grid == 0) {
        if (n_in != N_IN || (size_t)out_size != O_END || ws_size < WS_END) { fprintf(stderr, "kernel_launch: unexpected shapes: n_in %d out %d ws %zu (need %zu)\n", n_in, out_size, ws_size, (size_t)WS_END); grid = -1; return; }
        int dev = 0, cus = 0, per_cu = 0;
        if (hipGetDevice(&dev) != hipSuccess || hipDeviceGetAttribute(&cus, hipDeviceAttributeMultiprocessorCount, dev) != hipSuccess) { grid = -1; return; }
        if (hipFuncSetAttribute((const void*)fwd_kernel, hipFuncAttributeMaxDynamicSharedMemorySize, LDS_BYTES) != hipSuccess) { fprintf(stderr, "kernel_launch: hipFuncSetAttribute failed\n"); grid = -1; return; }
        if (hipOccupancyMaxActiveBlocksPerMultiprocessor(&per_cu, (const void*)fwd_kernel, NTHREADS, LDS_BYTES) != hipSuccess || per_cu < 1) { fprintf(stderr, "kernel_launch: occupancy query says %d blocks per CU\n", per_cu); (void)hipGetLastError(); grid = -1; return; }
        grid = cus;
    }
    if (grid < 0) return;
    (void)hipMemsetAsync((char*)d_ws + WS_CTL, 0, CTL_ZERO_BYTES, stream);
    Args a{};
    for (int i = 0; i < N_IN; ++i) a.in[i] = (const float*)d_in[i];
    a.out = (float*)d_out; a.ws = (unsigned char*)d_ws;
#if MK_MULTI
    for (int p = 0; p < PH_TOTAL; ++p) { a.ph_lo = p; a.ph_hi = p + 1; hipLaunchKernelGGL(fwd_kernel, dim3(grid), dim3(NTHREADS), LDS_BYTES, stream, a); }
#else
    a.ph_lo = 0; a.ph_hi = PH_TOTAL; hipLaunchKernelGGL(fwd_kernel, dim3(grid), dim3(NTHREADS), LDS_BYTES, stream, a);
#endif
    const hipError_t le = hipPeekAtLastError();
    if (le != hipSuccess) fprintf(stderr, "kernel_launch: launch failed: %s\n", hipGetErrorName(le));
}
```

```cpp
#include <hip/hip_runtime.h>
#include <cstdio>
#include <cstdint>
#ifndef MK_MULTI
#define MK_MULTI 0
#endif
__device__ __forceinline__ int ltid() { int t = (int)threadIdx.x; asm volatile("" : "+v"(t)); __builtin_assume(t >= 0 && t < 512); return t; }

namespace pg8 {
#define PG8_LAS __attribute__((address_space(3)))
typedef unsigned short bf16_t;
typedef short bf16x8 __attribute__((ext_vector_type(8)));
typedef float f32x4 __attribute__((ext_vector_type(4)));
typedef unsigned u32x4 __attribute__((ext_vector_type(4)));
constexpr int BM = 256, BK = 64, HALF = 128, HTB = HALF * BK * 2  , STAGE_BYTES = 8 * HTB, NXCD = 8, WGM = 8;

__host__ __device__ __forceinline__ int lds_byte(int r, int c) { const int st = (r >> 4) * 2 + (c >> 5), rr = r & 15, cc = c & 31, ob = rr * 64 + cc * 2; return st * 1024 + (ob ^ (((ob >> 9) & 1) << 5)); }
__host__ __device__ __forceinline__ void stage_rc(int b, int& R, int& C) { const int st = b / 1024, sb = b % 1024, swz = sb ^ (((sb >> 9) & 1) << 5); R = (st >> 1) * 16 + swz / 64; C = (st & 1) * 32 + (swz % 64) / 2; }
__host__ __device__ __forceinline__ int perm32(int rho) { const int n = rho >> 4, i = rho & 15; return 8 * (i >> 2) + 4 * n + (i & 3); }

struct Unit { int pm, pn; };
struct Gemm { const bf16_t* A; const bf16_t* Bt; int M, N, K; };

struct StaticOrder {
    int nM, nN, nwg, G, c;
    __host__ __device__ void init(int M, int N, int G_, int c_) { nM = M / BM; nN = N / BM; nwg = nM * nN; G = G_; c = c_; }
    __host__ __device__ bool next(int i, Unit& u) const {
        const long L = (long)i * G + c; if (L >= nwg) return false;
        int wgid = (int)L; { const int q = nwg / NXCD, r = nwg % NXCD, xcd = wgid % NXCD, off = wgid / NXCD; wgid = (xcd < r ? xcd * (q + 1) : r * (q + 1) + (xcd - r) * q) + off; }
        const int nig = WGM * nN, gid = wgid / nig, fm = gid * WGM, gsz = (nM - fm) < WGM ? (nM - fm) : WGM;
        u.pm = fm + ((wgid % nig) % gsz); u.pn = (wgid % nig) / gsz; return true;
    }
    __device__ __forceinline__ void a_ready(const Unit&) const {}
    __device__ __forceinline__ void done(const Unit&) const {}
};

__device__ __forceinline__ unsigned cvt_pk_bf16(float lo, float hi) { unsigned r; asm volatile("v_cvt_pk_bf16_f32 %0, %1, %2" : "=v"(r) : "v"(lo), "v"(hi)); return r; }
typedef float f32x2 __attribute__((ext_vector_type(2)));
__device__ __forceinline__ f32x2 gelu_pk(f32x2 v) {
    const f32x2 av = __builtin_elementwise_abs(v), d = av * 0.2316418882f + 1.0f;
    f32x2 t; t.x = __builtin_amdgcn_rcpf(d.x); t.y = __builtin_amdgcn_rcpf(d.y);
    f32x2 q = t * 0.5307027145f + (-0.7265760135f); q = q * t + 0.7107068705f; q = q * t + (-0.142248368f); q = q * t + 0.127414796f; q = q * t;
    const f32x2 s = (v * v) * (-0.72134752044f);
    f32x2 e; e.x = __builtin_amdgcn_exp2f(s.x); e.y = __builtin_amdgcn_exp2f(s.y);
    const f32x2 m = v * (q * e), r = v - m;
    f32x2 o; o.x = v.x < 0.f ? m.x : r.x; o.y = v.y < 0.f ? m.y : r.y; return o;
}

template <int ACT  > struct EpiBf16 {
    static constexpr bool PERM = true, AFTER_DRAIN = false; static_assert(ACT == 0 || ACT == 1, "EpiBf16: ACT is 0 (none) or 1 (gelu_pk)");
    bf16_t* O; int ldc; const float* bias; int split_cols; size_t split_stride; float scale0;
    __device__ __forceinline__ void operator()(const f32x4 (&acc)[2][2][4][2], const Unit& u, int wr, int wc, int fr, int fq) const {
        const int row0 = u.pm * BM + wr * 64 + fr; int colt = u.pn * BM; bf16_t* base = O;
        float sc = 1.f; if (split_cols) { const int t = colt / split_cols; base += (size_t)t * split_stride; colt -= t * split_cols; if (t == 0) sc = scale0; }
        const int col0 = colt + wc * 32 + 8 * fq, bcol0 = u.pn * BM + wc * 32 + 8 * fq;
        f32x4 bv[2][2];
#pragma unroll
        for (int bj = 0; bj < 2; ++bj)
#pragma unroll
            for (int n = 0; n < 2; ++n) bv[bj][n] = bias ? *(const f32x4*)(bias + bcol0 + bj * HALF + 4 * n) : (f32x4){0.f, 0.f, 0.f, 0.f};
#pragma unroll
        for (int ai = 0; ai < 2; ++ai)
#pragma unroll
            for (int m = 0; m < 4; ++m) { bf16_t* rowp = base + (size_t)(row0 + ai * HALF + m * 16) * ldc + col0;
#pragma unroll
                for (int bj = 0; bj < 2; ++bj) { f32x4 v0 = acc[ai][bj][m][0] + bv[bj][0], v1 = acc[ai][bj][m][1] + bv[bj][1];
                    if (ACT == 1) { f32x2 a = gelu_pk((f32x2){v0[0], v0[1]}), b = gelu_pk((f32x2){v0[2], v0[3]}), c = gelu_pk((f32x2){v1[0], v1[1]}), d = gelu_pk((f32x2){v1[2], v1[3]});
                        v0 = (f32x4){a.x, a.y, b.x, b.y}; v1 = (f32x4){c.x, c.y, d.x, d.y}; }
                    v0 = v0 * sc; v1 = v1 * sc; u32x4 w; w.x = cvt_pk_bf16(v0[0], v0[1]); w.y = cvt_pk_bf16(v0[2], v0[3]); w.z = cvt_pk_bf16(v1[0], v1[1]); w.w = cvt_pk_bf16(v1[2], v1[3]);
                    *(u32x4*)(rowp + bj * HALF) = w; } }
    }
};
struct EpiF32 {
    static constexpr bool PERM = false, AFTER_DRAIN = false;
    float* C; int ldc; const float* bias;
    __device__ __forceinline__ void operator()(const f32x4 (&acc)[2][2][4][2], const Unit& u, int wr, int wc, int fr, int fq) const {
        const int row0 = u.pm * BM + wr * 64 + fr, col0 = u.pn * BM + wc * 32 + 4 * fq;
        f32x4 bv[2][2];
#pragma unroll
        for (int bj = 0; bj < 2; ++bj)
#pragma unroll
            for (int n = 0; n < 2; ++n) bv[bj][n] = bias ? *(const f32x4*)(bias + col0 + bj * HALF + n * 16) : (f32x4){0.f, 0.f, 0.f, 0.f};
#pragma unroll
        for (int ai = 0; ai < 2; ++ai)
#pragma unroll
            for (int m = 0; m < 4; ++m) { float* rowp = C + (size_t)(row0 + ai * HALF + m * 16) * ldc + col0;
#pragma unroll
                for (int bj = 0; bj < 2; ++bj)
#pragma unroll
                    for (int n = 0; n < 2; ++n) *(f32x4*)(rowp + bj * HALF + n * 16) = acc[ai][bj][m][n] + bv[bj][n]; }
    }
};
template <class Epi, class Sched, bool ALIGN_EPI = false, bool SP2 = false>
__device__ __forceinline__ void gemm_phase(PG8_LAS unsigned char* lds, const Gemm g, const Sched& S, const Epi& E) {
    const int tid = ltid(), wid = __builtin_amdgcn_readfirstlane(tid >> 6), lane = tid & 63, wr = wid >> 2, wc = wid & 3, fr = lane & 15, fq = lane >> 4;
    const int K = g.K, nt = K / BK;
    unsigned voffA[2], voffB[2];
#pragma unroll
    for (int i = 0; i < 2; ++i) { int R, C; stage_rc(tid * 16 + i * 8192, R, C); const int Rb = Epi::PERM ? ((R & ~31) + perm32(R & 31)) : R;
        voffA[i] = (unsigned)(R * K + C) * 2u; voffB[i] = (unsigned)(Rb * K + C) * 2u; }
    const size_t kstep = (size_t)(BK * 2);
    const size_t hstep = (size_t)HALF * K * 2;
    const size_t tstep = 2 * hstep;
    const unsigned ldsw = (unsigned)wid * 1024u;
    const int aoff = lds_byte(wr * 64 + fr, fq * 8), boff = lds_byte(wc * 32 + fr, fq * 8);
#define PG8_SA(b, h) (((b) * 2 + (h)) * HTB)
#define PG8_SB(b, h) ((4 + (b) * 2 + (h)) * HTB)
#define PG8_STAGE(bufoff, gbase, voff) do { _Pragma("unroll") for (int _i = 0; _i < 2; ++_i) \
        __builtin_amdgcn_global_load_lds((const unsigned*)((const char*)(gbase) + (voff)[_i]), (PG8_LAS unsigned*)(lds + (bufoff) + ldsw + _i * 8192), 16, 0, 0); } while (0)
#define PG8_LDA(dst, b, h) do { _Pragma("unroll") for (int m = 0; m < 4; ++m) _Pragma("unroll") for (int k = 0; k < 2; ++k) dst[m][k] = *(const PG8_LAS bf16x8*)(lds + PG8_SA(b, h) + aoff + m * 2048 + k * 1024); } while (0)
#define PG8_LDB(dst, b, h) do { _Pragma("unroll") for (int n = 0; n < 2; ++n) _Pragma("unroll") for (int k = 0; k < 2; ++k) dst[n][k] = *(const PG8_LAS bf16x8*)(lds + PG8_SB(b, h) + boff + n * 2048 + k * 1024); } while (0)
#define PG8_MMA(ai, bj, At, Bt) do { __builtin_amdgcn_s_setprio(1); _Pragma("unroll") for (int m = 0; m < 4; ++m) _Pragma("unroll") for (int n = 0; n < 2; ++n) _Pragma("unroll") for (int k = 0; k < 2; ++k) \
        acc[ai][bj][m][n] = __builtin_amdgcn_mfma_f32_16x16x32_bf16(Bt[n][k], At[m][k], acc[ai][bj][m][n], 0, 0, 0); __builtin_amdgcn_s_setprio(0); } while (0)
#define PG8_WAIT_V(n) asm volatile("s_waitcnt vmcnt(" #n ")" ::: "memory")
#define PG8_WAIT_L(n) asm volatile("s_waitcnt lgkmcnt(" #n ")" ::: "memory")
#define PG8_BAR __builtin_amdgcn_s_barrier()
#define PG8_SCHED __builtin_amdgcn_sched_barrier(0)
    Unit cur, nxt; int ui = 0;
    if (!S.next(0, cur)) return;
    f32x4 acc[2][2][4][2];
#pragma unroll
    for (int a = 0; a < 2; ++a)
#pragma unroll
        for (int b = 0; b < 2; ++b)
#pragma unroll
            for (int m = 0; m < 4; ++m)
#pragma unroll
                for (int n = 0; n < 2; ++n) acc[a][b][m][n] = (f32x4){0.f, 0.f, 0.f, 0.f};
    bf16x8 At[4][2], B0[2][2], B1[2][2];
    const char* cA = (const char*)g.A + (size_t)cur.pm * tstep; const char* cB = (const char*)g.Bt + (size_t)cur.pn * tstep;
    S.a_ready(cur);
    if constexpr (SP2) {
        PG8_STAGE(PG8_SB(0, 0), cB, voffB); PG8_STAGE(PG8_SB(0, 1), cB + hstep, voffB); PG8_STAGE(PG8_SA(0, 0), cA, voffA); PG8_STAGE(PG8_SA(0, 1), cA + hstep, voffA);
        if (wr == 1) PG8_BAR;
        PG8_WAIT_V(2); PG8_BAR;
        PG8_STAGE(PG8_SB(1, 0), cB + kstep, voffB); PG8_STAGE(PG8_SA(1, 0), cA + kstep, voffA); PG8_STAGE(PG8_SB(1, 1), cB + hstep + kstep, voffB);
        PG8_WAIT_V(6); PG8_BAR;
    } else {
        PG8_STAGE(PG8_SB(0, 0), cB, voffB); PG8_STAGE(PG8_SA(0, 0), cA, voffA); PG8_STAGE(PG8_SB(0, 1), cB + hstep, voffB); PG8_STAGE(PG8_SA(0, 1), cA + hstep, voffA);
        if (wr == 1) PG8_BAR;
        PG8_WAIT_V(4); PG8_BAR;
        PG8_STAGE(PG8_SB(1, 0), cB + kstep, voffB); PG8_STAGE(PG8_SA(1, 0), cA + kstep, voffA); PG8_STAGE(PG8_SB(1, 1), cB + hstep + kstep, voffB);
        PG8_WAIT_V(6); PG8_BAR;
    }
    for (;;) {
        const bool has_next = S.next(ui + 1, nxt);
        const char* nA = has_next ? (const char*)g.A + (size_t)nxt.pm * tstep : cA; const char* nB = has_next ? (const char*)g.Bt + (size_t)nxt.pn * tstep : cB;
        for (int t = 0; t < nt; t += 2) {
            const bool last = (t == nt - 2);
            const char* a1 = cA + (size_t)(t + 1) * kstep;
            const char* a2 = last ? nA : cA + (size_t)(t + 2) * kstep; const char* b2 = last ? nB : cB + (size_t)(t + 2) * kstep;
            const char* a3 = a2 + kstep; const char* b3 = b2 + kstep;
            if (last && has_next) S.a_ready(nxt);
            if constexpr (SP2) {
            PG8_LDB(B0, 0, 0); PG8_LDB(B1, 0, 1); PG8_SCHED; PG8_LDA(At, 0, 0); PG8_STAGE(PG8_SA(1, 1), a1 + hstep, voffA);
            PG8_WAIT_V(8); PG8_WAIT_L(0); PG8_BAR; PG8_MMA(0, 0, At, B0); PG8_MMA(0, 1, At, B1); PG8_BAR; PG8_SCHED;
            PG8_LDA(At, 0, 1); PG8_STAGE(PG8_SB(0, 0), b2, voffB); PG8_STAGE(PG8_SB(0, 1), b2 + hstep, voffB); PG8_STAGE(PG8_SA(0, 0), a2, voffA);
            PG8_WAIT_V(8); PG8_WAIT_L(0); PG8_BAR; PG8_MMA(1, 0, At, B0); PG8_MMA(1, 1, At, B1); PG8_BAR; PG8_SCHED;
            PG8_LDB(B0, 1, 0); PG8_LDB(B1, 1, 1); PG8_SCHED; PG8_LDA(At, 1, 0); PG8_STAGE(PG8_SA(0, 1), a2 + hstep, voffA);
            PG8_WAIT_V(8); PG8_WAIT_L(0); PG8_BAR; PG8_MMA(0, 0, At, B0); PG8_MMA(0, 1, At, B1); PG8_BAR; PG8_SCHED;
            PG8_LDA(At, 1, 1); PG8_STAGE(PG8_SB(1, 0), b3, voffB); PG8_STAGE(PG8_SB(1, 1), b3 + hstep, voffB); PG8_STAGE(PG8_SA(1, 0), a3, voffA);
            PG8_WAIT_V(8); PG8_WAIT_L(0); PG8_BAR; PG8_MMA(1, 0, At, B0); PG8_MMA(1, 1, At, B1); PG8_BAR; PG8_SCHED;
            } else {
            PG8_LDB(B0, 0, 0); PG8_SCHED; PG8_LDA(At, 0, 0); PG8_STAGE(PG8_SA(1, 1), a1 + hstep, voffA);
            PG8_WAIT_L(8); PG8_BAR; PG8_WAIT_L(0); PG8_MMA(0, 0, At, B0); PG8_BAR; PG8_SCHED;
            PG8_LDB(B1, 0, 1); PG8_STAGE(PG8_SB(0, 0), b2, voffB);
            PG8_BAR; PG8_WAIT_L(0); PG8_MMA(0, 1, At, B1); PG8_BAR;
            PG8_LDA(At, 0, 1); PG8_STAGE(PG8_SA(0, 0), a2, voffA);
            PG8_BAR; PG8_WAIT_L(0); PG8_MMA(1, 0, At, B0); PG8_BAR; PG8_SCHED;
            PG8_STAGE(PG8_SB(0, 1), b2 + hstep, voffB);
            PG8_WAIT_V(6); PG8_BAR; PG8_MMA(1, 1, At, B1); PG8_BAR;
            PG8_LDB(B0, 1, 0); PG8_SCHED; PG8_LDA(At, 1, 0); PG8_STAGE(PG8_SA(0, 1), a2 + hstep, voffA);
            PG8_WAIT_L(8); PG8_BAR; PG8_WAIT_L(0); PG8_MMA(0, 0, At, B0); PG8_BAR; PG8_SCHED;
            PG8_LDB(B1, 1, 1); PG8_STAGE(PG8_SB(1, 0), b3, voffB);
            PG8_BAR; PG8_WAIT_L(0); PG8_MMA(0, 1, At, B1); PG8_BAR;
            PG8_LDA(At, 1, 1); PG8_STAGE(PG8_SA(1, 0), a3, voffA);
            PG8_BAR; PG8_WAIT_L(0); PG8_MMA(1, 0, At, B0); PG8_BAR; PG8_SCHED;
            PG8_STAGE(PG8_SB(1, 1), b3 + hstep, voffB);
            PG8_WAIT_V(6); PG8_BAR; PG8_MMA(1, 1, At, B1); PG8_BAR;
            }
        }
        if constexpr (ALIGN_EPI) { if (wr == 0) PG8_BAR; }
        if constexpr (!Epi::AFTER_DRAIN) { E(acc, cur, wr, wc, fr, fq); S.done(cur); }
        if (!has_next) break;
#pragma unroll
        for (int a = 0; a < 2; ++a)
#pragma unroll
            for (int b = 0; b < 2; ++b)
#pragma unroll
                for (int m = 0; m < 4; ++m)
#pragma unroll
                    for (int n = 0; n < 2; ++n) acc[a][b][m][n] = (f32x4){0.f, 0.f, 0.f, 0.f};
        cur = nxt; cA = nA; cB = nB; ++ui;
        if constexpr (ALIGN_EPI) { if (wr == 1) PG8_BAR; }
    }
    PG8_WAIT_V(0);
    if constexpr (!ALIGN_EPI) { if (wr == 0) PG8_BAR; }
    PG8_BAR;
    if constexpr (Epi::AFTER_DRAIN) { E.fused(acc, cur, wr, wc, fr, fq, lds, wid, lane); S.done(cur); }
#undef PG8_SA
#undef PG8_SB
#undef PG8_STAGE
#undef PG8_LDA
#undef PG8_LDB
#undef PG8_MMA
#undef PG8_WAIT_V
#undef PG8_WAIT_L
#undef PG8_BAR
#undef PG8_SCHED
}
}

constexpr int DM = 2048, NB_C = 32, S_C = 256, NB_L = 4, S_L = 4096, PAST = 512, DEPTH = 4;
constexpr int M_C = NB_C * S_C;
constexpr int M_L = NB_L * S_L;
constexpr int MTOK = M_C + M_L;
constexpr int SKV_L = PAST + S_L;
constexpr int MKEY = M_C + NB_L * SKV_L;
constexpr int DIN = 4416, NPROJ = 4608;
constexpr int DFF = 5632, NUP = 2 * DFF;
constexpr int LRU_W = 1024;
constexpr int C_QA = 0, C_KA = 512, C_VA = 768, C_XR = 1024, C_GR = 2048, C_QM = 3072, C_CKV = 3840, C_KR = 4352;
constexpr float NORM_EPS = 1e-6f;
constexpr size_t O_Y = 0, O_K = 50331648, O_V = 58720256, O_CKV = 67108864, O_KR = 83886080, O_ST = 85983232, O_END = 86245376;
enum { I_XP = 0, I_XS, I_CK, I_CV, I_CCKV, I_CKR, I_ST, I_C, I_CCTX, I_WMOD, I_BMOD, I_GPM, I_GPOM, I_GPF, I_GPOF, I_WIN, I_GQ, I_GK, I_LCW, I_LCB, I_LWA, I_LBA, I_LWX, I_LBX, I_LLAM, I_GKV, I_WUK, I_WUV, I_WOUT, I_WUP, I_FCW, I_FCB, I_WDN, N_IN };

constexpr size_t MiB = 1u << 20;
constexpr size_t WS_CTL = 0, CTL_ZERO_BYTES = 2 * MiB;
constexpr size_t WS_MOD = 1 * MiB;
constexpr size_t WS_ROPE = 2 * MiB;
constexpr size_t WS_WIN = 3 * MiB, WS_WOUT = 75 * MiB, WS_WUP = 107 * MiB, WS_WDN = 283 * MiB, WS_WKV = 371 * MiB, WS_WG = 375 * MiB;
constexpr size_t WS_H = 379 * MiB, WS_KAL = 475 * MiB, WS_VAL = 484 * MiB, WS_KAC = 493 * MiB, WS_VAC = 497 * MiB, WS_CKV = 501 * MiB, WS_KR = 527 * MiB;
constexpr size_t WS_R1 = 531 * MiB;
constexpr size_t WS_PROJ = WS_R1, WS_QA = WS_R1 + 216 * MiB, WS_QM = WS_R1 + 240 * MiB, WS_XC = WS_R1 + 276 * MiB, WS_AU = WS_R1 + 324 * MiB, WS_HF = WS_R1 + 708 * MiB,
                 WS_KVM = WS_R1 + 804 * MiB, WS_MIX = WS_R1 + 856 * MiB, WS_SUMM = WS_R1 + 952 * MiB;
constexpr size_t WS_MODP = WS_AU;
constexpr size_t WS_MO = WS_R1;
constexpr size_t WS_U = WS_R1, WS_ACT = WS_R1 + 528 * MiB;
constexpr size_t WS_DBG = WS_R1 + 953 * MiB;
constexpr size_t WS_END = WS_DBG + 8 * MiB;
static_assert(WS_ACT + (size_t)MTOK * DFF * 2 <= WS_DBG && WS_SUMM + MiB <= WS_DBG, "ws map");
constexpr int CW_TMO = 0, CW_CODE = 1, CW_BAR = 4096, CW_CHK = 65536;

constexpr int RING_BYTES = 143360, LDSCTL_OFF = RING_BYTES, MISC_OFF = LDSCTL_OFF + 320, LDS_BYTES = 147456;
static_assert(MISC_OFF + 128 <= LDS_BYTES, "LDS map");
constexpr int NWAVES = 8, NTHREADS = 512;

#define GAS __attribute__((address_space(1)))
#define LAS __attribute__((address_space(3)))
typedef unsigned short bf16;
typedef unsigned v4u __attribute__((ext_vector_type(4)));
typedef float f32x4 __attribute__((ext_vector_type(4)));
typedef short bf16x8 __attribute__((ext_vector_type(8)));
typedef float f32x16 __attribute__((ext_vector_type(16)));
typedef short s16x4 __attribute__((ext_vector_type(4)));
#define LDS_WAIT() asm volatile("s_waitcnt lgkmcnt(0)" ::: "memory")
#define VM_WAIT() asm volatile("s_waitcnt vmcnt(0)" ::: "memory")
__device__ __forceinline__ unsigned f2bf(float f) { unsigned u = __builtin_bit_cast(unsigned, f); return (u + 0x7fffu + ((u >> 16) & 1u)) >> 16; }
__device__ __forceinline__ unsigned pk2(float lo, float hi) { return f2bf(lo) | (f2bf(hi) << 16); }
__device__ __forceinline__ float bf2f(unsigned short b) { return __builtin_bit_cast(float, (unsigned)b << 16); }
__device__ __forceinline__ void ld8bf(const bf16* p, float (&x)[8]) { const v4u w = *(const v4u*)p;
    x[0] = __builtin_bit_cast(float, w.x << 16); x[1] = __builtin_bit_cast(float, w.x & 0xffff0000u); x[2] = __builtin_bit_cast(float, w.y << 16); x[3] = __builtin_bit_cast(float, w.y & 0xffff0000u);
    x[4] = __builtin_bit_cast(float, w.z << 16); x[5] = __builtin_bit_cast(float, w.z & 0xffff0000u); x[6] = __builtin_bit_cast(float, w.w << 16); x[7] = __builtin_bit_cast(float, w.w & 0xffff0000u); }
__device__ __forceinline__ void st8bf(bf16* p, const float (&x)[8]) { v4u w; w.x = pk2(x[0], x[1]); w.y = pk2(x[2], x[3]); w.z = pk2(x[4], x[5]); w.w = pk2(x[6], x[7]); *(v4u*)p = w; }
__device__ __forceinline__ void ld8f(const float* p, float (&x)[8]) { const f32x4 a = *(const f32x4*)p, b = *(const f32x4*)(p + 4); x[0] = a.x; x[1] = a.y; x[2] = a.z; x[3] = a.w; x[4] = b.x; x[5] = b.y; x[6] = b.z; x[7] = b.w; }
__device__ __forceinline__ void st8f(float* p, const float (&x)[8]) { *(f32x4*)p = (f32x4){x[0], x[1], x[2], x[3]}; *(f32x4*)(p + 4) = (f32x4){x[4], x[5], x[6], x[7]}; }
__device__ __forceinline__ float wave_sum(float v) {
#pragma unroll
    for (int o = 1; o < 64; o <<= 1) v += __shfl_xor(v, o);
    return v;
}
__device__ __forceinline__ float sigmoidf_(float x) { return __builtin_amdgcn_rcpf(1.0f + __expf(-x)); }
__device__ __forceinline__ float siluf_(float x) { return x * sigmoidf_(x); }
__device__ __forceinline__ float gelu_tanh(float x) { const float z = 0.7978845608028654f * (x + 0.044715f * x * x * x); const float t = 1.0f - 2.0f * __builtin_amdgcn_rcpf(__expf(2.0f * z) + 1.0f); return 0.5f * x * (1.0f + t); }

#define XB_TMO      128
#define XB_XCNT(j)  (256  + 64 * (j))
#define XB_XSUB(j)  (1280 + 64 * (j))
#define XB_XGEN(j)  (2304 + 64 * (j))
#define XB_TOP      3328
#define XB_TOPGEN   3392
#define XCD_BAR_WORDS 3456
#define XB_SPIN_CAP (1u << 18)

__device__ __forceinline__ unsigned xb_ld(unsigned* p)              { return __hip_atomic_load(p, __ATOMIC_RELAXED, __HIP_MEMORY_SCOPE_AGENT); }
__device__ __forceinline__ unsigned xb_add(unsigned* p, unsigned v) { return __hip_atomic_fetch_add(p, v, __ATOMIC_RELAXED, __HIP_MEMORY_SCOPE_AGENT); }
__device__ __forceinline__ unsigned xb_xcc_id() { return (unsigned)__builtin_amdgcn_s_getreg((3 << 11) | 20) & 0xFu; }
#define XB_SPIN(cond, bar) do { unsigned _sp = 0; while (cond) { __builtin_amdgcn_s_sleep(1); \
    if ((++_sp & 255u) == 0u) { if (xb_ld(&(bar)[XB_TMO])) break; if (_sp > XB_SPIN_CAP) { atomicAdd(&(bar)[XB_TMO], 1u); break; } } } } while (0)

struct XcdBarrier {
    unsigned* bar; unsigned x;
    volatile LAS unsigned* st;
};

__device__ __forceinline__ XcdBarrier xcd_barrier_post(unsigned* bar, volatile LAS unsigned* st) {
    XcdBarrier b; b.bar = bar; b.x = xb_xcc_id(); b.st = st;
    if (threadIdx.x == 0) (void)xb_add(&bar[XB_XCNT(b.x)], 1u);
    return b;
}
__device__ __forceinline__ void xcd_barrier_complete(unsigned* bar, unsigned x, unsigned& nloc, unsigned& nx) {
    const unsigned G = gridDim.x * gridDim.y * gridDim.z;
    unsigned sum, cnt, mine, sp = 0u;
    for (;;) {
        sum = 0u; cnt = 0u; mine = 0u;
#pragma unroll
        for (unsigned j = 0; j < 16; ++j) { const unsigned c = xb_ld(&bar[XB_XCNT(j)]); sum += c; cnt += (c > 0u) ? 1u : 0u; mine = (j == x) ? c : mine; }
        if (sum == G) break;
        __builtin_amdgcn_s_sleep(1);
        if ((++sp & 255u) == 0u) { if (xb_ld(&bar[XB_TMO])) break; if (sp > XB_SPIN_CAP) { atomicAdd(&bar[XB_TMO], 1u); break; } }
    }
    nloc = mine > 0u ? mine : 1u; nx = cnt > 0u ? cnt : 1u;
}

__device__ __forceinline__ void xcd_barrier(const XcdBarrier& b) {
    asm volatile("s_waitcnt vmcnt(0)" ::: "memory");
    __syncthreads();
    if (threadIdx.x == 0) {
        unsigned* bar = b.bar;
        __builtin_amdgcn_s_waitcnt(0);
        unsigned nloc = b.st[0], nx = b.st[1];
        if (nloc == 0u) { xcd_barrier_complete(bar, b.x, nloc, nx); b.st[0] = nloc; b.st[1] = nx; }
        const unsigned old = xb_add(&bar[XB_XSUB(b.x)], 1u);
        const unsigned gen = old / nloc;
        if (old + 1u == (gen + 1u) * nloc) {
            __builtin_amdgcn_fence(__ATOMIC_RELEASE, "agent");
            asm volatile("s_waitcnt vmcnt(0)" ::: "memory");
            const unsigned og = xb_add(&bar[XB_TOP], 1u);
            const unsigned tg = og / nx;
            if (og + 1u == (tg + 1u) * nx) xb_add(&bar[XB_TOPGEN], 1u);
            else XB_SPIN(xb_ld(&bar[XB_TOPGEN]) == tg, bar);
            __builtin_amdgcn_fence(__ATOMIC_ACQUIRE, "agent");
            xb_add(&bar[XB_XGEN(b.x)], 1u);
            asm volatile("s_waitcnt vmcnt(0)" ::: "memory");
        } else {
            XB_SPIN(xb_ld(&bar[XB_XGEN(b.x)]) == gen, bar);
            __builtin_amdgcn_fence(__ATOMIC_ACQUIRE, "agent");
            asm volatile("s_waitcnt vmcnt(0)" ::: "memory");
        }
    }
    __syncthreads();
}

namespace att {
typedef __attribute__((ext_vector_type(4))) unsigned u32x4;
constexpr int NW = 8, QBLK = 32, KVBLK = 64;
constexpr int SHM_V = KVBLK * 128 * 2, SHM_K = KVBLK * 128 * 2, SHM_KR = KVBLK * 64 * 2;
constexpr int OFF_V = 0, OFF_K = 2 * SHM_V, OFF_KR = OFF_K + 2 * SHM_K, OFF_WS = OFF_KR + 2 * SHM_KR, OFF_QR = OFF_WS + NW * 64 * 4;
template <int QL> constexpr int lds_attn() { return OFF_QR + NW * QL * 1024; }
#define KSWZ(row, colB) ((row) * 256 + ((colB) ^ (((row) & 7) << 4)))
#define KRSWZ(row, colB) ((row) * 128 + ((colB) ^ (((row) & 7) << 4)))
#define SBAR() __builtin_amdgcn_sched_barrier(0)
constexpr float THR = 8.f;
__device__ __forceinline__ int crow(int r, int hi) { return (r & 3) + 8 * (r >> 2) + 4 * hi; }
__device__ __forceinline__ unsigned cvtpk(float lo, float hi) { unsigned r; asm volatile("v_cvt_pk_bf16_f32 %0, %1, %2" : "=v"(r) : "v"(lo), "v"(hi)); return r; }

template <int DQK> __device__ __forceinline__ void partialSM(f32x16& p0, f32x16& p1, float& m_reg, float& mn, float& alpha) {
  constexpr float SCALE = (DQK == 128) ? 0.088388347648318440f : 0.072168783648703220f;
  constexpr float C = SCALE * 1.4426950408889634f;
  float pmax = p0[0];
#pragma unroll
  for (int r = 1; r < 16; ++r) pmax = fmaxf(pmax, p0[r]);
#pragma unroll
  for (int r = 0; r < 16; ++r) pmax = fmaxf(pmax, p1[r]);
  { auto rr = __builtin_amdgcn_permlane32_swap(__float_as_uint(pmax), __float_as_uint(pmax), false, false);
    pmax = fmaxf(__uint_as_float(rr[0]), __uint_as_float(rr[1])); }
  if (__builtin_expect(__all(pmax - m_reg <= THR / SCALE), 1)) { mn = m_reg; alpha = 1.f; }
  else { mn = fmaxf(m_reg, pmax); alpha = __builtin_amdgcn_exp2f((m_reg - mn) * C); m_reg = mn; }
  float mnC = -mn * C;
#pragma unroll
  for (int r = 0; r < 16; ++r) p0[r] = fmaf(p0[r], C, mnC);
#pragma unroll
  for (int r = 0; r < 16; ++r) p1[r] = fmaf(p1[r], C, mnC);
#pragma unroll
  for (int r = 0; r < 16; ++r) p0[r] = __builtin_amdgcn_exp2f(p0[r]);
}
__device__ __forceinline__ void finishSM(f32x16& p0, f32x16& p1, float alpha, float& l_reg, bf16x8& pa0, bf16x8& pa1, bf16x8& pa2, bf16x8& pa3) {
#pragma unroll
  for (int r = 0; r < 16; ++r) p1[r] = __builtin_amdgcn_exp2f(p1[r]);
  float ps = 0;
#pragma unroll
  for (int r = 0; r < 16; ++r) ps += p0[r];
#pragma unroll
  for (int r = 0; r < 16; ++r) ps += p1[r];
  { auto rr = __builtin_amdgcn_permlane32_swap(__float_as_uint(ps), __float_as_uint(ps), false, false);
    ps = __uint_as_float(rr[0]) + __uint_as_float(rr[1]); }
  l_reg = l_reg * alpha + ps;
#define PK4(P, BASE, OUT) do { unsigned a0 = cvtpk(P[BASE + 0], P[BASE + 1]), a1 = cvtpk(P[BASE + 2], P[BASE + 3]);   \
    unsigned b0 = cvtpk(P[BASE + 4], P[BASE + 5]), b1 = cvtpk(P[BASE + 6], P[BASE + 7]);                              \
    auto r0 = __builtin_amdgcn_permlane32_swap(a0, b0, false, false); auto r1 = __builtin_amdgcn_permlane32_swap(a1, b1, false, false); \
    u32x4 w = {r0[0], r1[0], r0[1], r1[1]}; OUT = *reinterpret_cast<bf16x8*>(&w); } while (0)
  PK4(p0, 0, pa0); PK4(p0, 8, pa1); PK4(p1, 0, pa2); PK4(p1, 8, pa3);
#undef PK4
}
template <int DR, int NQR> __device__ __forceinline__ void qkt(f32x16& p0, f32x16& p1, const char* Ks, const char* KRs, const bf16x8* qr, const char* qrl, int r32, int hi) {
  p0 = f32x16{}; p1 = f32x16{};
#pragma unroll
  for (int d0 = 0; d0 < 8; ++d0) { int cb = (d0 * 16 + hi * 8) * 2;
    bf16x8 b0 = *reinterpret_cast<const bf16x8*>(Ks + KSWZ(r32, cb));
    bf16x8 b1 = *reinterpret_cast<const bf16x8*>(Ks + KSWZ(32 + r32, cb));
    bf16x8 qf; if constexpr (true) { if (d0 < NQR) qf = qr[d0]; else qf = *reinterpret_cast<const bf16x8*>(qrl + (d0 - NQR) * 1024); }
    p0 = __builtin_amdgcn_mfma_f32_32x32x16_bf16(b0, qf, p0, 0, 0, 0);
    p1 = __builtin_amdgcn_mfma_f32_32x32x16_bf16(b1, qf, p1, 0, 0, 0); }
  if constexpr (DR > 0) {
#pragma unroll
    for (int d0 = 0; d0 < DR / 16; ++d0) { int cb = (d0 * 16 + hi * 8) * 2;
      bf16x8 b0 = *reinterpret_cast<const bf16x8*>(KRs + KRSWZ(r32, cb));
      bf16x8 b1 = *reinterpret_cast<const bf16x8*>(KRs + KRSWZ(32 + r32, cb));
      const bf16x8 qf = *reinterpret_cast<const bf16x8*>(qrl + (8 - NQR + d0) * 1024);
      p0 = __builtin_amdgcn_mfma_f32_32x32x16_bf16(b0, qf, p0, 0, 0, 0);
      p1 = __builtin_amdgcn_mfma_f32_32x32x16_bf16(b1, qf, p1, 0, 0, 0); }
  }
}
__device__ __forceinline__ int v_st(int k, int c) { const int kk = (k & ~0xC) | ((k & 4) << 1) | ((k & 8) >> 1); return ((kk >> 3) * 4 + (c >> 5)) * 512 + ((kk & 7) * 32 + (c & 31)) * 2; }
__device__ __forceinline__ int v_rd_base(int lane) { return ((lane & 3) << 3) | (((lane >> 2) & 3) << 6) | (((lane >> 4) & 1) << 5) | (((lane >> 5) & 1) << 8); }
constexpr int v_rd_off(int d0, int ks, int half) { return d0 * 512 + ks * 4096 + half * 2048; }
template <int OFF> __device__ __forceinline__ s16x4 tr_read(int vb) {
  s16x4 r; asm volatile("ds_read_b64_tr_b16 %0, %1 offset:%2" : "=&v"(r) : "v"(vb), "i"(OFF) : "memory"); return r;
}
template <int D0> __device__ __forceinline__ void pv_one(f32x16& od, int vb, bf16x8 pa0, bf16x8 pa1, bf16x8 pa2, bf16x8 pa3) {
  const s16x4 l0 = tr_read<v_rd_off(D0, 0, 0)>(vb), h0 = tr_read<v_rd_off(D0, 0, 1)>(vb), l1 = tr_read<v_rd_off(D0, 1, 0)>(vb), h1 = tr_read<v_rd_off(D0, 1, 1)>(vb);
  const s16x4 l2 = tr_read<v_rd_off(D0, 2, 0)>(vb), h2 = tr_read<v_rd_off(D0, 2, 1)>(vb), l3 = tr_read<v_rd_off(D0, 3, 0)>(vb), h3 = tr_read<v_rd_off(D0, 3, 1)>(vb);
  asm volatile("s_waitcnt lgkmcnt(0)" ::: "memory"); SBAR();
#define PK(L, H) (bf16x8){L[0], L[1], L[2], L[3], H[0], H[1], H[2], H[3]}
  od = __builtin_amdgcn_mfma_f32_32x32x16_bf16(pa0, PK(l0, h0), od, 0, 0, 0);
  od = __builtin_amdgcn_mfma_f32_32x32x16_bf16(pa1, PK(l1, h1), od, 0, 0, 0);
  od = __builtin_amdgcn_mfma_f32_32x32x16_bf16(pa2, PK(l2, h2), od, 0, 0, 0);
  od = __builtin_amdgcn_mfma_f32_32x32x16_bf16(pa3, PK(l3, h3), od, 0, 0, 0);
#undef PK
}
__device__ __forceinline__ void pv_d0(f32x16* o, int vb, bf16x8 pa0, bf16x8 pa1, bf16x8 pa2, bf16x8 pa3) {
  pv_one<0>(o[0], vb, pa0, pa1, pa2, pa3); pv_one<1>(o[1], vb, pa0, pa1, pa2, pa3); pv_one<2>(o[2], vb, pa0, pa1, pa2, pa3); pv_one<3>(o[3], vb, pa0, pa1, pa2, pa3);
}

template <int DR, int SD, int NQR, int LDQ, int LDK, int LDKR, int LDV, int LDO>
__device__ __forceinline__ void attn_body(const bf16* __restrict__ Qb, const bf16* __restrict__ Kh, const bf16* __restrict__ KRh, const bf16* __restrict__ Vh,
                                          bf16* __restrict__ Ob, int seq, char* lds) {
  constexpr int DQK = 128 + DR, NQ = NQR, QL = (8 - NQR) + DR / 16;
  static_assert(lds_attn<QL>() <= RING_BYTES, "attention LDS");
  const int tid = ltid(), wid = tid >> 6, lane = tid & 63, r32 = lane & 31, hi = lane >> 5;
  char* V_lds = lds + OFF_V; char* K_lds = lds + OFF_K; char* KR_lds = lds + OFF_KR;
  float* ws = (float*)(lds + OFF_WS) + wid * 64; float* li_l = ws; float* al_l = ws + 32;
  float m_reg = -1e30f, l_reg = 0; f32x16 o[4] = {}; bf16x8 qr[NQ];
  const bf16* Qw = Qb + (long)(wid * QBLK + r32) * LDQ + hi * 8;
#pragma unroll
  for (int d0 = 0; d0 < NQ; ++d0) qr[d0] = *reinterpret_cast<const bf16x8*>(Qw + d0 * 16);
  char* qrl = lds + OFF_QR + wid * (QL * 1024) + lane * 16;
#pragma unroll
  for (int d0 = 0; d0 < QL; ++d0) *reinterpret_cast<bf16x8*>(qrl + d0 * 1024) = *reinterpret_cast<const bf16x8*>(Qw + (NQR + d0) * 16);
  const int sr = tid >> 4, sc = (tid & 15) * 8, vst0 = v_st(sr, sc), vst1 = v_st(32 + sr, sc);
  const int rr = tid >> 3, rc = (tid & 7) * 8;
  const int vb0 = (int)(uintptr_t)V_lds + v_rd_base(lane);
  struct { bf16x8 vs0, vs1, ks0, ks1, kr; } sr_[SD];
#define SLOAD(i, k0) do { sr_[i].vs0 = *reinterpret_cast<const bf16x8*>(&Vh[(long)((k0) + sr) * LDV + sc]); sr_[i].vs1 = *reinterpret_cast<const bf16x8*>(&Vh[(long)((k0) + 32 + sr) * LDV + sc]); \
    sr_[i].ks0 = *reinterpret_cast<const bf16x8*>(&Kh[(long)((k0) + sr) * LDK + sc]); sr_[i].ks1 = *reinterpret_cast<const bf16x8*>(&Kh[(long)((k0) + 32 + sr) * LDK + sc]); \
    if constexpr (DR > 0) sr_[i].kr = *reinterpret_cast<const bf16x8*>(&KRh[(long)((k0) + rr) * LDKR + rc]); } while (0)
#define SWRITE(b, i) do { *(bf16x8*)(V_lds + (b) * SHM_V + vst0) = sr_[i].vs0;          \
    *(bf16x8*)(V_lds + (b) * SHM_V + vst1) = sr_[i].vs1; int kc = sc * 2;               \
    *(bf16x8*)(K_lds + (b) * SHM_K + KSWZ(sr, kc)) = sr_[i].ks0;                       \
    *(bf16x8*)(K_lds + (b) * SHM_K + KSWZ(32 + sr, kc)) = sr_[i].ks1;                  \
    if constexpr (DR > 0) *(bf16x8*)(KR_lds + (b) * SHM_KR + KRSWZ(rr, rc * 2)) = sr_[i].kr; } while (0)
#define SWAIT() do { if constexpr (SD == 1) asm volatile("s_waitcnt vmcnt(0)" ::: "memory"); else if constexpr (DR > 0) asm volatile("s_waitcnt vmcnt(5)" ::: "memory"); else asm volatile("s_waitcnt vmcnt(4)" ::: "memory"); } while (0)
#define RESC(a) do { if (__any((a) < 1.f)) { if (hi == 0) al_l[r32] = (a); asm volatile("s_waitcnt lgkmcnt(0)" ::: "memory"); \
    _Pragma("unroll") for (int d = 0; d < 4; ++d) _Pragma("unroll") for (int r = 0; r < 16; ++r) o[d][r] *= al_l[crow(r, hi)]; } } while (0)
  f32x16 pA0, pA1, pB0, pB1; float mnA, mnB, alA, alB; bf16x8 pa0, pa1, pa2, pa3; const int NT = seq / KVBLK;
  constexpr int SE = 0, SO = SD - 1;
  SLOAD(SE, 0); asm volatile("s_waitcnt vmcnt(0)" ::: "memory"); SWRITE(0, SE); __syncthreads();
  qkt<DR, NQR>(pA0, pA1, K_lds, KR_lds, qr, qrl, r32, hi); partialSM<DQK>(pA0, pA1, m_reg, mnA, alA);
  SLOAD(SO, KVBLK); if constexpr (SD == 2) { if (2 < NT) SLOAD(SE, 2 * KVBLK); }
  SWAIT(); SWRITE(1, SO); __syncthreads();
  for (int j = 1; j + 1 < NT; j += 2) {
    SBAR(); qkt<DR, NQR>(pB0, pB1, K_lds + SHM_K, KR_lds + SHM_KR, qr, qrl, r32, hi);
    finishSM(pA0, pA1, alA, l_reg, pa0, pa1, pa2, pa3); SBAR();
    SLOAD(SO, (j + SD) * KVBLK); SBAR();
    pv_d0(o, vb0, pa0, pa1, pa2, pa3); partialSM<DQK>(pB0, pB1, m_reg, mnB, alB);
    __syncthreads(); SWAIT(); SWRITE(0, SE);
    RESC(alB); __syncthreads();
    SBAR(); qkt<DR, NQR>(pA0, pA1, K_lds, KR_lds, qr, qrl, r32, hi);
    finishSM(pB0, pB1, alB, l_reg, pa0, pa1, pa2, pa3); SBAR();
    if (SD == 1 || j + 3 < NT) SLOAD(SE, (j + 1 + SD) * KVBLK); SBAR();
    pv_d0(o, vb0 + (int)SHM_V, pa0, pa1, pa2, pa3); partialSM<DQK>(pA0, pA1, m_reg, mnA, alA);
    __syncthreads(); SWAIT(); SWRITE(1, SO);
    RESC(alA); __syncthreads();
  }
  SBAR(); qkt<DR, NQR>(pB0, pB1, K_lds + SHM_K, KR_lds + SHM_KR, qr, qrl, r32, hi);
  finishSM(pA0, pA1, alA, l_reg, pa0, pa1, pa2, pa3); SBAR();
  pv_d0(o, vb0, pa0, pa1, pa2, pa3); partialSM<DQK>(pB0, pB1, m_reg, mnB, alB);
  __syncthreads(); RESC(alB);
  finishSM(pB0, pB1, alB, l_reg, pa0, pa1, pa2, pa3); SBAR();
  pv_d0(o, vb0 + (int)SHM_V, pa0, pa1, pa2, pa3);
  if (hi == 0) li_l[r32] = l_reg; asm volatile("s_waitcnt lgkmcnt(0)" ::: "memory");
  float rli[16];
#pragma unroll
  for (int r = 0; r < 16; ++r) rli[r] = __builtin_amdgcn_rcpf(li_l[crow(r, hi)]);
  bf16* Ow = Ob + (long)(wid * QBLK) * LDO;
#pragma unroll
  for (int r = 0; r < 16; ++r) { int orow = crow(r, hi);
#pragma unroll
    for (int d0 = 0; d0 < 4; ++d0) Ow[(long)orow * LDO + d0 * 32 + r32] = (bf16)f2bf(o[d0][r] * rli[r]); }
  __syncthreads();
#undef SLOAD
#undef SWRITE
#undef SWAIT
#undef RESC
}
}
#ifndef MLA_NQR
#define MLA_NQR 6
#endif
#ifndef MLA_SD
#define MLA_SD 1
#endif

struct Args { const float* in[N_IN]; float* out; unsigned char* ws; int ph_lo, ph_hi; };
constexpr int PH_PER_LAYER = 11, PH_PRE = 3, PH_TOTAL = PH_PRE + DEPTH * PH_PER_LAYER;
typedef const __attribute__((address_space(4))) Args* KArgs;
__device__ __forceinline__ KArgs launder(KArgs p) { asm volatile("" : "+s"(p)); return p; }

__device__ __forceinline__ void transpose_item(const float* W, int K, int N, bf16* WT, LAS float* scr, int item, int lane) {
    const int nblk = N / 32, kb = item / nblk, nb = item % nblk, k0 = 64 * kb, n0 = 32 * nb;
#pragma unroll 8
    for (int i = 0; i < 32; ++i) { const int kk = 2 * i + (lane >> 5); scr[kk * 33 + (lane & 31)] = W[(size_t)(k0 + kk) * N + n0 + (lane & 31)]; }
    LDS_WAIT(); asm volatile("" ::: "memory");
    const int c = lane & 7;
#pragma unroll
    for (int j = 0; j < 4; ++j) { const int n = (lane >> 3) + 8 * j; const LAS float* s = scr + (8 * c) * 33 + n;
        v4u o; o.x = pk2(s[0 * 33], s[1 * 33]); o.y = pk2(s[2 * 33], s[3 * 33]); o.z = pk2(s[4 * 33], s[5 * 33]); o.w = pk2(s[6 * 33], s[7 * 33]);
        *(v4u*)(WT + (size_t)(n0 + n) * K + k0 + 8 * c) = o; }
    LDS_WAIT(); asm volatile("" ::: "memory");
}

__device__ __forceinline__ void phase_prologue(KArgs a, char* lds, int gw, int NGW, int wave, int lane) {
    unsigned char* ws = a->ws;
    LAS float* scr = (LAS float*)(lds + wave * 16384);
    constexpr int I_IN = 32 * 138, I_OUT = 32 * 64, I_UP = 32 * 352, I_DN = 88 * 64, I_KV = 2 * 128, I_G = 256;
    constexpr int I_LAYER = I_IN + I_OUT + I_UP + I_DN + I_KV + I_G;
    for (int it = gw; it < DEPTH * I_LAYER; it += NGW) {
        const int l = it / I_LAYER; int r = it % I_LAYER;
        if (r < I_IN) { transpose_item(a->in[I_WIN] + (size_t)l * DM * DIN, DM, DIN, (bf16*)(ws + WS_WIN) + (size_t)l * NPROJ * DM, scr, r, lane); continue; } r -= I_IN;
        if (r < I_OUT) { transpose_item(a->in[I_WOUT] + (size_t)l * DM * DM, DM, DM, (bf16*)(ws + WS_WOUT) + (size_t)l * DM * DM, scr, r, lane); continue; } r -= I_OUT;
        if (r < I_UP) { transpose_item(a->in[I_WUP] + (size_t)l * DM * NUP, DM, NUP, (bf16*)(ws + WS_WUP) + (size_t)l * NUP * DM, scr, r, lane); continue; } r -= I_UP;
        if (r < I_DN) { transpose_item(a->in[I_WDN] + (size_t)l * DFF * DM, DFF, DM, (bf16*)(ws + WS_WDN) + (size_t)l * DM * DFF, scr, r, lane); continue; } r -= I_DN;
        if (r < I_KV) { const int which = r / 128;
            transpose_item(a->in[which ? I_WUV : I_WUK] + (size_t)l * 512 * 512, 512, 512, (bf16*)(ws + WS_WKV) + (size_t)l * 1024 * 512 + (size_t)which * 512 * 512, scr, r % 128, lane); continue; } r -= I_KV;
        { const int mat = r / 8, sub = r % 8;
          const int ty = mat & 1, dir = (mat >> 1) & 1, n = mat >> 2;
          const float* src = a->in[ty ? I_LWX : I_LWA] + ((size_t)((l * 2 + dir) * 8 + n)) * 128 * 128;
          transpose_item(src, 128, 128, (bf16*)(ws + WS_WG) + (size_t)l * 32 * 16384 + (size_t)mat * 16384, scr, sub, lane); }
    }
    { const int gt = gw * 64 + lane, NT = NGW * 64; constexpr int PER = (NPROJ - DIN) * DM / 8;
      for (int i = gt; i < DEPTH * PER; i += NT) { const int l = i / PER, j = i % PER; *((v4u*)((bf16*)(ws + WS_WIN) + (size_t)l * NPROJ * DM + (size_t)DIN * DM) + j) = (v4u){0u, 0u, 0u, 0u}; } }
    { float* MODP = (float*)(ws + WS_MODP);
      for (int it = gw; it < DEPTH * 32 * 48; it += NGW) {
        const int l = it / (32 * 48), kc = (it / 48) % 32, jb = it % 48, j = jb * 256 + 4 * lane, k = kc * 64 + lane;
        float cv[5];
#pragma unroll
        for (int cr = 0; cr < 4; ++cr) cv[cr] = siluf_(a->in[I_C][cr * DM + k]);
        cv[4] = siluf_(a->in[I_CCTX][k]);
        f32x4 acc[5];
#pragma unroll
        for (int cr = 0; cr < 5; ++cr) acc[cr] = (f32x4){0.f, 0.f, 0.f, 0.f};
        const float* wp = a->in[I_WMOD] + ((size_t)l * DM + (size_t)kc * 64) * 12288 + j;
#pragma unroll 4
        for (int kk = 0; kk < 64; ++kk) { const f32x4 w = *(const f32x4*)(wp + (size_t)kk * 12288);
#pragma unroll
            for (int cr = 0; cr < 5; ++cr) { const float s = __shfl(cv[cr], kk); acc[cr] += w * s; } }
        if (kc == 0) { const f32x4 b = *(const f32x4*)(a->in[I_BMOD] + (size_t)l * 12288 + j);
#pragma unroll
            for (int cr = 0; cr < 5; ++cr) acc[cr] += b; }
#pragma unroll
        for (int cr = 0; cr < 5; ++cr) *(f32x4*)(MODP + (((size_t)(l * 32 + kc) * 5 + cr)) * 12288 + j) = acc[cr];
      } }
    { const int gt = gw * 64 + lane;
      if (gt < 64 * 32 + 64 * 16) { const bool big = gt < 2048; const int e = big ? gt : gt - 2048, nf = big ? 32 : 16, pos = e / nf, f = e % nf;
        const float inv = exp2f(-(float)f / (float)nf * 13.287712379549449f);
        const float ang = (float)pos * inv;
        double rev = (double)ang * 0.15915494309189535; rev -= floor(rev);
        const float rf = (float)rev; const float sn = __builtin_amdgcn_sinf(rf), cs = __builtin_amdgcn_cosf(rf);
        float2* tab = (float2*)(ws + WS_ROPE + (big ? 0 : 32768)); tab[e] = make_float2(cs, sn); } }
}

__device__ __forceinline__ void phase_mod_reduce(KArgs a, int gtid, int NTHR) {
    const float* MODP = (const float*)(a->ws + WS_MODP); float* MOD = (float*)(a->ws + WS_MOD);
    for (int i = gtid; i < DEPTH * 5 * 12288 / 4; i += NTHR) { const int l = i / (5 * 3072), rem = i % (5 * 3072);
        f32x4 s = (f32x4){0.f, 0.f, 0.f, 0.f};
#pragma unroll 8
        for (int kc = 0; kc < 32; ++kc) s += *((const f32x4*)(MODP + ((size_t)(l * 32 + kc) * 5) * 12288) + rem);
        *((f32x4*)(MOD + (size_t)l * 5 * 12288) + rem) = s; }
}

__device__ __forceinline__ void row_update(const float* xsrc, const float* msrc, float* xdst, const float* g_post, const float* gate,
                                           const float* g_pre, const float* sc, const float* sh, bf16* hdst, int lane) {
    f32x4 x[8];
#pragma unroll
    for (int j = 0; j < 8; ++j) x[j] = *((const f32x4*)xsrc + lane + 64 * j);
    if (msrc) {
        f32x4 m[8]; float ss = 0.f;
#pragma unroll
        for (int j = 0; j < 8; ++j) { m[j] = *((const f32x4*)msrc + lane + 64 * j); ss += (m[j].x * m[j].x + m[j].y * m[j].y) + (m[j].z * m[j].z + m[j].w * m[j].w); }
        const float rs = rsqrtf(wave_sum(ss) * (1.0f / DM) + NORM_EPS);
#pragma unroll
        for (int j = 0; j < 8; ++j) { const f32x4 g = *((const f32x4*)g_post + lane + 64 * j), gt = *((const f32x4*)gate + lane + 64 * j); x[j] = x[j] + gt * (m[j] * rs * g); }
    }
    if (xdst) {
#pragma unroll
        for (int j = 0; j < 8; ++j) *((f32x4*)xdst + lane + 64 * j) = x[j];
    }
    if (hdst) {
        float ss = 0.f;
#pragma unroll
        for (int j = 0; j < 8; ++j) ss += (x[j].x * x[j].x + x[j].y * x[j].y) + (x[j].z * x[j].z + x[j].w * x[j].w);
        const float rs = rsqrtf(wave_sum(ss) * (1.0f / DM) + NORM_EPS);
#pragma unroll
        for (int j = 0; j < 8; ++j) { const f32x4 g = *((const f32x4*)g_pre + lane + 64 * j), s1 = *((const f32x4*)sc + lane + 64 * j), s0 = *((const f32x4*)sh + lane + 64 * j);
            const f32x4 h = x[j] * rs * g * (1.0f + s1) + s0;
            *((unsigned long long*)hdst + lane + 64 * j) = (unsigned long long)pk2(h.x, h.y) | ((unsigned long long)pk2(h.z, h.w) << 32); }
    }
}
__device__ __forceinline__ int cond_row(int r) { return r < M_C ? 4 : (r - M_C) / S_L; }
__device__ __forceinline__ const float* mod_ptr(KArgs a, int l, int cr, int which) { return (const float*)(a->ws + WS_MOD) + ((size_t)(l * 5 + cr) * 6 + which) * DM; }

__device__ __forceinline__ void phase_first_norm(KArgs a, int gw, int NGW, int lane) {
    for (int r = gw; r < MTOK; r += NGW) {
        const float* xs = r < M_C ? a->in[I_XP] + (size_t)r * DM : a->in[I_XS] + (size_t)(r - M_C) * DM; const int cr = cond_row(r);
        row_update(xs, nullptr, a->out + (size_t)r * DM, nullptr, nullptr, a->in[I_GPM], mod_ptr(a, 0, cr, 1), mod_ptr(a, 0, cr, 0), (bf16*)(a->ws + WS_H) + (size_t)r * DM, lane);
    }
}
__device__ __forceinline__ void phase_residual(KArgs a, int l, int which, int gw, int NGW, int lane) {
    const float* MO = (const float*)(a->ws + WS_MO);
    for (int r = gw; r < MTOK; r += NGW) {
        const int cr = cond_row(r); float* xr = a->out + (size_t)r * DM; bf16* hr = (bf16*)(a->ws + WS_H) + (size_t)r * DM;
        if (which == 0) row_update(xr, MO + (size_t)r * DM, xr, a->in[I_GPOM] + l * DM, mod_ptr(a, l, cr, 2), a->in[I_GPF] + l * DM, mod_ptr(a, l, cr, 4), mod_ptr(a, l, cr, 3), hr, lane);
        else if (l + 1 < DEPTH) row_update(xr, MO + (size_t)r * DM, xr, a->in[I_GPOF] + l * DM, mod_ptr(a, l, cr, 5), a->in[I_GPM] + (l + 1) * DM, mod_ptr(a, l + 1, cr, 1), mod_ptr(a, l + 1, cr, 0), hr, lane);
        else row_update(xr, MO + (size_t)r * DM, xr, a->in[I_GPOF] + l * DM, mod_ptr(a, l, cr, 5), nullptr, nullptr, nullptr, nullptr, lane);
    }
}

__device__ __forceinline__ void rope8(float (&y)[8], int pxor, bool first, const float2* tab) {
#pragma unroll
    for (int i = 0; i < 8; ++i) { const float yp = __shfl_xor(y[i], pxor); const float2 cs = tab[i]; y[i] = first ? y[i] * cs.x - yp * cs.y : y[i] * cs.x + yp * cs.y; }
}

__device__ __forceinline__ void phase_postproj(KArgs a, int l, int gw, int NGW, int lane) {
    unsigned char* ws = a->ws;
    const bf16* PROJ = (const bf16*)(ws + WS_PROJ);
    const float2* R128 = (const float2*)(ws + WS_ROPE); const float2* R64 = (const float2*)(ws + WS_ROPE + 32768);
    bf16* QA = (bf16*)(ws + WS_QA); bf16* QM = (bf16*)(ws + WS_QM); bf16* XC = (bf16*)(ws + WS_XC);
    bf16* KAL = (bf16*)(ws + WS_KAL); bf16* VAL = (bf16*)(ws + WS_VAL); bf16* KAC = (bf16*)(ws + WS_KAC); bf16* VAC = (bf16*)(ws + WS_VAC);
    bf16* CKV = (bf16*)(ws + WS_CKV); bf16* KR = (bf16*)(ws + WS_KR);
    for (int job = gw; job < MTOK + NB_L * PAST; job += NGW) {
        if (job >= MTOK) {
            const int cb = (job - MTOK) / PAST, p = (job - MTOK) % PAST; float x[8];
            const size_t crow_ = ((size_t)(cb * DEPTH + l) * PAST + p);
            if (lane < 32) { ld8f(a->in[I_CK] + crow_ * 256 + 8 * lane, x); st8bf(KAL + ((size_t)cb * SKV_L + p) * 256 + 8 * lane, x);
                             ld8f(a->in[I_CV] + crow_ * 256 + 8 * lane, x); st8bf(VAL + ((size_t)cb * SKV_L + p) * 256 + 8 * lane, x); }
            const size_t krow = (size_t)M_C + (size_t)cb * SKV_L + p;
            ld8f(a->in[I_CCKV] + crow_ * 512 + 8 * lane, x); st8bf(CKV + krow * 512 + 8 * lane, x);
            if (lane < 8) { ld8f(a->in[I_CKR] + crow_ * 64 + 8 * lane, x); st8bf(KR + krow * 64 + 8 * lane, x); }
            continue;
        }
        const int r = job; const bool lat = r >= M_C;
        const int b = lat ? (r - M_C) / S_L : r / S_C, t = lat ? (r - M_C) % S_L : r % S_C, slen = lat ? S_L : S_C;
        const int prow = t >> 6, pcol = t & 63;
        const bf16* pr = PROJ + (size_t)r * NPROJ;
        const size_t krow = lat ? (size_t)M_C + (size_t)b * SKV_L + PAST + t : (size_t)r;
        const size_t orow = ((size_t)(b * DEPTH + l) * S_C + t);
        float x[8];
        { ld8bf(pr + C_QA + 8 * lane, x); float ss = 0.f;
#pragma unroll
          for (int i = 0; i < 8; ++i) ss += x[i] * x[i];
          ss += __shfl_xor(ss, 1); ss += __shfl_xor(ss, 2); ss += __shfl_xor(ss, 4); ss += __shfl_xor(ss, 8);
          const float rs = rsqrtf(ss * (1.0f / 128.0f) + NORM_EPS); float g[8]; ld8f(a->in[I_GQ] + l * 128 + 8 * (lane & 15), g);
#pragma unroll
          for (int i = 0; i < 8; ++i) x[i] = x[i] * rs * g[i];
          if (lat) { const int s = lane & 15; rope8(x, 4, (s & 7) < 4, R128 + ((s >> 3) ? pcol : prow) * 32 + 8 * (s & 3)); }
          st8bf(QA + (size_t)r * 512 + 8 * lane, x); }
        { ld8bf(pr + C_KA + 8 * lane, x); float ss = 0.f;
#pragma unroll
          for (int i = 0; i < 8; ++i) ss += x[i] * x[i];
          ss += __shfl_xor(ss, 1); ss += __shfl_xor(ss, 2); ss += __shfl_xor(ss, 4); ss += __shfl_xor(ss, 8);
          const float rs = rsqrtf(ss * (1.0f / 128.0f) + NORM_EPS); float g[8]; ld8f(a->in[I_GK] + l * 128 + 8 * (lane & 15), g);
          float y[8];
#pragma unroll
          for (int i = 0; i < 8; ++i) y[i] = x[i] * rs * g[i];
          if (lat) { const int s = lane & 15; rope8(y, 4, (s & 7) < 4, R128 + ((s >> 3) ? pcol : prow) * 32 + 8 * (s & 3)); }
          if (lane < 32) {
              if (lat) st8bf(KAL + ((size_t)b * SKV_L + PAST + t) * 256 + 8 * lane, y);
              else { st8bf(KAC + (size_t)r * 256 + 8 * lane, y); st8f(a->out + O_K + orow * 256 + 8 * lane, y); }
          } else { const int c = 8 * (lane - 32);
              if (lat) st8bf(VAL + ((size_t)b * SKV_L + PAST + t) * 256 + c, x);
              else { st8bf(VAC + (size_t)r * 256 + c, x); st8f(a->out + O_V + orow * 256 + c, x); }
          } }
#pragma unroll
        for (int k = 0; k < 2; ++k) { const int c = 8 * lane + 512 * k; float acc[8]; ld8f(a->in[I_LCB] + l * LRU_W + c, acc);
#pragma unroll
          for (int j = 0; j < 4; ++j) { const int tt = t + j - 1; if (tt >= 0 && tt < slen) { float xv[8], w[8]; ld8bf(pr + (ptrdiff_t)(j - 1) * NPROJ + C_XR + c, xv); ld8f(a->in[I_LCW] + ((size_t)l * 4 + j) * LRU_W + c, w);
#pragma unroll
              for (int i = 0; i < 8; ++i) acc[i] += w[i] * xv[i]; } }
          st8bf(XC + (size_t)r * LRU_W + c, acc); }
#pragma unroll
        for (int ps = 0; ps < 2; ++ps) { const int s = 64 * ps + lane; const bool act = (ps == 0) || lane < 32; const int s24 = s % 24;
#pragma unroll
          for (int i = 0; i < 8; ++i) x[i] = 0.f;
          if (act) ld8bf(pr + C_QM + 8 * s, x);
          if (lat) { float y[8];
#pragma unroll
              for (int i = 0; i < 8; ++i) y[i] = x[i];
              const int sr = (s24 - 16) & 7; rope8(y, 2, (sr & 3) < 2, R64 + ((sr >> 2) ? pcol : prow) * 16 + 8 * (sr & 1));
              if (s24 >= 16) {
#pragma unroll
                  for (int i = 0; i < 8; ++i) x[i] = y[i]; } }
          if (act) st8bf(QM + (size_t)r * 768 + 8 * s, x); }
        { ld8bf(pr + C_CKV + 8 * lane, x); float ss = 0.f;
#pragma unroll
          for (int i = 0; i < 8; ++i) ss += x[i] * x[i];
          const float rs = rsqrtf(wave_sum(ss) * (1.0f / 512.0f) + NORM_EPS); float g[8]; ld8f(a->in[I_GKV] + l * 512 + 8 * lane, g);
#pragma unroll
          for (int i = 0; i < 8; ++i) x[i] = x[i] * rs * g[i];
          st8bf(CKV + krow * 512 + 8 * lane, x); if (!lat) st8f(a->out + O_CKV + orow * 512 + 8 * lane, x); }
        { const int ll = lane & 7; ld8bf(pr + C_KR + 8 * ll, x);
          if (lat) rope8(x, 2, (ll & 3) < 2, R64 + ((ll >> 2) ? pcol : prow) * 16 + 8 * (ll & 1));
          if (lane < 8) { st8bf(KR + krow * 64 + 8 * lane, x); if (!lat) st8f(a->out + O_KR + orow * 64 + 8 * lane, x); } }
    }
}

__device__ __forceinline__ void phase_lru_gates(KArgs a, int l, int gw, int NGW, int lane) {
    unsigned char* ws = a->ws; const bf16* XC = (const bf16*)(ws + WS_XC); const bf16* WG = (const bf16*)(ws + WS_WG) + (size_t)l * 32 * 16384;
    float* AB = (float*)(ws + WS_AU);
    const int r32 = lane & 31, hi = lane >> 5;
    for (int u = gw; u < 16 * (MTOK / 32); u += NGW) {
        const int nd = u / (MTOK / 32), rb = u % (MTOK / 32), n = nd >> 1, dir = nd & 1;
        bf16x8 af[8];
        const bf16* ap = XC + (size_t)(rb * 32 + r32) * LRU_W + n * 128 + hi * 8;
#pragma unroll
        for (int ks = 0; ks < 8; ++ks) af[ks] = *(const bf16x8*)(ap + ks * 16);
        float* Ad = AB + (size_t)(dir * 2 + 0) * MTOK * LRU_W; float* Ud = AB + (size_t)(dir * 2 + 1) * MTOK * LRU_W;
#pragma unroll 1
        for (int nb = 0; nb < 4; ++nb) {
            f32x16 acc0 = f32x16{}, acc1 = f32x16{};
            const bf16* bp0 = WG + (size_t)((n * 2 + dir) * 2 + 0) * 16384 + (size_t)(nb * 32 + r32) * 128 + hi * 8; const bf16* bp1 = bp0 + 16384;
#pragma unroll
            for (int ks = 0; ks < 8; ++ks) { const bf16x8 b0 = *(const bf16x8*)(bp0 + ks * 16), b1 = *(const bf16x8*)(bp1 + ks * 16);
                acc0 = __builtin_amdgcn_mfma_f32_32x32x16_bf16(af[ks], b0, acc0, 0, 0, 0); acc1 = __builtin_amdgcn_mfma_f32_32x32x16_bf16(af[ks], b1, acc1, 0, 0, 0); }
            const int c = n * 128 + nb * 32 + r32;
            const float ba = a->in[I_LBA][(l * 2 + dir) * LRU_W + c], bx = a->in[I_LBX][(l * 2 + dir) * LRU_W + c], lam = a->in[I_LLAM][(l * 2 + dir) * LRU_W + c];
            const float lsg = -log1pf(__expf(-lam)) * 8.0f;
#pragma unroll
            for (int r = 0; r < 16; ++r) { const int tok = rb * 32 + att::crow(r, hi);
                const float rg = sigmoidf_(acc0[r] + ba), ig = sigmoidf_(acc1[r] + bx);
                const float la = lsg * rg, av = __expf(la), xv = bf2f(XC[(size_t)tok * LRU_W + c]);
                const float uv = sqrtf(fmaxf(-expm1f(2.0f * la), 0.f)) * (ig * xv);
                Ad[(size_t)tok * LRU_W + c] = av; Ud[(size_t)tok * LRU_W + c] = uv; }
        }
    }
}
__device__ __forceinline__ void phase_lru_summ(KArgs a, int gtid, int NTHR) {
    const float* AB = (const float*)(a->ws + WS_AU); float2* SUMM = (float2*)(a->ws + WS_SUMM);
    for (int i = gtid; i < 2 * 64 * LRU_W; i += NTHR) {
        const int dir = i / (64 * LRU_W), tile = (i / LRU_W) % 64, c = i % LRU_W; const size_t row0 = (size_t)M_C + (size_t)tile * 256;
        const float* Ad = AB + (size_t)(dir * 2 + 0) * MTOK * LRU_W + c; const float* Ud = AB + (size_t)(dir * 2 + 1) * MTOK * LRU_W + c;
        float P = 1.f, h = 0.f;
#pragma unroll 8
        for (int s = 0; s < 256; ++s) { const size_t rr = row0 + (dir ? 255 - s : s); const float av = Ad[rr * LRU_W], uv = Ud[rr * LRU_W]; h = av * h + uv; P *= av; }
        SUMM[i] = make_float2(P, h);
    }
}
__device__ __forceinline__ void phase_lru_final(KArgs a, int l, int gtid, int NTHR) {
    unsigned char* ws = a->ws; const float* AB = (const float*)(ws + WS_AU); const float2* SUMM = (const float2*)(ws + WS_SUMM);
    float* HF = (float*)(ws + WS_HF); const bf16* PROJ = (const bf16*)(ws + WS_PROJ); bf16* MIX = (bf16*)(ws + WS_MIX);
    for (int i = gtid; i < 96 * LRU_W; i += NTHR) {
        const int tile = i / LRU_W, c = i % LRU_W; const bool lat = tile >= 32; const size_t row0 = (size_t)tile * 256;
        const float* Af = AB + (size_t)0 * MTOK * LRU_W + c; const float* Uf = AB + (size_t)1 * MTOK * LRU_W + c;
        const float* Ab = AB + (size_t)2 * MTOK * LRU_W + c; const float* Ub = AB + (size_t)3 * MTOK * LRU_W + c;
        float h = 0.f;
        if (lat) { const int b = (tile - 32) / 16, j = (tile - 32) % 16; h = a->in[I_ST][((size_t)(b * DEPTH + l) * 2 + 0) * LRU_W + c];
            for (int jj = 0; jj < j; ++jj) { const float2 s = SUMM[(size_t)(0 * 64 + b * 16 + jj) * LRU_W + c]; h = s.x * h + s.y; } }
#pragma unroll 8
        for (int s = 0; s < 256; ++s) { const size_t rr = row0 + s; h = Af[rr * LRU_W] * h + Uf[rr * LRU_W]; HF[rr * LRU_W + c] = h; }
        if (!lat) a->out[O_ST + ((size_t)(tile * DEPTH + l) * 2 + 0) * LRU_W + c] = h;
        h = 0.f;
        if (lat) { const int b = (tile - 32) / 16, j = (tile - 32) % 16; h = a->in[I_ST][((size_t)(b * DEPTH + l) * 2 + 1) * LRU_W + c];
            for (int jj = 15; jj > j; --jj) { const float2 s = SUMM[(size_t)(1 * 64 + b * 16 + jj) * LRU_W + c]; h = s.x * h + s.y; } }
#pragma unroll 8
        for (int s = 255; s >= 0; --s) { const size_t rr = row0 + s; h = Ab[rr * LRU_W] * h + Ub[rr * LRU_W];
            const float g = bf2f(PROJ[rr * NPROJ + C_GR + c]); const float y = (HF[rr * LRU_W + c] + h) * gelu_tanh(g);
            MIX[rr * DM + 512 + c] = (bf16)f2bf(y); }
        if (!lat) a->out[O_ST + ((size_t)(tile * DEPTH + l) * 2 + 1) * LRU_W + c] = h;
    }
}

__device__ __forceinline__ void phase_attention_gqa(KArgs a, char* lds, int wg, int G) {
    unsigned char* ws = a->ws;
    const bf16* QA = (const bf16*)(ws + WS_QA); const bf16* KAL = (const bf16*)(ws + WS_KAL); const bf16* VAL = (const bf16*)(ws + WS_VAL); const bf16* KAC = (const bf16*)(ws + WS_KAC); const bf16* VAC = (const bf16*)(ws + WS_VAC);
    bf16* MIX = (bf16*)(ws + WS_MIX);
    for (int u = wg; u < 384; u += G) {
        const bool lat = u < 256; int b, head, seq; size_t row0;
        if (lat) { const int x = u & 7, idx = u >> 3, qb = idx & 15; seq = SKV_L; b = x >> 1; head = (x & 1) * 2 + (idx >> 4); row0 = (size_t)M_C + (size_t)b * S_L + (size_t)qb * 256; }
        else { const int v = u - 256; b = v >> 2; head = v & 3; seq = S_C; row0 = (size_t)b * S_C; }
        const int kvh = head >> 1;
        const bf16* Kp = lat ? KAL + (size_t)b * SKV_L * 256 + kvh * 128 : KAC + (size_t)b * S_C * 256 + kvh * 128;
        const bf16* Vp = lat ? VAL + (size_t)b * SKV_L * 256 + kvh * 128 : VAC + (size_t)b * S_C * 256 + kvh * 128;
        att::attn_body<0, 2, 8, 512, 256, 64, 256, DM>(QA + row0 * 512 + head * 128, Kp, nullptr, Vp, MIX + row0 * DM + head * 128, seq, lds);
    }
}
__device__ __forceinline__ void phase_attention_mla(KArgs a, char* lds, int wg, int G) {
    unsigned char* ws = a->ws;
    const bf16* QM = (const bf16*)(ws + WS_QM); const bf16* KVM = (const bf16*)(ws + WS_KVM); const bf16* KR = (const bf16*)(ws + WS_KR); bf16* MIX = (bf16*)(ws + WS_MIX);
    for (int u = wg; u < 384; u += G) {
        const bool lat = u < 256; int b, head, seq; size_t row0, key0;
        if (lat) { const int x = u & 7, idx = u >> 3, qb = idx & 15, p = x * 2 + (idx >> 4); seq = SKV_L; b = p >> 2; head = p & 3; row0 = (size_t)M_C + (size_t)b * S_L + (size_t)qb * 256; key0 = (size_t)M_C + (size_t)b * SKV_L; }
        else { const int v = u - 256; b = v >> 2; head = v & 3; seq = S_C; row0 = (size_t)b * S_C; key0 = row0; }
        att::attn_body<64, MLA_SD, MLA_NQR, 768, 1024, 64, 1024, DM>(QM + row0 * 768 + head * 192, KVM + key0 * 1024 + head * 128, KR + key0 * 64, KVM + key0 * 1024 + 512 + head * 128,
                                                                  MIX + row0 * DM + 1536 + head * 128, seq, lds);
    }
}

__device__ __forceinline__ void phase_ffn_act(KArgs a, int l, int gtid, int NTHR) {
    const bf16* U = (const bf16*)(a->ws + WS_U); bf16* ACT = (bf16*)(a->ws + WS_ACT);
    const float* cw = a->in[I_FCW] + (size_t)l * 3 * NUP; const float* cb = a->in[I_FCB] + (size_t)l * NUP;
    constexpr int CG = DFF / 8;
    for (long i = gtid; i < (long)MTOK * CG; i += NTHR) {
        const int r = (int)(i / CG), c = (int)(i % CG) * 8; const bool lat = r >= M_C; const int t = lat ? (r - M_C) % S_L : r % S_C, slen = lat ? S_L : S_C;
        float g[8], v[8]; ld8f(cb + c, g); ld8f(cb + DFF + c, v);
#pragma unroll
        for (int j = 0; j < 3; ++j) { const int tt = t + j - 1; if (tt >= 0 && tt < slen) { float xg[8], xv[8], wg_[8], wv[8]; const bf16* ur = U + (size_t)(r + j - 1) * NUP;
            ld8bf(ur + c, xg); ld8bf(ur + DFF + c, xv); ld8f(cw + (size_t)j * NUP + c, wg_); ld8f(cw + (size_t)j * NUP + DFF + c, wv);
#pragma unroll
            for (int e = 0; e < 8; ++e) { g[e] += wg_[e] * xg[e]; v[e] += wv[e] * xv[e]; } } }
        float o[8];
#pragma unroll
        for (int e = 0; e < 8; ++e) o[e] = siluf_(g[e]) * v[e];
        st8bf(ACT + (size_t)r * DFF + c, o);
    }
}

#ifndef EN_AT2
#define EN_AT2 1
#endif
#ifndef EN_P0
#define EN_P0 1
#endif
#ifndef EN_P1
#define EN_P1 1
#endif
#ifndef EN_G1
#define EN_G1 1
#endif
#ifndef EN_PP
#define EN_PP 1
#endif
#ifndef EN_LG
#define EN_LG 1
#endif
#ifndef EN_LS
#define EN_LS 1
#endif
#ifndef EN_AT
#define EN_AT 1
#endif
#ifndef EN_LF
#define EN_LF 1
#endif
#ifndef EN_G2
#define EN_G2 1
#endif
#ifndef EN_R1
#define EN_R1 1
#endif
#ifndef EN_G3
#define EN_G3 1
#endif
#ifndef EN_FA
#define EN_FA 1
#endif
#ifndef EN_G4
#define EN_G4 1
#endif
#ifndef EN_R2
#define EN_R2 1
#endif
__global__ void __launch_bounds__(NTHREADS, 2) fwd_kernel(Args args) {
    extern __shared__ __attribute__((aligned(16))) unsigned char lds_raw[];
    const KArgs ka = (KArgs)__builtin_amdgcn_kernarg_segment_ptr();
    const int G = gridDim.x, bx = blockIdx.x;
    const int vcu = (G % 8 == 0) ? (bx % 8) * (G / 8) + bx / 8 : bx;
    const int NGW = G * NWAVES, NTHR = G * NTHREADS;
#define PH_IDS const int tid = ltid(), lane = tid & 63, wave = __builtin_amdgcn_readfirstlane(tid >> 6), gw = vcu * NWAVES + wave, gtid = vcu * NTHREADS + tid; (void)lane; (void)wave; (void)gw; (void)gtid; const KArgs a = launder(ka)
    LAS unsigned char* ldsL = (LAS unsigned char*)lds_raw; char* lds = (char*)lds_raw;
    volatile LAS unsigned* MISC = (volatile LAS unsigned*)(ldsL + MISC_OFF);
    for (int u = threadIdx.x; u < (LDS_BYTES - LDSCTL_OFF) / 4; u += NTHREADS) ((LAS unsigned*)(ldsL + LDSCTL_OFF))[u] = 0u;
    __syncthreads();
    unsigned* ctl = (unsigned*)(ka->ws + WS_CTL);
#if MK_MULTI
#define GRID_BAR() do { } while (0)
#else
    XcdBarrier bar = xcd_barrier_post(ctl + CW_BAR, MISC + 8);
#define GRID_BAR() xcd_barrier(bar)
#endif
    const int lo = ka->ph_lo, hi = ka->ph_hi;
#define IN(k) (lo <= (k) && (k) < hi)
#define SEAM(k) do { if (IN(k) && IN((k) + 1)) GRID_BAR(); else __syncthreads(); } while (0)
    if (EN_P0 && IN(0)) { PH_IDS; phase_prologue(a, lds, gw, NGW, wave, lane); } SEAM(0);
    if (EN_P0 && IN(1)) { PH_IDS; phase_mod_reduce(a, gtid, NTHR); } SEAM(1);
    if (EN_P1 && IN(2)) { PH_IDS; phase_first_norm(a, gw, NGW, lane); } SEAM(2);

    for (int l = 0; l < DEPTH; ++l) {
        const int pb = PH_PRE + l * PH_PER_LAYER;
        if (EN_G1 && IN(pb + 0)) {
            unsigned char* ws = launder(ka)->ws;
            pg8::Gemm g{(const bf16*)(ws + WS_H), (const bf16*)(ws + WS_WIN) + (size_t)l * NPROJ * DM, MTOK, NPROJ, DM}; pg8::StaticOrder S; S.init(MTOK, NPROJ, G, bx);
            pg8::EpiBf16<0> E{(bf16*)(ws + WS_PROJ), NPROJ, nullptr, 0, 0, 1.f};
            pg8::gemm_phase<pg8::EpiBf16<0>, pg8::StaticOrder, true, true>(ldsL, g, S, E);
        } SEAM(pb + 0);
        if (EN_PP && IN(pb + 1)) { PH_IDS; phase_postproj(a, l, gw, NGW, lane); } SEAM(pb + 1);
        if (EN_LG && IN(pb + 2)) {
            { PH_IDS; phase_lru_gates(a, l, gw, NGW, lane); }
            __syncthreads();
            unsigned char* ws = launder(ka)->ws;
            pg8::Gemm g{(const bf16*)(ws + WS_CKV), (const bf16*)(ws + WS_WKV) + (size_t)l * 1024 * 512, MKEY, 1024, 512}; pg8::StaticOrder S; S.init(MKEY, 1024, G, bx);
            pg8::EpiBf16<0> E{(bf16*)(ws + WS_KVM), 1024, nullptr, 0, 0, 1.f};
            pg8::gemm_phase<pg8::EpiBf16<0>, pg8::StaticOrder, true, true>(ldsL, g, S, E);
        } SEAM(pb + 2);
        if (IN(pb + 3)) { if (EN_LS) { PH_IDS; phase_lru_summ(a, gtid, NTHR); } __syncthreads();
            if (EN_AT) { PH_IDS; phase_attention_gqa(a, lds, bx, G); }
            if (EN_AT2) { PH_IDS; phase_attention_mla(a, lds, bx, G); } } SEAM(pb + 3);
        if (EN_LF && IN(pb + 4)) { PH_IDS; phase_lru_final(a, l, gtid, NTHR); } SEAM(pb + 4);
        if (EN_G2 && IN(pb + 5)) {
            unsigned char* ws = launder(ka)->ws;
            pg8::Gemm g{(const bf16*)(ws + WS_MIX), (const bf16*)(ws + WS_WOUT) + (size_t)l * DM * DM, MTOK, DM, DM}; pg8::StaticOrder S; S.init(MTOK, DM, G, bx);
            pg8::EpiF32 E{(float*)(ws + WS_MO), DM, nullptr};
            pg8::gemm_phase<pg8::EpiF32, pg8::StaticOrder, true, true>(ldsL, g, S, E);
        } SEAM(pb + 5);
        if (EN_R1 && IN(pb + 6)) { PH_IDS; phase_residual(a, l, 0, gw, NGW, lane); } SEAM(pb + 6);
        if (EN_G3 && IN(pb + 7)) {
            unsigned char* ws = launder(ka)->ws;
            pg8::Gemm g{(const bf16*)(ws + WS_H), (const bf16*)(ws + WS_WUP) + (size_t)l * NUP * DM, MTOK, NUP, DM}; pg8::StaticOrder S; S.init(MTOK, NUP, G, bx);
            pg8::EpiBf16<0> E{(bf16*)(ws + WS_U), NUP, nullptr, 0, 0, 1.f};
            pg8::gemm_phase<pg8::EpiBf16<0>, pg8::StaticOrder, true, true>(ldsL, g, S, E);
        } SEAM(pb + 7);
        if (EN_FA && IN(pb + 8)) { PH_IDS; phase_ffn_act(a, l, gtid, NTHR); } SEAM(pb + 8);
        if (EN_G4 && IN(pb + 9)) {
            unsigned char* ws = launder(ka)->ws;
            pg8::Gemm g{(const bf16*)(ws + WS_ACT), (const bf16*)(ws + WS_WDN) + (size_t)l * DM * DFF, MTOK, DM, DFF}; pg8::StaticOrder S; S.init(MTOK, DM, G, bx);
            pg8::EpiF32 E{(float*)(ws + WS_MO), DM, nullptr};
            pg8::gemm_phase<pg8::EpiF32, pg8::StaticOrder, true, true>(ldsL, g, S, E);
        } SEAM(pb + 9);
        if (EN_R2 && IN(pb + 10)) { PH_IDS; phase_residual(a, l, 1, gw, NGW, lane); } SEAM(pb + 10);
    }
#undef IN
#undef SEAM
}

extern "C" void kernel_launch(void* const* d_in, const int* in_sizes, int n_in, void* d_out, int out_size, void* d_ws, size_t ws_size, hipStream_t stream) {
    static int grid = 0;
    if (grid == 0) {
        if (n_in != N_IN || (size_t)out_size != O_END || ws_size < WS_END) { fprintf(stderr, "kernel_launch: unexpected shapes: n_in %d out %d ws %zu (need %zu)\n", n_in, out_size, ws_size, (size_t)WS_END); grid = -1; return; }
        int dev = 0, cus = 0, per_cu = 0;
        if (hipGetDevice(&dev) != hipSuccess || hipDeviceGetAttribute(&cus, hipDeviceAttributeMultiprocessorCount, dev) != hipSuccess) { grid = -1; return; }
        if (hipFuncSetAttribute((const void*)fwd_kernel, hipFuncAttributeMaxDynamicSharedMemorySize, LDS_BYTES) != hipSuccess) { fprintf(stderr, "kernel_launch: hipFuncSetAttribute failed\n"); grid = -1; return; }
        if (hipOccupancyMaxActiveBlocksPerMultiprocessor(&per_cu, (const void*)fwd_kernel, NTHREADS, LDS_BYTES) != hipSuccess || per_cu < 1) { fprintf(stderr, "kernel_launch: occupancy query says %d blocks per CU\n", per_cu); (void)hipGetLastError(); grid = -1; return; }
        grid = cus;
    }
    if (grid < 0) return;
    (void)hipMemsetAsync((char*)d_ws + WS_CTL, 0, CTL_ZERO_BYTES, stream);
    Args a{};
    for (int i = 0; i < N_IN; ++i) a.in[i] = (const float*)d_in[i];
    a.out = (float*)d_out; a.ws = (unsigned char*)d_ws;
#if MK_MULTI
    for (int p = 0; p < PH_TOTAL; ++p) { a.ph_lo = p; a.ph_hi = p + 1; hipLaunchKernelGGL(fwd_kernel, dim3(grid), dim3(NTHREADS), LDS_BYTES, stream, a); }
#else
    a.ph_lo = 0; a.ph_hi = PH_TOTAL; hipLaunchKernelGGL(fwd_kernel, dim3(grid), dim3(NTHREADS), LDS_BYTES, stream, a);
#endif
    const hipError_t le = hipPeekAtLastError();
    if (le != hipSuccess) fprintf(stderr, "kernel_launch: launch failed: %s\n", hipGetErrorName(le));
}
```

```cpp
#include <hip/hip_runtime.h>
#include <cstdio>
#include <cstdint>
#ifndef MK_MULTI
#define MK_MULTI 0
#endif
__device__ __forceinline__ int ltid(int wave) { int t = wave * 64 + (int)__builtin_amdgcn_mbcnt_hi(~0u, __builtin_amdgcn_mbcnt_lo(~0u, 0u)); asm volatile("" : "+v"(t)); __builtin_assume(t >= 0 && t < 512); return t; }

namespace pg8 {
#define PG8_LAS __attribute__((address_space(3)))
typedef unsigned short bf16_t;
typedef short bf16x8 __attribute__((ext_vector_type(8)));
typedef float f32x4 __attribute__((ext_vector_type(4)));
typedef unsigned u32x4 __attribute__((ext_vector_type(4)));
constexpr int BM = 256, BK = 64, HALF = 128, HTB = HALF * BK * 2  , STAGE_BYTES = 8 * HTB, NXCD = 8, WGM = 8;

__host__ __device__ __forceinline__ int lds_byte(int r, int c) { const int st = (r >> 4) * 2 + (c >> 5), rr = r & 15, cc = c & 31, ob = rr * 64 + cc * 2; return st * 1024 + (ob ^ (((ob >> 9) & 1) << 5)); }
__host__ __device__ __forceinline__ void stage_rc(int b, int& R, int& C) { const int st = b / 1024, sb = b % 1024, swz = sb ^ (((sb >> 9) & 1) << 5); R = (st >> 1) * 16 + swz / 64; C = (st & 1) * 32 + (swz % 64) / 2; }
__host__ __device__ __forceinline__ int perm32(int rho) { const int n = rho >> 4, i = rho & 15; return 8 * (i >> 2) + 4 * n + (i & 3); }

struct Unit { int pm, pn; };
struct Gemm { const bf16_t* A; const bf16_t* Bt; int M, N, K; };

struct StaticOrder {
    int nM, nN, nwg, G, c;
    __host__ __device__ void init(int M, int N, int G_, int c_) { nM = M / BM; nN = N / BM; nwg = nM * nN; G = G_; c = c_; }
    __host__ __device__ bool next(int i, Unit& u) const {
        const long L = (long)i * G + c; if (L >= nwg) return false;
        int wgid = (int)L; { const int q = nwg / NXCD, r = nwg % NXCD, xcd = wgid % NXCD, off = wgid / NXCD; wgid = (xcd < r ? xcd * (q + 1) : r * (q + 1) + (xcd - r) * q) + off; }
        const int nig = WGM * nN, gid = wgid / nig, fm = gid * WGM, gsz = (nM - fm) < WGM ? (nM - fm) : WGM;
        u.pm = fm + ((wgid % nig) % gsz); u.pn = (wgid % nig) / gsz; return true;
    }
    __device__ __forceinline__ void a_ready(const Unit&) const {}
    __device__ __forceinline__ void done(const Unit&) const {}
};

__device__ __forceinline__ unsigned cvt_pk_bf16(float lo, float hi) { unsigned r; asm volatile("v_cvt_pk_bf16_f32 %0, %1, %2" : "=v"(r) : "v"(lo), "v"(hi)); return r; }
typedef float f32x2 __attribute__((ext_vector_type(2)));
__device__ __forceinline__ f32x2 gelu_pk(f32x2 v) {
    const f32x2 av = __builtin_elementwise_abs(v), d = av * 0.2316418882f + 1.0f;
    f32x2 t; t.x = __builtin_amdgcn_rcpf(d.x); t.y = __builtin_amdgcn_rcpf(d.y);
    f32x2 q = t * 0.5307027145f + (-0.7265760135f); q = q * t + 0.7107068705f; q = q * t + (-0.142248368f); q = q * t + 0.127414796f; q = q * t;
    const f32x2 s = (v * v) * (-0.72134752044f);
    f32x2 e; e.x = __builtin_amdgcn_exp2f(s.x); e.y = __builtin_amdgcn_exp2f(s.y);
    const f32x2 m = v * (q * e), r = v - m;
    f32x2 o; o.x = v.x < 0.f ? m.x : r.x; o.y = v.y < 0.f ? m.y : r.y; return o;
}

template <int ACT  > struct EpiBf16 {
    static constexpr bool PERM = true, AFTER_DRAIN = false; static_assert(ACT == 0 || ACT == 1, "EpiBf16: ACT is 0 (none) or 1 (gelu_pk)");
    bf16_t* O; int ldc; const float* bias; int split_cols; size_t split_stride; float scale0;
    __device__ __forceinline__ void operator()(const f32x4 (&acc)[2][2][4][2], const Unit& u, int wr, int wc, int fr, int fq) const {
        const int row0 = u.pm * BM + wr * 64 + fr; int colt = u.pn * BM; bf16_t* base = O;
        float sc = 1.f; if (split_cols) { const int t = colt / split_cols; base += (size_t)t * split_stride; colt -= t * split_cols; if (t == 0) sc = scale0; }
        const int col0 = colt + wc * 32 + 8 * fq, bcol0 = u.pn * BM + wc * 32 + 8 * fq;
        f32x4 bv[2][2];
#pragma unroll
        for (int bj = 0; bj < 2; ++bj)
#pragma unroll
            for (int n = 0; n < 2; ++n) bv[bj][n] = bias ? *(const f32x4*)(bias + bcol0 + bj * HALF + 4 * n) : (f32x4){0.f, 0.f, 0.f, 0.f};
#pragma unroll
        for (int ai = 0; ai < 2; ++ai)
#pragma unroll
            for (int m = 0; m < 4; ++m) { bf16_t* rowp = base + (size_t)(row0 + ai * HALF + m * 16) * ldc + col0;
#pragma unroll
                for (int bj = 0; bj < 2; ++bj) { f32x4 v0 = acc[ai][bj][m][0] + bv[bj][0], v1 = acc[ai][bj][m][1] + bv[bj][1];
                    if (ACT == 1) { f32x2 a = gelu_pk((f32x2){v0[0], v0[1]}), b = gelu_pk((f32x2){v0[2], v0[3]}), c = gelu_pk((f32x2){v1[0], v1[1]}), d = gelu_pk((f32x2){v1[2], v1[3]});
                        v0 = (f32x4){a.x, a.y, b.x, b.y}; v1 = (f32x4){c.x, c.y, d.x, d.y}; }
                    v0 = v0 * sc; v1 = v1 * sc; u32x4 w; w.x = cvt_pk_bf16(v0[0], v0[1]); w.y = cvt_pk_bf16(v0[2], v0[3]); w.z = cvt_pk_bf16(v1[0], v1[1]); w.w = cvt_pk_bf16(v1[2], v1[3]);
                    *(u32x4*)(rowp + bj * HALF) = w; } }
    }
};
#ifndef CONV_CENTER_ONLY
#define CONV_CENTER_ONLY 0
#endif
struct EpiF32 {
    static constexpr bool PERM = false, AFTER_DRAIN = false;
    float* C; int ldc; const float* bias;
    __device__ __forceinline__ void operator()(const f32x4 (&acc)[2][2][4][2], const Unit& u, int wr, int wc, int fr, int fq) const {
        const int row0 = u.pm * BM + wr * 64 + fr, col0 = u.pn * BM + wc * 32 + 4 * fq;
        f32x4 bv[2][2];
#pragma unroll
        for (int bj = 0; bj < 2; ++bj)
#pragma unroll
            for (int n = 0; n < 2; ++n) bv[bj][n] = bias ? *(const f32x4*)(bias + col0 + bj * HALF + n * 16) : (f32x4){0.f, 0.f, 0.f, 0.f};
#pragma unroll
        for (int ai = 0; ai < 2; ++ai)
#pragma unroll
            for (int m = 0; m < 4; ++m) { float* rowp = C + (size_t)(row0 + ai * HALF + m * 16) * ldc + col0;
#pragma unroll
                for (int bj = 0; bj < 2; ++bj)
#pragma unroll
                    for (int n = 0; n < 2; ++n) *(f32x4*)(rowp + bj * HALF + n * 16) = acc[ai][bj][m][n] + bv[bj][n]; }
    }
};

struct EpiFfnAct {
    static constexpr bool PERM = true, AFTER_DRAIN = false;
    bf16_t* ACT; int ldact; const float* cw; const float* cb; int nup, dff; bf16_t* HALO; PG8_LAS float* xr;
    __device__ __forceinline__ void operator()(const f32x4 (&acc)[2][2][4][2], const Unit& u, int wr, int wc, int fr_, int fq_) const {
        int fr = fr_, fq = fq_; asm volatile("" : "+v"(fr), "+v"(fq));
        const int lane = fq * 16 + fr, colw = wc * 32 + 8 * fq, ch0 = u.pn * 128 + colw;
#pragma unroll
        for (int ai = 0; ai < 2; ++ai)
#pragma unroll
            for (int bj = 0; bj < 2; ++bj)
#pragma unroll
                for (int n = 0; n < 2; ++n) { const int idx = (ai * 2 + wr) * 256 + bj * 128 + colw + 4 * n;
                    if (fr == 0) *(PG8_LAS f32x4*)(xr + idx) = acc[ai][bj][0][n];
                    if (fr == 15) *(PG8_LAS f32x4*)(xr + 1024 + idx) = acc[ai][bj][3][n]; }
        asm volatile("s_waitcnt lgkmcnt(0)" ::: "memory"); __builtin_amdgcn_s_barrier(); asm volatile("" ::: "memory");
        const int srcP = ((lane & 48) | ((fr + 15) & 15)) * 4, srcN = ((lane & 48) | ((fr + 1) & 15)) * 4;
        const f32x4 z4 = (f32x4){0.f, 0.f, 0.f, 0.f};
        typedef unsigned u32x2_t __attribute__((ext_vector_type(2)));
#pragma unroll
        for (int ai = 0; ai < 2; ++ai) { const int blk = ai * 2 + wr;
#pragma unroll
            for (int n = 0; n < 2; ++n) {
                f32x4 og[4];
                const float* cwl = cw; const float* cbl = cb; asm volatile("" : "+s"(cwl), "+s"(cbl));
#pragma unroll
                for (int bj = 0; bj < 2; ++bj) { const float* wp = cwl + bj * dff + ch0 + 4 * n; const int xi = bj * 128 + colw + 4 * n;
                    const f32x4 w0 = *(const f32x4*)(wp), w1 = *(const f32x4*)(wp + nup), w2 = *(const f32x4*)(wp + 2 * nup), bb = *(const f32x4*)(cbl + bj * dff + ch0 + 4 * n);
                    const f32x4 XP = blk > 0 ? *(const PG8_LAS f32x4*)(xr + 1024 + (blk - 1) * 256 + xi) : z4, XN = blk < 3 ? *(const PG8_LAS f32x4*)(xr + (blk + 1) * 256 + xi) : z4;
#pragma unroll
                    for (int c = 0; c < 4; ++c) { float R[4], L[4];
#pragma unroll
                        for (int m = 0; m < 4; ++m) { const float tv = acc[ai][bj][m][n][c]; const int ti = __float_as_int(tv);
                            R[m] = __int_as_float(__builtin_amdgcn_ds_bpermute(srcP, ti)); L[m] = __int_as_float(__builtin_amdgcn_ds_bpermute(srcN, ti)); }
#pragma unroll
                        for (int m = 0; m < 4; ++m) { const float prev = fr > 0 ? R[m] : (m > 0 ? R[m > 0 ? m - 1 : 0] : XP[c]), next = fr < 15 ? L[m] : (m < 3 ? L[m < 3 ? m + 1 : 3] : XN[c]);
                            const float o = bb[c] + (CONV_CENTER_ONLY ? 0.f : w0[c] * prev) + w1[c] * acc[ai][bj][m][n][c] + (CONV_CENTER_ONLY ? 0.f : w2[c] * next);
                            if (bj == 0) og[m][c] = o * __builtin_amdgcn_rcpf(1.0f + __expf(-o)); else og[m][c] *= o; } }
                    __builtin_amdgcn_sched_barrier(0); }
#pragma unroll
                for (int m = 0; m < 4; ++m) { const size_t row = (size_t)u.pm * BM + ai * HALF + wr * 64 + m * 16 + fr;
                    u32x2_t w; w.x = cvt_pk_bf16(og[m][0], og[m][1]); w.y = cvt_pk_bf16(og[m][2], og[m][3]);
                    *(u32x2_t*)(ACT + row * ldact + ch0 + 4 * n) = w; }
                __builtin_amdgcn_sched_barrier(0); } }
        if (u.pm >= 32) {
            const bool top = (wr == 0) && fr < 2, bot = (wr == 1) && fr >= 14;
            if (top || bot) { const int ai = top ? 0 : 1, m = top ? 0 : 3, hrow = top ? fr : 2 + (fr - 14);
#pragma unroll
                for (int bj = 0; bj < 2; ++bj) { const f32x4 v0 = top ? acc[0][bj][0][0] : acc[1][bj][3][0], v1 = top ? acc[0][bj][0][1] : acc[1][bj][3][1];
                    u32x4 w; w.x = cvt_pk_bf16(v0[0], v0[1]); w.y = cvt_pk_bf16(v0[2], v0[3]); w.z = cvt_pk_bf16(v1[0], v1[1]); w.w = cvt_pk_bf16(v1[2], v1[3]);
                    *(u32x4*)(HALO + ((size_t)((u.pm - 32) * 4 + hrow) * (nup / 256) + u.pn) * 256 + bj * 128 + colw) = w; }
                (void)ai; (void)m; } }
    }
};
template <class Epi, class Sched, bool ALIGN_EPI = false, bool SP2 = false>
__device__ __forceinline__ void gemm_phase(PG8_LAS unsigned char* lds, const Gemm g, const Sched& S, const Epi& E, const int wave_id) {
    const int tid = ltid(wave_id), wid = __builtin_amdgcn_readfirstlane(tid >> 6), lane = tid & 63, wr = wid >> 2, wc = wid & 3, fr = lane & 15, fq = lane >> 4;
    const int K = g.K, nt = K / BK;
    unsigned voffA[2], voffB[2];
#pragma unroll
    for (int i = 0; i < 2; ++i) { int R, C; stage_rc(tid * 16 + i * 8192, R, C); const int Rb = Epi::PERM ? ((R & ~31) + perm32(R & 31)) : R;
        voffA[i] = (unsigned)(R * K + C) * 2u; voffB[i] = (unsigned)(Rb * K + C) * 2u; }
    const size_t kstep = (size_t)(BK * 2);
    const size_t hstep = (size_t)HALF * K * 2;
    const size_t tstep = 2 * hstep;
    const unsigned ldsw = (unsigned)wid * 1024u;
    const int aoff = lds_byte(wr * 64 + fr, fq * 8), boff = lds_byte(wc * 32 + fr, fq * 8);
#define PG8_SA(b, h) (((b) * 2 + (h)) * HTB)
#define PG8_SB(b, h) ((4 + (b) * 2 + (h)) * HTB)
#define PG8_STAGE(bufoff, gbase, voff) do { _Pragma("unroll") for (int _i = 0; _i < 2; ++_i) \
        __builtin_amdgcn_global_load_lds((const unsigned*)((const char*)(gbase) + (voff)[_i]), (PG8_LAS unsigned*)(lds + (bufoff) + ldsw + _i * 8192), 16, 0, 0); } while (0)
#define PG8_LDA(dst, b, h) do { _Pragma("unroll") for (int m = 0; m < 4; ++m) _Pragma("unroll") for (int k = 0; k < 2; ++k) dst[m][k] = *(const PG8_LAS bf16x8*)(lds + PG8_SA(b, h) + aoff + m * 2048 + k * 1024); } while (0)
#define PG8_LDB(dst, b, h) do { _Pragma("unroll") for (int n = 0; n < 2; ++n) _Pragma("unroll") for (int k = 0; k < 2; ++k) dst[n][k] = *(const PG8_LAS bf16x8*)(lds + PG8_SB(b, h) + boff + n * 2048 + k * 1024); } while (0)
#define PG8_MMA(ai, bj, At, Bt) do { __builtin_amdgcn_s_setprio(1); _Pragma("unroll") for (int m = 0; m < 4; ++m) _Pragma("unroll") for (int n = 0; n < 2; ++n) _Pragma("unroll") for (int k = 0; k < 2; ++k) \
        acc[ai][bj][m][n] = __builtin_amdgcn_mfma_f32_16x16x32_bf16(Bt[n][k], At[m][k], acc[ai][bj][m][n], 0, 0, 0); __builtin_amdgcn_s_setprio(0); } while (0)
#define PG8_WAIT_V(n) asm volatile("s_waitcnt vmcnt(" #n ")" ::: "memory")
#define PG8_WAIT_L(n) asm volatile("s_waitcnt lgkmcnt(" #n ")" ::: "memory")
#define PG8_BAR __builtin_amdgcn_s_barrier()
#define PG8_SCHED __builtin_amdgcn_sched_barrier(0)
    Unit cur, nxt; int ui = 0;
    if (!S.next(0, cur)) return;
    f32x4 acc[2][2][4][2];
#pragma unroll
    for (int a = 0; a < 2; ++a)
#pragma unroll
        for (int b = 0; b < 2; ++b)
#pragma unroll
            for (int m = 0; m < 4; ++m)
#pragma unroll
                for (int n = 0; n < 2; ++n) acc[a][b][m][n] = (f32x4){0.f, 0.f, 0.f, 0.f};
    bf16x8 At[4][2], B0[2][2], B1[2][2];
    const char* cA = (const char*)g.A + (size_t)cur.pm * tstep; const char* cB = (const char*)g.Bt + (size_t)cur.pn * tstep;
    S.a_ready(cur);
    if constexpr (SP2) {
        PG8_STAGE(PG8_SB(0, 0), cB, voffB); PG8_STAGE(PG8_SB(0, 1), cB + hstep, voffB); PG8_STAGE(PG8_SA(0, 0), cA, voffA); PG8_STAGE(PG8_SA(0, 1), cA + hstep, voffA);
        if (wr == 1) PG8_BAR;
        PG8_WAIT_V(2); PG8_BAR;
        PG8_STAGE(PG8_SB(1, 0), cB + kstep, voffB); PG8_STAGE(PG8_SA(1, 0), cA + kstep, voffA); PG8_STAGE(PG8_SB(1, 1), cB + hstep + kstep, voffB);
        PG8_WAIT_V(6); PG8_BAR;
    } else {
        PG8_STAGE(PG8_SB(0, 0), cB, voffB); PG8_STAGE(PG8_SA(0, 0), cA, voffA); PG8_STAGE(PG8_SB(0, 1), cB + hstep, voffB); PG8_STAGE(PG8_SA(0, 1), cA + hstep, voffA);
        if (wr == 1) PG8_BAR;
        PG8_WAIT_V(4); PG8_BAR;
        PG8_STAGE(PG8_SB(1, 0), cB + kstep, voffB); PG8_STAGE(PG8_SA(1, 0), cA + kstep, voffA); PG8_STAGE(PG8_SB(1, 1), cB + hstep + kstep, voffB);
        PG8_WAIT_V(6); PG8_BAR;
    }
    for (;;) {
        const bool has_next = S.next(ui + 1, nxt);
        const char* nA = has_next ? (const char*)g.A + (size_t)nxt.pm * tstep : cA; const char* nB = has_next ? (const char*)g.Bt + (size_t)nxt.pn * tstep : cB;
        for (int t = 0; t < nt; t += 2) {
            const bool last = (t == nt - 2);
            const char* a1 = cA + (size_t)(t + 1) * kstep;
            const char* a2 = last ? nA : cA + (size_t)(t + 2) * kstep; const char* b2 = last ? nB : cB + (size_t)(t + 2) * kstep;
            const char* a3 = a2 + kstep; const char* b3 = b2 + kstep;
            if (last && has_next) S.a_ready(nxt);
            if constexpr (SP2) {
            PG8_LDB(B0, 0, 0); PG8_LDB(B1, 0, 1); PG8_SCHED; PG8_LDA(At, 0, 0); PG8_STAGE(PG8_SA(1, 1), a1 + hstep, voffA);
            PG8_WAIT_V(8); PG8_WAIT_L(0); PG8_BAR; PG8_MMA(0, 0, At, B0); PG8_MMA(0, 1, At, B1); PG8_BAR; PG8_SCHED;
            PG8_LDA(At, 0, 1); PG8_STAGE(PG8_SB(0, 0), b2, voffB); PG8_STAGE(PG8_SB(0, 1), b2 + hstep, voffB); PG8_STAGE(PG8_SA(0, 0), a2, voffA);
            PG8_WAIT_V(8); PG8_WAIT_L(0); PG8_BAR; PG8_MMA(1, 0, At, B0); PG8_MMA(1, 1, At, B1); PG8_BAR; PG8_SCHED;
            PG8_LDB(B0, 1, 0); PG8_LDB(B1, 1, 1); PG8_SCHED; PG8_LDA(At, 1, 0); PG8_STAGE(PG8_SA(0, 1), a2 + hstep, voffA);
            PG8_WAIT_V(8); PG8_WAIT_L(0); PG8_BAR; PG8_MMA(0, 0, At, B0); PG8_MMA(0, 1, At, B1); PG8_BAR; PG8_SCHED;
            PG8_LDA(At, 1, 1); PG8_STAGE(PG8_SB(1, 0), b3, voffB); PG8_STAGE(PG8_SB(1, 1), b3 + hstep, voffB); PG8_STAGE(PG8_SA(1, 0), a3, voffA);
            PG8_WAIT_V(8); PG8_WAIT_L(0); PG8_BAR; PG8_MMA(1, 0, At, B0); PG8_MMA(1, 1, At, B1); PG8_BAR; PG8_SCHED;
            } else {
            PG8_LDB(B0, 0, 0); PG8_SCHED; PG8_LDA(At, 0, 0); PG8_STAGE(PG8_SA(1, 1), a1 + hstep, voffA);
            PG8_WAIT_L(8); PG8_BAR; PG8_WAIT_L(0); PG8_MMA(0, 0, At, B0); PG8_BAR; PG8_SCHED;
            PG8_LDB(B1, 0, 1); PG8_STAGE(PG8_SB(0, 0), b2, voffB);
            PG8_BAR; PG8_WAIT_L(0); PG8_MMA(0, 1, At, B1); PG8_BAR;
            PG8_LDA(At, 0, 1); PG8_STAGE(PG8_SA(0, 0), a2, voffA);
            PG8_BAR; PG8_WAIT_L(0); PG8_MMA(1, 0, At, B0); PG8_BAR; PG8_SCHED;
            PG8_STAGE(PG8_SB(0, 1), b2 + hstep, voffB);
            PG8_WAIT_V(6); PG8_BAR; PG8_MMA(1, 1, At, B1); PG8_BAR;
            PG8_LDB(B0, 1, 0); PG8_SCHED; PG8_LDA(At, 1, 0); PG8_STAGE(PG8_SA(0, 1), a2 + hstep, voffA);
            PG8_WAIT_L(8); PG8_BAR; PG8_WAIT_L(0); PG8_MMA(0, 0, At, B0); PG8_BAR; PG8_SCHED;
            PG8_LDB(B1, 1, 1); PG8_STAGE(PG8_SB(1, 0), b3, voffB);
            PG8_BAR; PG8_WAIT_L(0); PG8_MMA(0, 1, At, B1); PG8_BAR;
            PG8_LDA(At, 1, 1); PG8_STAGE(PG8_SA(1, 0), a3, voffA);
            PG8_BAR; PG8_WAIT_L(0); PG8_MMA(1, 0, At, B0); PG8_BAR; PG8_SCHED;
            PG8_STAGE(PG8_SB(1, 1), b3 + hstep, voffB);
            PG8_WAIT_V(6); PG8_BAR; PG8_MMA(1, 1, At, B1); PG8_BAR;
            }
        }
        if constexpr (ALIGN_EPI) { if (wr == 0) PG8_BAR; }
        if constexpr (!Epi::AFTER_DRAIN) { E(acc, cur, wr, wc, fr, fq); S.done(cur); }
        if (!has_next) break;
#pragma unroll
        for (int a = 0; a < 2; ++a)
#pragma unroll
            for (int b = 0; b < 2; ++b)
#pragma unroll
                for (int m = 0; m < 4; ++m)
#pragma unroll
                    for (int n = 0; n < 2; ++n) acc[a][b][m][n] = (f32x4){0.f, 0.f, 0.f, 0.f};
        cur = nxt; cA = nA; cB = nB; ++ui;
        if constexpr (ALIGN_EPI) { if (wr == 1) PG8_BAR; }
    }
    PG8_WAIT_V(0);
    if constexpr (!ALIGN_EPI) { if (wr == 0) PG8_BAR; }
    PG8_BAR;
    if constexpr (Epi::AFTER_DRAIN) { E.fused(acc, cur, wr, wc, fr, fq, lds, wid, lane); S.done(cur); }
#undef PG8_SA
#undef PG8_SB
#undef PG8_STAGE
#undef PG8_LDA
#undef PG8_LDB
#undef PG8_MMA
#undef PG8_WAIT_V
#undef PG8_WAIT_L
#undef PG8_BAR
#undef PG8_SCHED
}
}

constexpr int DM = 2048, NB_C = 32, S_C = 256, NB_L = 4, S_L = 4096, PAST = 512, DEPTH = 4;
constexpr int M_C = NB_C * S_C;
constexpr int M_L = NB_L * S_L;
constexpr int MTOK = M_C + M_L;
constexpr int SKV_L = PAST + S_L;
constexpr int MKEY = M_C + NB_L * SKV_L;
constexpr int DIN = 4416, NPROJ = 4608;
constexpr int DFF = 5632, NUP = 2 * DFF;
constexpr int LRU_W = 1024;
constexpr int C_QA = 0, C_KA = 512, C_VA = 768, C_XR = 1024, C_GR = 2048, C_QM = 3072, C_CKV = 3840, C_KR = 4352;
constexpr float NORM_EPS = 1e-6f;
constexpr size_t O_Y = 0, O_K = 50331648, O_V = 58720256, O_CKV = 67108864, O_KR = 83886080, O_ST = 85983232, O_END = 86245376;
enum { I_XP = 0, I_XS, I_CK, I_CV, I_CCKV, I_CKR, I_ST, I_C, I_CCTX, I_WMOD, I_BMOD, I_GPM, I_GPOM, I_GPF, I_GPOF, I_WIN, I_GQ, I_GK, I_LCW, I_LCB, I_LWA, I_LBA, I_LWX, I_LBX, I_LLAM, I_GKV, I_WUK, I_WUV, I_WOUT, I_WUP, I_FCW, I_FCB, I_WDN, N_IN };

constexpr size_t MiB = 1u << 20;
constexpr size_t WS_CTL = 0, CTL_ZERO_BYTES = 2 * MiB;
constexpr size_t WS_MOD = 1 * MiB;
constexpr size_t WS_ROPE = 2 * MiB;
constexpr size_t WS_WIN = 3 * MiB, WS_WOUT = 75 * MiB, WS_WUP = 107 * MiB, WS_WDN = 283 * MiB, WS_WKV = 371 * MiB, WS_WG = 375 * MiB;
constexpr size_t WS_H = 379 * MiB, WS_KAL = 475 * MiB, WS_VAL = 484 * MiB, WS_KAC = 493 * MiB, WS_VAC = 497 * MiB, WS_CKV = 501 * MiB, WS_KR = 527 * MiB;
constexpr size_t WS_R1 = 531 * MiB;
constexpr size_t WS_PROJ = WS_R1, WS_QA = WS_R1 + 216 * MiB, WS_QM = WS_R1 + 240 * MiB, WS_XC = WS_R1 + 276 * MiB, WS_AU = WS_R1 + 324 * MiB, WS_HF = WS_R1 + 708 * MiB,
                 WS_KVM = WS_R1 + 804 * MiB, WS_MIX = WS_R1 + 856 * MiB, WS_SUMM = WS_R1 + 952 * MiB;
constexpr size_t WS_MODP = WS_AU;
constexpr size_t WS_MO = WS_R1;
constexpr size_t WS_U = WS_R1, WS_ACT = WS_R1 + 528 * MiB;
constexpr size_t WS_HALO = WS_R1 + 792 * MiB;
constexpr size_t WS_DBG = WS_R1 + 953 * MiB;
constexpr size_t WS_END = WS_DBG + 8 * MiB;
static_assert(WS_ACT + (size_t)MTOK * DFF * 2 <= WS_DBG && WS_SUMM + MiB <= WS_DBG, "ws map");
constexpr int CW_TMO = 0, CW_CODE = 1, CW_BAR = 4096, CW_CHK = 65536;

constexpr int RING_BYTES = 143360, LDSCTL_OFF = RING_BYTES, MISC_OFF = LDSCTL_OFF + 320, LDS_BYTES = 147456;
static_assert(MISC_OFF + 128 <= LDS_BYTES, "LDS map");
constexpr int NWAVES = 8, NTHREADS = 512;

#define GAS __attribute__((address_space(1)))
#define LAS __attribute__((address_space(3)))
typedef unsigned short bf16;
typedef unsigned v4u __attribute__((ext_vector_type(4)));
typedef float f32x4 __attribute__((ext_vector_type(4)));
typedef short bf16x8 __attribute__((ext_vector_type(8)));
typedef float f32x16 __attribute__((ext_vector_type(16)));
typedef short s16x4 __attribute__((ext_vector_type(4)));
#define LDS_WAIT() asm volatile("s_waitcnt lgkmcnt(0)" ::: "memory")
#define VM_WAIT() asm volatile("s_waitcnt vmcnt(0)" ::: "memory")
__device__ __forceinline__ unsigned f2bf(float f) { unsigned u = __builtin_bit_cast(unsigned, f); return (u + 0x7fffu + ((u >> 16) & 1u)) >> 16; }
__device__ __forceinline__ unsigned pk2(float lo, float hi) { return f2bf(lo) | (f2bf(hi) << 16); }
__device__ __forceinline__ float bf2f(unsigned short b) { return __builtin_bit_cast(float, (unsigned)b << 16); }
__device__ __forceinline__ void ld8bf(const bf16* p, float (&x)[8]) { const v4u w = *(const v4u*)p;
    x[0] = __builtin_bit_cast(float, w.x << 16); x[1] = __builtin_bit_cast(float, w.x & 0xffff0000u); x[2] = __builtin_bit_cast(float, w.y << 16); x[3] = __builtin_bit_cast(float, w.y & 0xffff0000u);
    x[4] = __builtin_bit_cast(float, w.z << 16); x[5] = __builtin_bit_cast(float, w.z & 0xffff0000u); x[6] = __builtin_bit_cast(float, w.w << 16); x[7] = __builtin_bit_cast(float, w.w & 0xffff0000u); }
__device__ __forceinline__ void st8bf(bf16* p, const float (&x)[8]) { v4u w; w.x = pk2(x[0], x[1]); w.y = pk2(x[2], x[3]); w.z = pk2(x[4], x[5]); w.w = pk2(x[6], x[7]); *(v4u*)p = w; }
__device__ __forceinline__ void ld8f(const float* p, float (&x)[8]) { const f32x4 a = *(const f32x4*)p, b = *(const f32x4*)(p + 4); x[0] = a.x; x[1] = a.y; x[2] = a.z; x[3] = a.w; x[4] = b.x; x[5] = b.y; x[6] = b.z; x[7] = b.w; }
__device__ __forceinline__ void st8f(float* p, const float (&x)[8]) { *(f32x4*)p = (f32x4){x[0], x[1], x[2], x[3]}; *(f32x4*)(p + 4) = (f32x4){x[4], x[5], x[6], x[7]}; }
__device__ __forceinline__ float wave_sum(float v) {
#pragma unroll
    for (int o = 1; o < 64; o <<= 1) v += __shfl_xor(v, o);
    return v;
}
__device__ __forceinline__ float sigmoidf_(float x) { return __builtin_amdgcn_rcpf(1.0f + __expf(-x)); }
__device__ __forceinline__ float siluf_(float x) { return x * sigmoidf_(x); }
__device__ __forceinline__ float gelu_tanh(float x) { const float z = 0.7978845608028654f * (x + 0.044715f * x * x * x); const float t = 1.0f - 2.0f * __builtin_amdgcn_rcpf(__expf(2.0f * z) + 1.0f); return 0.5f * x * (1.0f + t); }

#define XB_TMO      128
#define XB_XCNT(j)  (256  + 64 * (j))
#define XB_XSUB(j)  (1280 + 64 * (j))
#define XB_XGEN(j)  (2304 + 64 * (j))
#define XB_TOP      3328
#define XB_TOPGEN   3392
#define XCD_BAR_WORDS 3456
#define XB_SPIN_CAP (1u << 18)

__device__ __forceinline__ unsigned xb_ld(unsigned* p)              { return __hip_atomic_load(p, __ATOMIC_RELAXED, __HIP_MEMORY_SCOPE_AGENT); }
__device__ __forceinline__ unsigned xb_add(unsigned* p, unsigned v) { return __hip_atomic_fetch_add(p, v, __ATOMIC_RELAXED, __HIP_MEMORY_SCOPE_AGENT); }
__device__ __forceinline__ unsigned xb_xcc_id() { return (unsigned)__builtin_amdgcn_s_getreg((3 << 11) | 20) & 0xFu; }
#define XB_SPIN(cond, bar) do { unsigned _sp = 0; while (cond) { __builtin_amdgcn_s_sleep(1); \
    if ((++_sp & 255u) == 0u) { if (xb_ld(&(bar)[XB_TMO])) break; if (_sp > XB_SPIN_CAP) { atomicAdd(&(bar)[XB_TMO], 1u); break; } } } } while (0)

struct XcdBarrier {
    unsigned* bar; unsigned x; unsigned w0;
    volatile LAS unsigned* st;
};

__device__ __forceinline__ XcdBarrier xcd_barrier_post(unsigned* bar, volatile LAS unsigned* st, int wave_id) {
    XcdBarrier b; b.bar = bar; b.x = xb_xcc_id(); b.st = st; b.w0 = (wave_id == 0);
    if (b.w0 && __builtin_amdgcn_mbcnt_hi(~0u, __builtin_amdgcn_mbcnt_lo(~0u, 0u)) == 0u) (void)xb_add(&bar[XB_XCNT(b.x)], 1u);
    return b;
}
__device__ __forceinline__ void xcd_barrier_complete(unsigned* bar, unsigned x, unsigned& nloc, unsigned& nx) {
    const unsigned G = gridDim.x * gridDim.y * gridDim.z;
    unsigned sum, cnt, mine, sp = 0u;
    for (;;) {
        sum = 0u; cnt = 0u; mine = 0u;
#pragma unroll
        for (unsigned j = 0; j < 16; ++j) { const unsigned c = xb_ld(&bar[XB_XCNT(j)]); sum += c; cnt += (c > 0u) ? 1u : 0u; mine = (j == x) ? c : mine; }
        if (sum == G) break;
        __builtin_amdgcn_s_sleep(1);
        if ((++sp & 255u) == 0u) { if (xb_ld(&bar[XB_TMO])) break; if (sp > XB_SPIN_CAP) { atomicAdd(&bar[XB_TMO], 1u); break; } }
    }
    nloc = mine > 0u ? mine : 1u; nx = cnt > 0u ? cnt : 1u;
}

__device__ __forceinline__ void xcd_barrier(const XcdBarrier& b) {
    asm volatile("s_waitcnt vmcnt(0)" ::: "memory");
    __syncthreads();
    if (b.w0 && __builtin_amdgcn_mbcnt_hi(~0u, __builtin_amdgcn_mbcnt_lo(~0u, 0u)) == 0u) {
        unsigned* bar = b.bar;
        __builtin_amdgcn_s_waitcnt(0);
        unsigned nloc = b.st[0], nx = b.st[1];
        if (nloc == 0u) { xcd_barrier_complete(bar, b.x, nloc, nx); b.st[0] = nloc; b.st[1] = nx; }
        const unsigned old = xb_add(&bar[XB_XSUB(b.x)], 1u);
        const unsigned gen = old / nloc;
        if (old + 1u == (gen + 1u) * nloc) {
            __builtin_amdgcn_fence(__ATOMIC_RELEASE, "agent");
            asm volatile("s_waitcnt vmcnt(0)" ::: "memory");
            const unsigned og = xb_add(&bar[XB_TOP], 1u);
            const unsigned tg = og / nx;
            if (og + 1u == (tg + 1u) * nx) xb_add(&bar[XB_TOPGEN], 1u);
            else XB_SPIN(xb_ld(&bar[XB_TOPGEN]) == tg, bar);
            __builtin_amdgcn_fence(__ATOMIC_ACQUIRE, "agent");
            xb_add(&bar[XB_XGEN(b.x)], 1u);
            asm volatile("s_waitcnt vmcnt(0)" ::: "memory");
        } else {
            XB_SPIN(xb_ld(&bar[XB_XGEN(b.x)]) == gen, bar);
            __builtin_amdgcn_fence(__ATOMIC_ACQUIRE, "agent");
            asm volatile("s_waitcnt vmcnt(0)" ::: "memory");
        }
    }
    __syncthreads();
}

namespace att {
typedef __attribute__((ext_vector_type(4))) unsigned u32x4;
constexpr int NW = 8, QBLK = 32, KVBLK = 64;
constexpr int SHM_V = KVBLK * 128 * 2, SHM_K = KVBLK * 128 * 2, SHM_KR = KVBLK * 64 * 2;
constexpr int OFF_V = 0, OFF_K = 2 * SHM_V, OFF_KR = OFF_K + 2 * SHM_K, OFF_WS = OFF_KR + 2 * SHM_KR, OFF_QR = OFF_WS + NW * 64 * 4;
template <int QL> constexpr int lds_attn() { return OFF_QR + NW * QL * 1024; }
#define KSWZ(row, colB) ((row) * 256 + ((colB) ^ (((row) & 7) << 4)))
#define KRSWZ(row, colB) ((row) * 128 + ((colB) ^ (((row) & 7) << 4)))
#define SBAR() __builtin_amdgcn_sched_barrier(0)
constexpr float THR = 8.f;
__device__ __forceinline__ int crow(int r, int hi) { return (r & 3) + 8 * (r >> 2) + 4 * hi; }
__device__ __forceinline__ unsigned cvtpk(float lo, float hi) { unsigned r; asm volatile("v_cvt_pk_bf16_f32 %0, %1, %2" : "=v"(r) : "v"(lo), "v"(hi)); return r; }

template <int DQK> __device__ __forceinline__ void partialSM(f32x16& p0, f32x16& p1, float& m_reg, float& mn, float& alpha) {
  constexpr float SCALE = (DQK == 128) ? 0.088388347648318440f : 0.072168783648703220f;
  constexpr float C = SCALE * 1.4426950408889634f;
  float pmax = p0[0];
#pragma unroll
  for (int r = 1; r < 16; ++r) pmax = fmaxf(pmax, p0[r]);
#pragma unroll
  for (int r = 0; r < 16; ++r) pmax = fmaxf(pmax, p1[r]);
  { auto rr = __builtin_amdgcn_permlane32_swap(__float_as_uint(pmax), __float_as_uint(pmax), false, false);
    pmax = fmaxf(__uint_as_float(rr[0]), __uint_as_float(rr[1])); }
  if (__builtin_expect(__all(pmax - m_reg <= THR / SCALE), 1)) { mn = m_reg; alpha = 1.f; }
  else { mn = fmaxf(m_reg, pmax); alpha = __builtin_amdgcn_exp2f((m_reg - mn) * C); m_reg = mn; }
  float mnC = -mn * C;
#pragma unroll
  for (int r = 0; r < 16; ++r) p0[r] = fmaf(p0[r], C, mnC);
#pragma unroll
  for (int r = 0; r < 16; ++r) p1[r] = fmaf(p1[r], C, mnC);
#pragma unroll
  for (int r = 0; r < 16; ++r) p0[r] = __builtin_amdgcn_exp2f(p0[r]);
}
__device__ __forceinline__ void finishSM(f32x16& p0, f32x16& p1, float alpha, float& l_reg, bf16x8& pa0, bf16x8& pa1, bf16x8& pa2, bf16x8& pa3) {
#pragma unroll
  for (int r = 0; r < 16; ++r) p1[r] = __builtin_amdgcn_exp2f(p1[r]);
  float ps = 0;
#pragma unroll
  for (int r = 0; r < 16; ++r) ps += p0[r];
#pragma unroll
  for (int r = 0; r < 16; ++r) ps += p1[r];
  { auto rr = __builtin_amdgcn_permlane32_swap(__float_as_uint(ps), __float_as_uint(ps), false, false);
    ps = __uint_as_float(rr[0]) + __uint_as_float(rr[1]); }
  l_reg = l_reg * alpha + ps;
#define PK4(P, BASE, OUT) do { unsigned a0 = cvtpk(P[BASE + 0], P[BASE + 1]), a1 = cvtpk(P[BASE + 2], P[BASE + 3]);   \
    unsigned b0 = cvtpk(P[BASE + 4], P[BASE + 5]), b1 = cvtpk(P[BASE + 6], P[BASE + 7]);                              \
    auto r0 = __builtin_amdgcn_permlane32_swap(a0, b0, false, false); auto r1 = __builtin_amdgcn_permlane32_swap(a1, b1, false, false); \
    u32x4 w = {r0[0], r1[0], r0[1], r1[1]}; OUT = *reinterpret_cast<bf16x8*>(&w); } while (0)
  PK4(p0, 0, pa0); PK4(p0, 8, pa1); PK4(p1, 0, pa2); PK4(p1, 8, pa3);
#undef PK4
}
template <int DR, int NQR> __device__ __forceinline__ void qkt(f32x16& p0, f32x16& p1, const char* Ks, const char* KRs, const bf16x8* qr, const char* qrl, int r32, int hi) {
  p0 = f32x16{}; p1 = f32x16{};
#pragma unroll
  for (int d0 = 0; d0 < 8; ++d0) { int cb = (d0 * 16 + hi * 8) * 2;
    bf16x8 b0 = *reinterpret_cast<const bf16x8*>(Ks + KSWZ(r32, cb));
    bf16x8 b1 = *reinterpret_cast<const bf16x8*>(Ks + KSWZ(32 + r32, cb));
    bf16x8 qf; if constexpr (true) { if (d0 < NQR) qf = qr[d0]; else qf = *reinterpret_cast<const bf16x8*>(qrl + (d0 - NQR) * 1024); }
    p0 = __builtin_amdgcn_mfma_f32_32x32x16_bf16(b0, qf, p0, 0, 0, 0);
    p1 = __builtin_amdgcn_mfma_f32_32x32x16_bf16(b1, qf, p1, 0, 0, 0); }
  if constexpr (DR > 0) {
#pragma unroll
    for (int d0 = 0; d0 < DR / 16; ++d0) { int cb = (d0 * 16 + hi * 8) * 2;
      bf16x8 b0 = *reinterpret_cast<const bf16x8*>(KRs + KRSWZ(r32, cb));
      bf16x8 b1 = *reinterpret_cast<const bf16x8*>(KRs + KRSWZ(32 + r32, cb));
      const bf16x8 qf = *reinterpret_cast<const bf16x8*>(qrl + (8 - NQR + d0) * 1024);
      p0 = __builtin_amdgcn_mfma_f32_32x32x16_bf16(b0, qf, p0, 0, 0, 0);
      p1 = __builtin_amdgcn_mfma_f32_32x32x16_bf16(b1, qf, p1, 0, 0, 0); }
  }
}
__device__ __forceinline__ int v_st(int k, int c) { const int kk = (k & ~0xC) | ((k & 4) << 1) | ((k & 8) >> 1); return ((kk >> 3) * 4 + (c >> 5)) * 512 + ((kk & 7) * 32 + (c & 31)) * 2; }
__device__ __forceinline__ int v_rd_base(int lane) { return ((lane & 3) << 3) | (((lane >> 2) & 3) << 6) | (((lane >> 4) & 1) << 5) | (((lane >> 5) & 1) << 8); }
constexpr int v_rd_off(int d0, int ks, int half) { return d0 * 512 + ks * 4096 + half * 2048; }
template <int OFF> __device__ __forceinline__ s16x4 tr_read(int vb) {
  s16x4 r; asm volatile("ds_read_b64_tr_b16 %0, %1 offset:%2" : "=&v"(r) : "v"(vb), "i"(OFF) : "memory"); return r;
}
template <int D0> __device__ __forceinline__ void pv_one(f32x16& od, int vb, bf16x8 pa0, bf16x8 pa1, bf16x8 pa2, bf16x8 pa3) {
  const s16x4 l0 = tr_read<v_rd_off(D0, 0, 0)>(vb), h0 = tr_read<v_rd_off(D0, 0, 1)>(vb), l1 = tr_read<v_rd_off(D0, 1, 0)>(vb), h1 = tr_read<v_rd_off(D0, 1, 1)>(vb);
  const s16x4 l2 = tr_read<v_rd_off(D0, 2, 0)>(vb), h2 = tr_read<v_rd_off(D0, 2, 1)>(vb), l3 = tr_read<v_rd_off(D0, 3, 0)>(vb), h3 = tr_read<v_rd_off(D0, 3, 1)>(vb);
  asm volatile("s_waitcnt lgkmcnt(0)" ::: "memory"); SBAR();
#define PK(L, H) (bf16x8){L[0], L[1], L[2], L[3], H[0], H[1], H[2], H[3]}
  od = __builtin_amdgcn_mfma_f32_32x32x16_bf16(pa0, PK(l0, h0), od, 0, 0, 0);
  od = __builtin_amdgcn_mfma_f32_32x32x16_bf16(pa1, PK(l1, h1), od, 0, 0, 0);
  od = __builtin_amdgcn_mfma_f32_32x32x16_bf16(pa2, PK(l2, h2), od, 0, 0, 0);
  od = __builtin_amdgcn_mfma_f32_32x32x16_bf16(pa3, PK(l3, h3), od, 0, 0, 0);
#undef PK
}
__device__ __forceinline__ void pv_d0(f32x16* o, int vb, bf16x8 pa0, bf16x8 pa1, bf16x8 pa2, bf16x8 pa3) {
  pv_one<0>(o[0], vb, pa0, pa1, pa2, pa3); pv_one<1>(o[1], vb, pa0, pa1, pa2, pa3); pv_one<2>(o[2], vb, pa0, pa1, pa2, pa3); pv_one<3>(o[3], vb, pa0, pa1, pa2, pa3);
}

template <int DR, int SD, int NQR, int LDQ, int LDK, int LDKR, int LDV, int LDO>
__device__ __forceinline__ void attn_body(const bf16* __restrict__ Qb, const bf16* __restrict__ Kh, const bf16* __restrict__ KRh, const bf16* __restrict__ Vh,
                                          bf16* __restrict__ Ob, int seq, char* lds, const int wave_id) {
  constexpr int DQK = 128 + DR, NQ = NQR, QL = (8 - NQR) + DR / 16;
  static_assert(lds_attn<QL>() <= RING_BYTES, "attention LDS");
  const int tid = ltid(wave_id), wid = tid >> 6, lane = tid & 63, r32 = lane & 31, hi = lane >> 5;
  char* V_lds = lds + OFF_V; char* K_lds = lds + OFF_K; char* KR_lds = lds + OFF_KR;
  float* ws = (float*)(lds + OFF_WS) + wid * 64; float* li_l = ws; float* al_l = ws + 32;
  float m_reg = -1e30f, l_reg = 0; f32x16 o[4] = {}; bf16x8 qr[NQ];
  const bf16* Qw = Qb + (long)(wid * QBLK + r32) * LDQ + hi * 8;
#pragma unroll
  for (int d0 = 0; d0 < NQ; ++d0) qr[d0] = *reinterpret_cast<const bf16x8*>(Qw + d0 * 16);
  char* qrl = lds + OFF_QR + wid * (QL * 1024) + lane * 16;
#pragma unroll
  for (int d0 = 0; d0 < QL; ++d0) *reinterpret_cast<bf16x8*>(qrl + d0 * 1024) = *reinterpret_cast<const bf16x8*>(Qw + (NQR + d0) * 16);
  const int sr = tid >> 4, sc = (tid & 15) * 8, vst0 = v_st(sr, sc), vst1 = v_st(32 + sr, sc);
  const int rr = tid >> 3, rc = (tid & 7) * 8;
  const int vb0 = (int)(uintptr_t)V_lds + v_rd_base(lane);
  struct { bf16x8 vs0, vs1, ks0, ks1, kr; } sr_[SD];
#define SLOAD(i, k0) do { sr_[i].vs0 = *reinterpret_cast<const bf16x8*>(&Vh[(long)((k0) + sr) * LDV + sc]); sr_[i].vs1 = *reinterpret_cast<const bf16x8*>(&Vh[(long)((k0) + 32 + sr) * LDV + sc]); \
    sr_[i].ks0 = *reinterpret_cast<const bf16x8*>(&Kh[(long)((k0) + sr) * LDK + sc]); sr_[i].ks1 = *reinterpret_cast<const bf16x8*>(&Kh[(long)((k0) + 32 + sr) * LDK + sc]); \
    if constexpr (DR > 0) sr_[i].kr = *reinterpret_cast<const bf16x8*>(&KRh[(long)((k0) + rr) * LDKR + rc]); } while (0)
#define SWRITE(b, i) do { *(bf16x8*)(V_lds + (b) * SHM_V + vst0) = sr_[i].vs0;          \
    *(bf16x8*)(V_lds + (b) * SHM_V + vst1) = sr_[i].vs1; int kc = sc * 2;               \
    *(bf16x8*)(K_lds + (b) * SHM_K + KSWZ(sr, kc)) = sr_[i].ks0;                       \
    *(bf16x8*)(K_lds + (b) * SHM_K + KSWZ(32 + sr, kc)) = sr_[i].ks1;                  \
    if constexpr (DR > 0) *(bf16x8*)(KR_lds + (b) * SHM_KR + KRSWZ(rr, rc * 2)) = sr_[i].kr; } while (0)
#define SWAIT() do { if constexpr (SD == 1) asm volatile("s_waitcnt vmcnt(0)" ::: "memory"); else if constexpr (DR > 0) asm volatile("s_waitcnt vmcnt(5)" ::: "memory"); else asm volatile("s_waitcnt vmcnt(4)" ::: "memory"); } while (0)
#define RESC(a) do { if (__any((a) < 1.f)) { if (hi == 0) al_l[r32] = (a); asm volatile("s_waitcnt lgkmcnt(0)" ::: "memory"); \
    _Pragma("unroll") for (int d = 0; d < 4; ++d) _Pragma("unroll") for (int r = 0; r < 16; ++r) o[d][r] *= al_l[crow(r, hi)]; } } while (0)
  f32x16 pA0, pA1, pB0, pB1; float mnA, mnB, alA, alB; bf16x8 pa0, pa1, pa2, pa3; const int NT = seq / KVBLK;
  constexpr int SE = 0, SO = SD - 1;
  SLOAD(SE, 0); asm volatile("s_waitcnt vmcnt(0)" ::: "memory"); SWRITE(0, SE); __syncthreads();
  qkt<DR, NQR>(pA0, pA1, K_lds, KR_lds, qr, qrl, r32, hi); partialSM<DQK>(pA0, pA1, m_reg, mnA, alA);
  SLOAD(SO, KVBLK); if constexpr (SD == 2) { if (2 < NT) SLOAD(SE, 2 * KVBLK); }
  SWAIT(); SWRITE(1, SO); __syncthreads();
  for (int j = 1; j + 1 < NT; j += 2) {
    SBAR(); qkt<DR, NQR>(pB0, pB1, K_lds + SHM_K, KR_lds + SHM_KR, qr, qrl, r32, hi);
    finishSM(pA0, pA1, alA, l_reg, pa0, pa1, pa2, pa3); SBAR();
    SLOAD(SO, (j + SD) * KVBLK); SBAR();
    pv_d0(o, vb0, pa0, pa1, pa2, pa3); partialSM<DQK>(pB0, pB1, m_reg, mnB, alB);
    __syncthreads(); SWAIT(); SWRITE(0, SE);
    RESC(alB); __syncthreads();
    SBAR(); qkt<DR, NQR>(pA0, pA1, K_lds, KR_lds, qr, qrl, r32, hi);
    finishSM(pB0, pB1, alB, l_reg, pa0, pa1, pa2, pa3); SBAR();
    if (SD == 1 || j + 3 < NT) SLOAD(SE, (j + 1 + SD) * KVBLK); SBAR();
    pv_d0(o, vb0 + (int)SHM_V, pa0, pa1, pa2, pa3); partialSM<DQK>(pA0, pA1, m_reg, mnA, alA);
    __syncthreads(); SWAIT(); SWRITE(1, SO);
    RESC(alA); __syncthreads();
  }
  SBAR(); qkt<DR, NQR>(pB0, pB1, K_lds + SHM_K, KR_lds + SHM_KR, qr, qrl, r32, hi);
  finishSM(pA0, pA1, alA, l_reg, pa0, pa1, pa2, pa3); SBAR();
  pv_d0(o, vb0, pa0, pa1, pa2, pa3); partialSM<DQK>(pB0, pB1, m_reg, mnB, alB);
  __syncthreads(); RESC(alB);
  finishSM(pB0, pB1, alB, l_reg, pa0, pa1, pa2, pa3); SBAR();
  pv_d0(o, vb0 + (int)SHM_V, pa0, pa1, pa2, pa3);
  if (hi == 0) li_l[r32] = l_reg; asm volatile("s_waitcnt lgkmcnt(0)" ::: "memory");
  float rli[16];
#pragma unroll
  for (int r = 0; r < 16; ++r) rli[r] = __builtin_amdgcn_rcpf(li_l[crow(r, hi)]);
  bf16* Ow = Ob + (long)(wid * QBLK) * LDO;
#pragma unroll
  for (int r = 0; r < 16; ++r) { int orow = crow(r, hi);
#pragma unroll
    for (int d0 = 0; d0 < 4; ++d0) Ow[(long)orow * LDO + d0 * 32 + r32] = (bf16)f2bf(o[d0][r] * rli[r]); }
  __syncthreads();
#undef SLOAD
#undef SWRITE
#undef SWAIT
#undef RESC
}
}
#ifndef MLA_NQR
#define MLA_NQR 6
#endif
#ifndef MLA_SD
#define MLA_SD 1
#endif

struct Args { const float* in[N_IN]; float* out; unsigned char* ws; int ph_lo, ph_hi; };
constexpr int PH_PER_LAYER = 10, PH_PRE = 3, PH_TOTAL = PH_PRE + DEPTH * PH_PER_LAYER;
typedef const __attribute__((address_space(4))) Args* KArgs;
__device__ __forceinline__ KArgs launder(KArgs p) { asm volatile("" : "+s"(p)); return p; }

template <bool FFNUP = false>
__device__ __forceinline__ void transpose_item(const float* W, int K, int N, bf16* WT, LAS float* scr, int item, int lane) {
    const int nblk = N / 32, kb = item / nblk, nb = item % nblk, k0 = 64 * kb, n0 = 32 * nb;
    const int d0 = FFNUP ? ((n0 % DFF) / 128) * 256 + (n0 / DFF) * 128 + (n0 % DFF) % 128 : n0;
#pragma unroll 8
    for (int i = 0; i < 32; ++i) { const int kk = 2 * i + (lane >> 5); scr[kk * 33 + (lane & 31)] = W[(size_t)(k0 + kk) * N + n0 + (lane & 31)]; }
    LDS_WAIT(); asm volatile("" ::: "memory");
    const int c = lane & 7;
#pragma unroll
    for (int j = 0; j < 4; ++j) { const int n = (lane >> 3) + 8 * j; const LAS float* s = scr + (8 * c) * 33 + n;
        v4u o; o.x = pk2(s[0 * 33], s[1 * 33]); o.y = pk2(s[2 * 33], s[3 * 33]); o.z = pk2(s[4 * 33], s[5 * 33]); o.w = pk2(s[6 * 33], s[7 * 33]);
        *(v4u*)(WT + (size_t)(d0 + n) * K + k0 + 8 * c) = o; }
    LDS_WAIT(); asm volatile("" ::: "memory");
}

__device__ __forceinline__ void phase_prologue(KArgs a, char* lds, int gw, int NGW, int wave, int lane) {
    unsigned char* ws = a->ws;
    LAS float* scr = (LAS float*)(lds + wave * 16384);
    constexpr int I_IN = 32 * 138, I_OUT = 32 * 64, I_UP = 32 * 352, I_DN = 88 * 64, I_KV = 2 * 128, I_G = 256;
    constexpr int I_LAYER = I_IN + I_OUT + I_UP + I_DN + I_KV + I_G;
    for (int it = gw; it < DEPTH * I_LAYER; it += NGW) {
        const int l = it / I_LAYER; int r = it % I_LAYER;
        if (r < I_IN) { transpose_item(a->in[I_WIN] + (size_t)l * DM * DIN, DM, DIN, (bf16*)(ws + WS_WIN) + (size_t)l * NPROJ * DM, scr, r, lane); continue; } r -= I_IN;
        if (r < I_OUT) { transpose_item(a->in[I_WOUT] + (size_t)l * DM * DM, DM, DM, (bf16*)(ws + WS_WOUT) + (size_t)l * DM * DM, scr, r, lane); continue; } r -= I_OUT;
        if (r < I_UP) { transpose_item<true>(a->in[I_WUP] + (size_t)l * DM * NUP, DM, NUP, (bf16*)(ws + WS_WUP) + (size_t)l * NUP * DM, scr, r, lane); continue; } r -= I_UP;
        if (r < I_DN) { transpose_item(a->in[I_WDN] + (size_t)l * DFF * DM, DFF, DM, (bf16*)(ws + WS_WDN) + (size_t)l * DM * DFF, scr, r, lane); continue; } r -= I_DN;
        if (r < I_KV) { const int which = r / 128;
            transpose_item(a->in[which ? I_WUV : I_WUK] + (size_t)l * 512 * 512, 512, 512, (bf16*)(ws + WS_WKV) + (size_t)l * 1024 * 512 + (size_t)which * 512 * 512, scr, r % 128, lane); continue; } r -= I_KV;
        { const int mat = r / 8, sub = r % 8;
          const int ty = mat & 1, dir = (mat >> 1) & 1, n = mat >> 2;
          const float* src = a->in[ty ? I_LWX : I_LWA] + ((size_t)((l * 2 + dir) * 8 + n)) * 128 * 128;
          transpose_item(src, 128, 128, (bf16*)(ws + WS_WG) + (size_t)l * 32 * 16384 + (size_t)mat * 16384, scr, sub, lane); }
    }
    { const int gt = gw * 64 + lane, NT = NGW * 64; constexpr int PER = (NPROJ - DIN) * DM / 8;
      for (int i = gt; i < DEPTH * PER; i += NT) { const int l = i / PER, j = i % PER; *((v4u*)((bf16*)(ws + WS_WIN) + (size_t)l * NPROJ * DM + (size_t)DIN * DM) + j) = (v4u){0u, 0u, 0u, 0u}; } }
    { float* MODP = (float*)(ws + WS_MODP);
      for (int it = gw; it < DEPTH * 32 * 48; it += NGW) {
        const int l = it / (32 * 48), kc = (it / 48) % 32, jb = it % 48, j = jb * 256 + 4 * lane, k = kc * 64 + lane;
        float cv[5];
#pragma unroll
        for (int cr = 0; cr < 4; ++cr) cv[cr] = siluf_(a->in[I_C][cr * DM + k]);
        cv[4] = siluf_(a->in[I_CCTX][k]);
        f32x4 acc[5];
#pragma unroll
        for (int cr = 0; cr < 5; ++cr) acc[cr] = (f32x4){0.f, 0.f, 0.f, 0.f};
        const float* wp = a->in[I_WMOD] + ((size_t)l * DM + (size_t)kc * 64) * 12288 + j;
#pragma unroll 4
        for (int kk = 0; kk < 64; ++kk) { const f32x4 w = *(const f32x4*)(wp + (size_t)kk * 12288);
#pragma unroll
            for (int cr = 0; cr < 5; ++cr) { const float s = __shfl(cv[cr], kk); acc[cr] += w * s; } }
        if (kc == 0) { const f32x4 b = *(const f32x4*)(a->in[I_BMOD] + (size_t)l * 12288 + j);
#pragma unroll
            for (int cr = 0; cr < 5; ++cr) acc[cr] += b; }
#pragma unroll
        for (int cr = 0; cr < 5; ++cr) *(f32x4*)(MODP + (((size_t)(l * 32 + kc) * 5 + cr)) * 12288 + j) = acc[cr];
      } }
    { const int gt = gw * 64 + lane;
      if (gt < 64 * 32 + 64 * 16) { const bool big = gt < 2048; const int e = big ? gt : gt - 2048, nf = big ? 32 : 16, pos = e / nf, f = e % nf;
        const float inv = exp2f(-(float)f / (float)nf * 13.287712379549449f);
        const float ang = (float)pos * inv;
        double rev = (double)ang * 0.15915494309189535; rev -= floor(rev);
        const float rf = (float)rev; const float sn = __builtin_amdgcn_sinf(rf), cs = __builtin_amdgcn_cosf(rf);
        float2* tab = (float2*)(ws + WS_ROPE + (big ? 0 : 32768)); tab[e] = make_float2(cs, sn); } }
}

__device__ __forceinline__ void phase_mod_reduce(KArgs a, int gtid, int NTHR) {
    const float* MODP = (const float*)(a->ws + WS_MODP); float* MOD = (float*)(a->ws + WS_MOD);
    for (int i = gtid; i < DEPTH * 5 * 12288 / 4; i += NTHR) { const int l = i / (5 * 3072), rem = i % (5 * 3072);
        f32x4 s = (f32x4){0.f, 0.f, 0.f, 0.f};
#pragma unroll 8
        for (int kc = 0; kc < 32; ++kc) s += *((const f32x4*)(MODP + ((size_t)(l * 32 + kc) * 5) * 12288) + rem);
        *((f32x4*)(MOD + (size_t)l * 5 * 12288) + rem) = s; }
}

__device__ __forceinline__ void row_update(const float* xsrc, const float* msrc, float* xdst, const float* g_post, const float* gate,
                                           const float* g_pre, const float* sc, const float* sh, bf16* hdst, int lane) {
    f32x4 x[8];
#pragma unroll
    for (int j = 0; j < 8; ++j) x[j] = *((const f32x4*)xsrc + lane + 64 * j);
    if (msrc) {
        f32x4 m[8]; float ss = 0.f;
#pragma unroll
        for (int j = 0; j < 8; ++j) { m[j] = *((const f32x4*)msrc + lane + 64 * j); ss += (m[j].x * m[j].x + m[j].y * m[j].y) + (m[j].z * m[j].z + m[j].w * m[j].w); }
        const float rs = rsqrtf(wave_sum(ss) * (1.0f / DM) + NORM_EPS);
#pragma unroll
        for (int j = 0; j < 8; ++j) { const f32x4 g = *((const f32x4*)g_post + lane + 64 * j), gt = *((const f32x4*)gate + lane + 64 * j); x[j] = x[j] + gt * (m[j] * rs * g); }
    }
    if (xdst) {
#pragma unroll
        for (int j = 0; j < 8; ++j) *((f32x4*)xdst + lane + 64 * j) = x[j];
    }
    if (hdst) {
        float ss = 0.f;
#pragma unroll
        for (int j = 0; j < 8; ++j) ss += (x[j].x * x[j].x + x[j].y * x[j].y) + (x[j].z * x[j].z + x[j].w * x[j].w);
        const float rs = rsqrtf(wave_sum(ss) * (1.0f / DM) + NORM_EPS);
#pragma unroll
        for (int j = 0; j < 8; ++j) { const f32x4 g = *((const f32x4*)g_pre + lane + 64 * j), s1 = *((const f32x4*)sc + lane + 64 * j), s0 = *((const f32x4*)sh + lane + 64 * j);
            const f32x4 h = x[j] * rs * g * (1.0f + s1) + s0;
            *((unsigned long long*)hdst + lane + 64 * j) = (unsigned long long)pk2(h.x, h.y) | ((unsigned long long)pk2(h.z, h.w) << 32); }
    }
}
__device__ __forceinline__ int cond_row(int r) { return r < M_C ? 4 : (r - M_C) / S_L; }
__device__ __forceinline__ const float* mod_ptr(KArgs a, int l, int cr, int which) { return (const float*)(a->ws + WS_MOD) + ((size_t)(l * 5 + cr) * 6 + which) * DM; }

__device__ __forceinline__ void phase_first_norm(KArgs a, int gw, int NGW, int lane) {
    for (int r = gw; r < MTOK; r += NGW) {
        const float* xs = r < M_C ? a->in[I_XP] + (size_t)r * DM : a->in[I_XS] + (size_t)(r - M_C) * DM; const int cr = cond_row(r);
        row_update(xs, nullptr, a->out + (size_t)r * DM, nullptr, nullptr, a->in[I_GPM], mod_ptr(a, 0, cr, 1), mod_ptr(a, 0, cr, 0), (bf16*)(a->ws + WS_H) + (size_t)r * DM, lane);
    }
}
__device__ __forceinline__ void phase_residual(KArgs a, int l, int which, int gw, int NGW, int lane) {
    const float* MO = (const float*)(a->ws + WS_MO);
    for (int r = gw; r < MTOK; r += NGW) {
        const int cr = cond_row(r); float* xr = a->out + (size_t)r * DM; bf16* hr = (bf16*)(a->ws + WS_H) + (size_t)r * DM;
        if (which == 0) row_update(xr, MO + (size_t)r * DM, xr, a->in[I_GPOM] + l * DM, mod_ptr(a, l, cr, 2), a->in[I_GPF] + l * DM, mod_ptr(a, l, cr, 4), mod_ptr(a, l, cr, 3), hr, lane);
        else if (l + 1 < DEPTH) row_update(xr, MO + (size_t)r * DM, xr, a->in[I_GPOF] + l * DM, mod_ptr(a, l, cr, 5), a->in[I_GPM] + (l + 1) * DM, mod_ptr(a, l + 1, cr, 1), mod_ptr(a, l + 1, cr, 0), hr, lane);
        else row_update(xr, MO + (size_t)r * DM, xr, a->in[I_GPOF] + l * DM, mod_ptr(a, l, cr, 5), nullptr, nullptr, nullptr, nullptr, lane);
    }
}

__device__ __forceinline__ void rope8(float (&y)[8], int pxor, bool first, const float2* tab) {
#pragma unroll
    for (int i = 0; i < 8; ++i) { const float yp = __shfl_xor(y[i], pxor); const float2 cs = tab[i]; y[i] = first ? y[i] * cs.x - yp * cs.y : y[i] * cs.x + yp * cs.y; }
}

__device__ __forceinline__ void phase_postproj(KArgs a, int l, int gw, int NGW, int lane) {
    unsigned char* ws = a->ws;
    const bf16* PROJ = (const bf16*)(ws + WS_PROJ);
    const float2* R128 = (const float2*)(ws + WS_ROPE); const float2* R64 = (const float2*)(ws + WS_ROPE + 32768);
    bf16* QA = (bf16*)(ws + WS_QA); bf16* QM = (bf16*)(ws + WS_QM); bf16* XC = (bf16*)(ws + WS_XC);
    bf16* KAL = (bf16*)(ws + WS_KAL); bf16* VAL = (bf16*)(ws + WS_VAL); bf16* KAC = (bf16*)(ws + WS_KAC); bf16* VAC = (bf16*)(ws + WS_VAC);
    bf16* CKV = (bf16*)(ws + WS_CKV); bf16* KR = (bf16*)(ws + WS_KR);
    for (int job = gw; job < MTOK + NB_L * PAST; job += NGW) {
        if (job >= MTOK) {
            const int cb = (job - MTOK) / PAST, p = (job - MTOK) % PAST; float x[8];
            const size_t crow_ = ((size_t)(cb * DEPTH + l) * PAST + p);
            if (lane < 32) { ld8f(a->in[I_CK] + crow_ * 256 + 8 * lane, x); st8bf(KAL + ((size_t)cb * SKV_L + p) * 256 + 8 * lane, x);
                             ld8f(a->in[I_CV] + crow_ * 256 + 8 * lane, x); st8bf(VAL + ((size_t)cb * SKV_L + p) * 256 + 8 * lane, x); }
            const size_t krow = (size_t)M_C + (size_t)cb * SKV_L + p;
            ld8f(a->in[I_CCKV] + crow_ * 512 + 8 * lane, x); st8bf(CKV + krow * 512 + 8 * lane, x);
            if (lane < 8) { ld8f(a->in[I_CKR] + crow_ * 64 + 8 * lane, x); st8bf(KR + krow * 64 + 8 * lane, x); }
            continue;
        }
        const int r = job; const bool lat = r >= M_C;
        const int b = lat ? (r - M_C) / S_L : r / S_C, t = lat ? (r - M_C) % S_L : r % S_C, slen = lat ? S_L : S_C;
        const int prow = t >> 6, pcol = t & 63;
        const bf16* pr = PROJ + (size_t)r * NPROJ;
        const size_t krow = lat ? (size_t)M_C + (size_t)b * SKV_L + PAST + t : (size_t)r;
        const size_t orow = ((size_t)(b * DEPTH + l) * S_C + t);
        float x[8];
        { ld8bf(pr + C_QA + 8 * lane, x); float ss = 0.f;
#pragma unroll
          for (int i = 0; i < 8; ++i) ss += x[i] * x[i];
          ss += __shfl_xor(ss, 1); ss += __shfl_xor(ss, 2); ss += __shfl_xor(ss, 4); ss += __shfl_xor(ss, 8);
          const float rs = rsqrtf(ss * (1.0f / 128.0f) + NORM_EPS); float g[8]; ld8f(a->in[I_GQ] + l * 128 + 8 * (lane & 15), g);
#pragma unroll
          for (int i = 0; i < 8; ++i) x[i] = x[i] * rs * g[i];
          if (lat) { const int s = lane & 15; rope8(x, 4, (s & 7) < 4, R128 + ((s >> 3) ? pcol : prow) * 32 + 8 * (s & 3)); }
          st8bf(QA + (size_t)r * 512 + 8 * lane, x); }
        { ld8bf(pr + C_KA + 8 * lane, x); float ss = 0.f;
#pragma unroll
          for (int i = 0; i < 8; ++i) ss += x[i] * x[i];
          ss += __shfl_xor(ss, 1); ss += __shfl_xor(ss, 2); ss += __shfl_xor(ss, 4); ss += __shfl_xor(ss, 8);
          const float rs = rsqrtf(ss * (1.0f / 128.0f) + NORM_EPS); float g[8]; ld8f(a->in[I_GK] + l * 128 + 8 * (lane & 15), g);
          float y[8];
#pragma unroll
          for (int i = 0; i < 8; ++i) y[i] = x[i] * rs * g[i];
          if (lat) { const int s = lane & 15; rope8(y, 4, (s & 7) < 4, R128 + ((s >> 3) ? pcol : prow) * 32 + 8 * (s & 3)); }
          if (lane < 32) {
              if (lat) st8bf(KAL + ((size_t)b * SKV_L + PAST + t) * 256 + 8 * lane, y);
              else { st8bf(KAC + (size_t)r * 256 + 8 * lane, y); st8f(a->out + O_K + orow * 256 + 8 * lane, y); }
          } else { const int c = 8 * (lane - 32);
              if (lat) st8bf(VAL + ((size_t)b * SKV_L + PAST + t) * 256 + c, x);
              else { st8bf(VAC + (size_t)r * 256 + c, x); st8f(a->out + O_V + orow * 256 + c, x); }
          } }
#pragma unroll
        for (int k = 0; k < 2; ++k) { const int c = 8 * lane + 512 * k; float acc[8]; ld8f(a->in[I_LCB] + l * LRU_W + c, acc);
#pragma unroll
          for (int j = 0; j < 4; ++j) { const int tt = t + j - 1; if (tt >= 0 && tt < slen) { float xv[8], w[8]; ld8bf(pr + (ptrdiff_t)(j - 1) * NPROJ + C_XR + c, xv); ld8f(a->in[I_LCW] + ((size_t)l * 4 + j) * LRU_W + c, w);
#pragma unroll
              for (int i = 0; i < 8; ++i) acc[i] += w[i] * xv[i]; } }
          st8bf(XC + (size_t)r * LRU_W + c, acc); }
#pragma unroll
        for (int ps = 0; ps < 2; ++ps) { const int s = 64 * ps + lane; const bool act = (ps == 0) || lane < 32; const int s24 = s % 24;
#pragma unroll
          for (int i = 0; i < 8; ++i) x[i] = 0.f;
          if (act) ld8bf(pr + C_QM + 8 * s, x);
          if (lat) { float y[8];
#pragma unroll
              for (int i = 0; i < 8; ++i) y[i] = x[i];
              const int sr = (s24 - 16) & 7; rope8(y, 2, (sr & 3) < 2, R64 + ((sr >> 2) ? pcol : prow) * 16 + 8 * (sr & 1));
              if (s24 >= 16) {
#pragma unroll
                  for (int i = 0; i < 8; ++i) x[i] = y[i]; } }
          if (act) st8bf(QM + (size_t)r * 768 + 8 * s, x); }
        { ld8bf(pr + C_CKV + 8 * lane, x); float ss = 0.f;
#pragma unroll
          for (int i = 0; i < 8; ++i) ss += x[i] * x[i];
          const float rs = rsqrtf(wave_sum(ss) * (1.0f / 512.0f) + NORM_EPS); float g[8]; ld8f(a->in[I_GKV] + l * 512 + 8 * lane, g);
#pragma unroll
          for (int i = 0; i < 8; ++i) x[i] = x[i] * rs * g[i];
          st8bf(CKV + krow * 512 + 8 * lane, x); if (!lat) st8f(a->out + O_CKV + orow * 512 + 8 * lane, x); }
        { const int ll = lane & 7; ld8bf(pr + C_KR + 8 * ll, x);
          if (lat) rope8(x, 2, (ll & 3) < 2, R64 + ((ll >> 2) ? pcol : prow) * 16 + 8 * (ll & 1));
          if (lane < 8) { st8bf(KR + krow * 64 + 8 * lane, x); if (!lat) st8f(a->out + O_KR + orow * 64 + 8 * lane, x); } }
    }
}

namespace lru {
__device__ __forceinline__ void swap2(float x, float& lo, float& hh) { auto rr = __builtin_amdgcn_permlane32_swap(__float_as_uint(x), __float_as_uint(x), false, false); lo = __uint_as_float(rr[0]); hh = __uint_as_float(rr[1]); }
template <int DIR> __device__ __forceinline__ void compose(const f32x16& av, const f32x16& uv, float (&Aq)[4], float (&Bq)[4]) {
#pragma unroll
    for (int q = 0; q < 4; ++q) {
        if (DIR == 0) { float A = av[4 * q], B = uv[4 * q];
#pragma unroll
            for (int i = 1; i < 4; ++i) { B = B * av[4 * q + i] + uv[4 * q + i]; A *= av[4 * q + i]; }
            Aq[q] = A; Bq[q] = B; }
        else { float A = av[4 * q + 3], B = uv[4 * q + 3];
#pragma unroll
            for (int i = 2; i >= 0; --i) { B = B * av[4 * q + i] + uv[4 * q + i]; A *= av[4 * q + i]; }
            Aq[q] = A; Bq[q] = B; }
    }
}
template <int DIR> __device__ __forceinline__ float chain(const float (&Aq)[4], const float (&Bq)[4], float h0, int hi, float (&hin)[4]) {
    float hcur = h0;
#pragma unroll
    for (int qq = 0; qq < 4; ++qq) { const int q = DIR == 0 ? qq : 3 - qq;
        float lo, hh; const float t0 = Aq[q] * hcur + Bq[q]; swap2(t0, lo, hh);
        const float x0 = DIR == 0 ? lo : hh;
        const float t1 = Aq[q] * x0 + Bq[q]; swap2(t1, lo, hh);
        const bool first = DIR == 0 ? (hi == 0) : (hi == 1);
        hin[q] = first ? hcur : x0;
        hcur = DIR == 0 ? hh : lo; }
    return hcur;
}
template <int DIR> __device__ __forceinline__ void expand(const f32x16& av, const f32x16& uv, const float (&hin)[4], f32x16& h) {
#pragma unroll
    for (int q = 0; q < 4; ++q) { float s = hin[q];
        if (DIR == 0) {
#pragma unroll
            for (int i = 0; i < 4; ++i) { s = av[4 * q + i] * s + uv[4 * q + i]; h[4 * q + i] = s; } }
        else {
#pragma unroll
            for (int i = 3; i >= 0; --i) { s = av[4 * q + i] * s + uv[4 * q + i]; h[4 * q + i] = s; } }
    }
}
constexpr int LDS_W = 0, LDS_S = 131072, LDS_TIN = LDS_S + 8192, LDS_LRU = LDS_TIN + 2048;
static_assert(LDS_LRU <= RING_BYTES, "LRU LDS");
}

template <bool FINAL>
__device__ __forceinline__ void phase_lru(KArgs a, int l, char* lds, int wg, int G, int tid) {
    unsigned char* ws = a->ws; const bf16* XC = (const bf16*)(ws + WS_XC); const bf16* WGl = (const bf16*)(ws + WS_WG) + (size_t)l * 32 * 16384;
    const bf16* PROJ = (const bf16*)(ws + WS_PROJ); bf16* MIX = (bf16*)(ws + WS_MIX); float2* SUMM = (float2*)(ws + WS_SUMM);
    const int lane = tid & 63, w = __builtin_amdgcn_readfirstlane(tid >> 6), r32 = lane & 31, hi = lane >> 5;
    float2* S = (float2*)(lds + lru::LDS_S); float* TIN = (float*)(lds + lru::LDS_TIN);
    bf16x8 idb[2];
#pragma unroll
    for (int s = 0; s < 2; ++s)
#pragma unroll
        for (int i = 0; i < 8; ++i) idb[s][i] = (r32 - 16 * s - 8 * hi == i) ? (short)0x3F80 : (short)0;
    const int nunits = FINAL ? 96 * 8 : 64 * 8;
    const bool staged = (G & 7) == 0;
    if (staged) { const bf16* src = WGl + (size_t)(wg & 7) * 4 * 16384;
#pragma unroll 4
        for (int i = 0; i < 16; ++i) { const int q = tid + 512 * i, mat = q >> 11, row = (q >> 4) & 127, c16 = q & 15;
            *(bf16x8*)(lds + lru::LDS_W + mat * 32768 + KSWZ(row, c16 * 16)) = *(const bf16x8*)(src + (size_t)q * 8); }
        __syncthreads(); }
    int par = 0;
    for (int u = wg; u < nunits; u += G, par ^= 1) {
        const int n = u & 7, tile = FINAL ? (u >> 3) : 32 + (u >> 3); const bool lat = tile >= 32;
        const size_t row0 = (size_t)tile * 256 + (size_t)w * 32;
        if (FINAL && tid < 256) {
            const int dir = tid >> 7, ch = tid & 127, c = n * 128 + ch; float h = 0.f;
            if (lat) { const int b = (tile - 32) >> 4, jt = (tile - 32) & 15; h = a->in[I_ST][((size_t)(b * DEPTH + l) * 2 + dir) * LRU_W + c];
                float2 sv[15];
#pragma unroll
                for (int k = 0; k < 15; ++k) { const int jj = dir == 0 ? k : 15 - k; const bool use = dir == 0 ? (jj < jt) : (jj > jt);
                    sv[k] = use ? SUMM[(size_t)(dir * 64 + b * 16 + jj) * LRU_W + c] : make_float2(1.f, 0.f); }
#pragma unroll
                for (int k = 0; k < 15; ++k) h = sv[k].x * h + sv[k].y; }
            TIN[(par * 2 + dir) * 128 + ch] = h; }
        bf16x8 af[8];
        { const bf16* ap = XC + (row0 + r32) * LRU_W + n * 128 + hi * 8;
#pragma unroll
          for (int ks = 0; ks < 8; ++ks) af[ks] = *(const bf16x8*)(ap + ks * 16); }
#pragma unroll 1
        for (int nb = 0; nb < 4; ++nb) {
            const int c = n * 128 + nb * 32 + r32, buf = nb & 1;
            f32x16 av[2], uv[2];
            bf16x8 gf0, gf1;
            if (FINAL) { const bf16* gp = PROJ + (row0 + r32) * NPROJ + C_GR + n * 128 + hi * 8; gf0 = *(const bf16x8*)(gp + (2 * nb) * 16); gf1 = *(const bf16x8*)(gp + (2 * nb + 1) * 16); }
            {
                f32x16 xv = f32x16{};
#pragma unroll
                for (int ks = 0; ks < 8; ++ks) { if ((ks >> 1) == nb) xv = __builtin_amdgcn_mfma_f32_32x32x16_bf16(af[ks], idb[ks & 1], xv, 0, 0, 0); }
#pragma unroll
                for (int dir = 0; dir < 2; ++dir) {
                    f32x16 ga = f32x16{}, gx = f32x16{};
                    const bf16* bp0 = WGl + (size_t)((n * 2 + dir) * 2 + 0) * 16384 + (size_t)(nb * 32 + r32) * 128 + hi * 8; const bf16* bp1 = bp0 + 16384;
                    if (staged) { const char* lw = lds + lru::LDS_W + (dir * 2) * 32768; const int rw = nb * 32 + r32;
#pragma unroll
                        for (int ks = 0; ks < 8; ++ks) { const int cb = (ks * 16 + hi * 8) * 2; const bf16x8 b0 = *(const bf16x8*)(lw + KSWZ(rw, cb)), b1 = *(const bf16x8*)(lw + 32768 + KSWZ(rw, cb));
                            ga = __builtin_amdgcn_mfma_f32_32x32x16_bf16(af[ks], b0, ga, 0, 0, 0); gx = __builtin_amdgcn_mfma_f32_32x32x16_bf16(af[ks], b1, gx, 0, 0, 0); }
                    } else {
#pragma unroll
                        for (int ks = 0; ks < 8; ++ks) { const bf16x8 b0 = *(const bf16x8*)(bp0 + ks * 16), b1 = *(const bf16x8*)(bp1 + ks * 16);
                            ga = __builtin_amdgcn_mfma_f32_32x32x16_bf16(af[ks], b0, ga, 0, 0, 0); gx = __builtin_amdgcn_mfma_f32_32x32x16_bf16(af[ks], b1, gx, 0, 0, 0); } }
                    const float ba = a->in[I_LBA][(l * 2 + dir) * LRU_W + c], bx = a->in[I_LBX][(l * 2 + dir) * LRU_W + c], lam = a->in[I_LLAM][(l * 2 + dir) * LRU_W + c];
                    const float lsg = -log1pf(__expf(-lam)) * 8.0f;
#pragma unroll
                    for (int r = 0; r < 16; ++r) { const float rg = sigmoidf_(ga[r] + ba), ig = sigmoidf_(gx[r] + bx); const float aa = __expf(lsg * rg);
                        av[dir][r] = aa; uv[dir][r] = sqrtf(fmaxf(1.0f - aa * aa, 0.f)) * (ig * xv[r]); }
                    float Aq[4], Bq[4], hin[4]; float Bsb;
                    if (dir == 0) { lru::compose<0>(av[0], uv[0], Aq, Bq); Bsb = lru::chain<0>(Aq, Bq, 0.f, hi, hin); }
                    else { lru::compose<1>(av[1], uv[1], Aq, Bq); Bsb = lru::chain<1>(Aq, Bq, 0.f, hi, hin); }
                    float lo, hh; lru::swap2((Aq[0] * Aq[1]) * (Aq[2] * Aq[3]), lo, hh);
                    if (hi == 0) S[((buf * 2 + dir) * 8 + w) * 32 + r32] = make_float2(lo * hh, Bsb);
                }
            }
            __syncthreads();
            if (!FINAL) {
                if (tid < 64) { const int dir = tid >> 5, chl = tid & 31; float h = 0.f, P = 1.f;
                    if (dir == 0) { for (int ww = 0; ww < 8; ++ww) { const float2 s = S[((buf * 2 + 0) * 8 + ww) * 32 + chl]; h = s.x * h + s.y; P *= s.x; } }
                    else { for (int ww = 7; ww >= 0; --ww) { const float2 s = S[((buf * 2 + 1) * 8 + ww) * 32 + chl]; h = s.x * h + s.y; P *= s.x; } }
                    SUMM[(size_t)(dir * 64 + (tile - 32)) * LRU_W + n * 128 + nb * 32 + chl] = make_float2(P, h); }
            } else {
                float hf_in = TIN[(par * 2 + 0) * 128 + nb * 32 + r32], hb_in = TIN[(par * 2 + 1) * 128 + nb * 32 + r32];
                for (int ww = 0; ww < w; ++ww) { const float2 s = S[((buf * 2 + 0) * 8 + ww) * 32 + r32]; hf_in = s.x * hf_in + s.y; }
                for (int ww = 7; ww > w; --ww) { const float2 s = S[((buf * 2 + 1) * 8 + ww) * 32 + r32]; hb_in = s.x * hb_in + s.y; }
                f32x16 hsum;
                {   float Aq[4], Bq[4], hin[4]; f32x16 hf, hb;
                    lru::compose<0>(av[0], uv[0], Aq, Bq); const float endf = lru::chain<0>(Aq, Bq, hf_in, hi, hin); lru::expand<0>(av[0], uv[0], hin, hf);
                    lru::compose<1>(av[1], uv[1], Aq, Bq); const float endb = lru::chain<1>(Aq, Bq, hb_in, hi, hin); lru::expand<1>(av[1], uv[1], hin, hb);
                    hsum = hf + hb;
                    if (!lat && hi == 0) {
                        if (w == 7) a->out[O_ST + ((size_t)(tile * DEPTH + l) * 2 + 0) * LRU_W + c] = endf;
                        if (w == 0) a->out[O_ST + ((size_t)(tile * DEPTH + l) * 2 + 1) * LRU_W + c] = endb; } }
                f32x16 gv = f32x16{};
                gv = __builtin_amdgcn_mfma_f32_32x32x16_bf16(gf0, idb[0], gv, 0, 0, 0);
                gv = __builtin_amdgcn_mfma_f32_32x32x16_bf16(gf1, idb[1], gv, 0, 0, 0);
#pragma unroll
                for (int r = 0; r < 16; ++r) MIX[(row0 + att::crow(r, hi)) * DM + 512 + c] = (bf16)f2bf(hsum[r] * gelu_tanh(gv[r]));
            }
        }
    }
    __syncthreads();
}

__device__ __forceinline__ void phase_attention_gqa(KArgs a, char* lds, int wg, int G, int wave_id) {
    unsigned char* ws = a->ws;
    const bf16* QA = (const bf16*)(ws + WS_QA); const bf16* KAL = (const bf16*)(ws + WS_KAL); const bf16* VAL = (const bf16*)(ws + WS_VAL); const bf16* KAC = (const bf16*)(ws + WS_KAC); const bf16* VAC = (const bf16*)(ws + WS_VAC);
    bf16* MIX = (bf16*)(ws + WS_MIX);
    for (int u = wg; u < 384; u += G) {
        const bool lat = u < 256; int b, head, seq; size_t row0;
        if (lat) { const int x = u & 7, idx = u >> 3, qb = idx & 15; seq = SKV_L; b = x >> 1; head = (x & 1) * 2 + (idx >> 4); row0 = (size_t)M_C + (size_t)b * S_L + (size_t)qb * 256; }
        else { const int v = u - 256; b = v >> 2; head = v & 3; seq = S_C; row0 = (size_t)b * S_C; }
        const int kvh = head >> 1;
        const bf16* Kp = lat ? KAL + (size_t)b * SKV_L * 256 + kvh * 128 : KAC + (size_t)b * S_C * 256 + kvh * 128;
        const bf16* Vp = lat ? VAL + (size_t)b * SKV_L * 256 + kvh * 128 : VAC + (size_t)b * S_C * 256 + kvh * 128;
        att::attn_body<0, 2, 8, 512, 256, 64, 256, DM>(QA + row0 * 512 + head * 128, Kp, nullptr, Vp, MIX + row0 * DM + head * 128, seq, lds, wave_id);
    }
}
__device__ __forceinline__ void phase_attention_mla(KArgs a, char* lds, int wg, int G, int wave_id) {
    unsigned char* ws = a->ws;
    const bf16* QM = (const bf16*)(ws + WS_QM); const bf16* KVM = (const bf16*)(ws + WS_KVM); const bf16* KR = (const bf16*)(ws + WS_KR); bf16* MIX = (bf16*)(ws + WS_MIX);
    for (int u = wg; u < 384; u += G) {
        const bool lat = u < 256; int b, head, seq; size_t row0, key0;
        if (lat) { const int x = u & 7, idx = u >> 3, qb = idx & 15, p = x * 2 + (idx >> 4); seq = SKV_L; b = p >> 2; head = p & 3; row0 = (size_t)M_C + (size_t)b * S_L + (size_t)qb * 256; key0 = (size_t)M_C + (size_t)b * SKV_L; }
        else { const int v = u - 256; b = v >> 2; head = v & 3; seq = S_C; row0 = (size_t)b * S_C; key0 = row0; }
        att::attn_body<64, MLA_SD, MLA_NQR, 768, 1024, 64, 1024, DM>(QM + row0 * 768 + head * 192, KVM + key0 * 1024 + head * 128, KR + key0 * 64, KVM + key0 * 1024 + 512 + head * 128,
                                                                  MIX + row0 * DM + 1536 + head * 128, seq, lds, wave_id);
    }
}


#ifndef FFN_DBG
#define FFN_DBG 0
#endif
#ifndef DBG_SEL
#define DBG_SEL(r, c) 0
#endif
#ifndef DBG_REPORT
#define DBG_REPORT (10000.0f * (float)tot / (24576.0f * 5632.0f))
#endif
#ifndef FFN_UNFUSED
#define FFN_UNFUSED 0
#endif
__device__ __forceinline__ void phase_ffn_act_dbg(KArgs a, int l, int gtid, int NTHR) {
    const bf16* U = (const bf16*)(a->ws + WS_U); bf16* ACT = (bf16*)(a->ws + WS_ACT);
    const float* cw = a->in[I_FCW] + (size_t)l * 3 * NUP; const float* cb = a->in[I_FCB] + (size_t)l * NUP;
    constexpr int CG = DFF / 8;
    for (long i = gtid; i < (long)MTOK * CG; i += NTHR) {
        const int r = (int)(i / CG), c = (int)(i % CG) * 8; const bool lat = r >= M_C; const int t = lat ? (r - M_C) % S_L : r % S_C, slen = lat ? S_L : S_C;
        const int ucol = (c / 128) * 256 + (c % 128);
        float g[8], v[8]; ld8f(cb + c, g); ld8f(cb + DFF + c, v);
#pragma unroll
        for (int j = 0; j < 3; ++j) { const int tt = t + j - 1; if (tt >= 0 && tt < slen) { float xg[8], xv[8], wg_[8], wv[8]; const bf16* ur = U + (size_t)(r + j - 1) * NUP;
            ld8bf(ur + ucol, xg); ld8bf(ur + ucol + 128, xv); ld8f(cw + (size_t)j * NUP + c, wg_); ld8f(cw + (size_t)j * NUP + DFF + c, wv);
#pragma unroll
            for (int e = 0; e < 8; ++e) { g[e] += wg_[e] * xg[e]; v[e] += wv[e] * xv[e]; } } }
        float o[8];
#pragma unroll
        for (int e = 0; e < 8; ++e) o[e] = siluf_(g[e]) * v[e];
        st8bf(ACT + (size_t)r * DFF + c, o);
    }
}
__device__ __forceinline__ void phase_ffn_cmp_dbg(KArgs a, int l, int gtid, int NTHR) {
    const bf16* U = (const bf16*)(a->ws + WS_U); bf16* ACT = (bf16*)(a->ws + WS_ACT);
    const float* cw = a->in[I_FCW] + (size_t)l * 3 * NUP; const float* cb = a->in[I_FCB] + (size_t)l * NUP;
    constexpr int CG = DFF / 8;
    for (long i = gtid; i < (long)MTOK * CG; i += NTHR) {
        const int r = (int)(i / CG), c = (int)(i % CG) * 8; const bool lat = r >= M_C; const int t = lat ? (r - M_C) % S_L : r % S_C, slen = lat ? S_L : S_C;
        const int ucol = (c / 128) * 256 + (c % 128);
        float g[8], v[8]; ld8f(cb + c, g); ld8f(cb + DFF + c, v);
#pragma unroll
        for (int j = 0; j < 3; ++j) { const int tt = t + j - 1; if (tt >= 0 && tt < slen && (!CONV_CENTER_ONLY || j == 1)) { float xg[8], xv[8], wg_[8], wv[8]; const bf16* ur = U + (size_t)(r + j - 1) * NUP;
            ld8bf(ur + ucol, xg); ld8bf(ur + ucol + 128, xv); ld8f(cw + (size_t)j * NUP + c, wg_); ld8f(cw + (size_t)j * NUP + DFF + c, wv);
#pragma unroll
            for (int e = 0; e < 8; ++e) { g[e] += wg_[e] * xg[e]; v[e] += wv[e] * xv[e]; } } }
        float o[8];
#pragma unroll
        for (int e = 0; e < 8; ++e) o[e] = siluf_(g[e]) * v[e];
        if ((t & 255) != 0 && (t & 255) != 255) { float f[8]; ld8bf(ACT + (size_t)r * DFF + c, f); unsigned bad = 0;
#pragma unroll
            for (int e = 0; e < 8; ++e) bad += (fabsf(f[e] - o[e]) > 0.02f * (fabsf(o[e]) + 0.05f)) ? 1u : 0u;
            if (bad) atomicAdd((unsigned*)(a->ws + WS_CTL) + CW_CHK + DBG_SEL(r, c), bad); }
    }
}
__device__ __forceinline__ void phase_ffn_fix(KArgs a, int l, int gtid, int NTHR) {
    const bf16* HALO = (const bf16*)(a->ws + WS_HALO); bf16* ACT = (bf16*)(a->ws + WS_ACT);
    const float* cw = a->in[I_FCW] + (size_t)l * 3 * NUP; const float* cb = a->in[I_FCB] + (size_t)l * NUP;
    constexpr int CG = DFF / 8;
    for (int i = gtid; i < 64 * 2 * CG; i += NTHR) {
        const int lt = i / (2 * CG), side = (i / CG) & 1, c = (i % CG) * 8, jt = lt & 15;
        if ((side == 0 && jt == 0) || (side == 1 && jt == 15)) continue;
        const int pn = c / 128, cl = c % 128;
        const int t0 = side == 0 ? lt - 1 : lt, h0 = side == 0 ? 3 : 2, t1 = lt, h1 = side == 0 ? 0 : 3, t2 = side == 0 ? lt : lt + 1, h2 = side == 0 ? 1 : 0;
        float g[8], v[8]; ld8f(cb + c, g); ld8f(cb + DFF + c, v);
        const int tt[3] = {t0, t1, t2}, hh[3] = {h0, h1, h2};
#pragma unroll
        for (int j = 0; j < 3; ++j) { const bf16* hr = HALO + ((size_t)(tt[j] * 4 + hh[j]) * 44 + pn) * 256 + cl; float xg[8], xv[8], wg_[8], wv[8];
            ld8bf(hr, xg); ld8bf(hr + 128, xv); ld8f(cw + (size_t)j * NUP + c, wg_); ld8f(cw + (size_t)j * NUP + DFF + c, wv);
#pragma unroll
            for (int e = 0; e < 8; ++e) { g[e] += wg_[e] * xg[e]; v[e] += wv[e] * xv[e]; } }
        float o[8];
#pragma unroll
        for (int e = 0; e < 8; ++e) o[e] = siluf_(g[e]) * v[e];
        const size_t row = (size_t)M_C + (size_t)lt * 256 + (side ? 255 : 0);
        st8bf(ACT + row * DFF + c, o);
    }
}

#ifndef EN_AT2
#define EN_AT2 1
#endif
#ifndef REP_GEMM
#define REP_GEMM 1
#endif
#ifndef REP_AT
#define REP_AT 1
#endif
#ifndef REP_LRU
#define REP_LRU 1
#endif
#ifndef REP_RW
#define REP_RW 1
#endif
#ifndef EN_P0
#define EN_P0 1
#endif
#ifndef EN_P1
#define EN_P1 1
#endif
#ifndef EN_G1
#define EN_G1 1
#endif
#ifndef EN_PP
#define EN_PP 1
#endif
#ifndef EN_LG
#define EN_LG 1
#endif
#ifndef EN_LS
#define EN_LS 1
#endif
#ifndef EN_AT
#define EN_AT 1
#endif
#ifndef EN_LF
#define EN_LF 1
#endif
#ifndef EN_G2
#define EN_G2 1
#endif
#ifndef EN_R1
#define EN_R1 1
#endif
#ifndef EN_G3
#define EN_G3 1
#endif
#ifndef EN_FA
#define EN_FA 1
#endif
#ifndef EN_G4
#define EN_G4 1
#endif
#ifndef EN_R2
#define EN_R2 1
#endif
__global__ void __launch_bounds__(NTHREADS, 2) fwd_kernel(Args args) {
    extern __shared__ __attribute__((aligned(16))) unsigned char lds_raw[];
    const KArgs ka = (KArgs)__builtin_amdgcn_kernarg_segment_ptr();
    const int wave0 = __builtin_amdgcn_readfirstlane((int)threadIdx.x >> 6);
    const int G = gridDim.x, bx = blockIdx.x;
    const int vcu = (G % 8 == 0) ? (bx % 8) * (G / 8) + bx / 8 : bx;
    const int NGW = G * NWAVES, NTHR = G * NTHREADS;
#define PH_IDS const int tid = ltid(wave0), lane = tid & 63, wave = __builtin_amdgcn_readfirstlane(tid >> 6), gw = vcu * NWAVES + wave, gtid = vcu * NTHREADS + tid; (void)lane; (void)wave; (void)gw; (void)gtid; const KArgs a = launder(ka)
    LAS unsigned char* ldsL = (LAS unsigned char*)lds_raw; char* lds = (char*)lds_raw;
    volatile LAS unsigned* MISC = (volatile LAS unsigned*)(ldsL + MISC_OFF);
    for (int u = ltid(wave0); u < (LDS_BYTES - LDSCTL_OFF) / 4; u += NTHREADS) ((LAS unsigned*)(ldsL + LDSCTL_OFF))[u] = 0u;
    __syncthreads();
    unsigned* ctl = (unsigned*)(ka->ws + WS_CTL);
#if MK_MULTI
#define GRID_BAR() do { } while (0)
#else
    XcdBarrier bar = xcd_barrier_post(ctl + CW_BAR, MISC + 8, wave0);
#define GRID_BAR() xcd_barrier(bar)
#endif
    const int lo = ka->ph_lo, hi = ka->ph_hi;
#define IN(k) (lo <= (k) && (k) < hi)
#define SEAM(k) do { if (IN(k) && IN((k) + 1)) GRID_BAR(); else __syncthreads(); } while (0)
    if (EN_P0 && IN(0)) { PH_IDS; phase_prologue(a, lds, gw, NGW, wave, lane); } SEAM(0);
    if (EN_P0 && IN(1)) { PH_IDS; phase_mod_reduce(a, gtid, NTHR); } SEAM(1);
    if (EN_P1 && IN(2)) { PH_IDS; phase_first_norm(a, gw, NGW, lane); } SEAM(2);

    for (int l = 0; l < DEPTH; ++l) {
        const int pb = PH_PRE + l * PH_PER_LAYER;
        if (EN_G1 && IN(pb + 0)) {
            unsigned char* ws = launder(ka)->ws;
            pg8::Gemm g{(const bf16*)(ws + WS_H), (const bf16*)(ws + WS_WIN) + (size_t)l * NPROJ * DM, MTOK, NPROJ, DM}; pg8::StaticOrder S; S.init(MTOK, NPROJ, G, bx);
            pg8::EpiBf16<0> E{(bf16*)(ws + WS_PROJ), NPROJ, nullptr, 0, 0, 1.f};
            for (int rep = 0; rep < REP_GEMM; ++rep) { pg8::gemm_phase<pg8::EpiBf16<0>, pg8::StaticOrder, true, true>(ldsL, g, S, E, wave0); if (rep + 1 < REP_GEMM) __syncthreads(); }
        } SEAM(pb + 0);
        if (EN_PP && IN(pb + 1)) { PH_IDS; for (int rep = 0; rep < REP_RW; ++rep) phase_postproj(a, l, gw, NGW, lane); } SEAM(pb + 1);
        if (EN_LG && IN(pb + 2)) {
            { PH_IDS; for (int rep = 0; rep < REP_LRU; ++rep) phase_lru<false>(a, l, lds, bx, G, tid); }
            __syncthreads();
            unsigned char* ws = launder(ka)->ws;
            pg8::Gemm g{(const bf16*)(ws + WS_CKV), (const bf16*)(ws + WS_WKV) + (size_t)l * 1024 * 512, MKEY, 1024, 512}; pg8::StaticOrder S; S.init(MKEY, 1024, G, bx);
            pg8::EpiBf16<0> E{(bf16*)(ws + WS_KVM), 1024, nullptr, 0, 0, 1.f};
            for (int rep = 0; rep < REP_GEMM; ++rep) { pg8::gemm_phase<pg8::EpiBf16<0>, pg8::StaticOrder, true, true>(ldsL, g, S, E, wave0); if (rep + 1 < REP_GEMM) __syncthreads(); }
        } SEAM(pb + 2);
        if (IN(pb + 3)) { if (EN_LS) { PH_IDS; for (int rep = 0; rep < REP_LRU; ++rep) phase_lru<true>(a, l, lds, bx, G, tid); } __syncthreads();
            if (EN_AT) { PH_IDS; for (int rep = 0; rep < REP_AT; ++rep) phase_attention_gqa(a, lds, bx, G, wave0); }
            if (EN_AT2) { PH_IDS; for (int rep = 0; rep < REP_AT; ++rep) phase_attention_mla(a, lds, bx, G, wave0); } } SEAM(pb + 3);
        if (EN_G2 && IN(pb + 4)) {
            unsigned char* ws = launder(ka)->ws;
            pg8::Gemm g{(const bf16*)(ws + WS_MIX), (const bf16*)(ws + WS_WOUT) + (size_t)l * DM * DM, MTOK, DM, DM}; pg8::StaticOrder S; S.init(MTOK, DM, G, bx);
            pg8::EpiF32 E{(float*)(ws + WS_MO), DM, nullptr};
            for (int rep = 0; rep < REP_GEMM; ++rep) { pg8::gemm_phase<pg8::EpiF32, pg8::StaticOrder, true, true>(ldsL, g, S, E, wave0); if (rep + 1 < REP_GEMM) __syncthreads(); }
        } SEAM(pb + 4);
        if (EN_R1 && IN(pb + 5)) { PH_IDS; phase_residual(a, l, 0, gw, NGW, lane); } SEAM(pb + 5);
        if (EN_G3 && IN(pb + 6)) {
            const KArgs a = launder(ka); unsigned char* ws = a->ws;
            pg8::Gemm g{(const bf16*)(ws + WS_H), (const bf16*)(ws + WS_WUP) + (size_t)l * NUP * DM, MTOK, NUP, DM}; pg8::StaticOrder S; S.init(MTOK, NUP, G, bx);
#if FFN_UNFUSED
            pg8::EpiBf16<0> E{(bf16*)(ws + WS_U), NUP, nullptr, 0, 0, 1.f};
            pg8::gemm_phase<pg8::EpiBf16<0>, pg8::StaticOrder, true, true>(ldsL, g, S, E, wave0);
#else
            pg8::EpiFfnAct E{(bf16*)(ws + WS_ACT), DFF, a->in[I_FCW] + (size_t)l * 3 * NUP, a->in[I_FCB] + (size_t)l * NUP, NUP, DFF, (bf16*)(ws + WS_HALO), (LAS float*)(ldsL + 131072)};
            for (int rep = 0; rep < REP_GEMM; ++rep) { pg8::gemm_phase<pg8::EpiFfnAct, pg8::StaticOrder, true, true>(ldsL, g, S, E, wave0); if (rep + 1 < REP_GEMM) __syncthreads(); }
#endif
#if FFN_DBG
            if (l == 0) { __syncthreads(); pg8::EpiBf16<0> E2{(bf16*)(ws + WS_U), NUP, nullptr, 0, 0, 1.f};
                pg8::gemm_phase<pg8::EpiBf16<0>, pg8::StaticOrder, true, true>(ldsL, g, S, E2, wave0); }
#endif
        } SEAM(pb + 6);
        if (EN_FA && IN(pb + 7)) { PH_IDS; for (int rep = 0; rep < REP_RW; ++rep) { if (FFN_UNFUSED) phase_ffn_act_dbg(a, l, gtid, NTHR); else { if (FFN_DBG && l == 0) phase_ffn_cmp_dbg(a, l, gtid, NTHR); phase_ffn_fix(a, l, gtid, NTHR); } } } SEAM(pb + 7);
        if (EN_G4 && IN(pb + 8)) {
            unsigned char* ws = launder(ka)->ws;
            pg8::Gemm g{(const bf16*)(ws + WS_ACT), (const bf16*)(ws + WS_WDN) + (size_t)l * DM * DFF, MTOK, DM, DFF}; pg8::StaticOrder S; S.init(MTOK, DM, G, bx);
            pg8::EpiF32 E{(float*)(ws + WS_MO), DM, nullptr};
            for (int rep = 0; rep < REP_GEMM; ++rep) { pg8::gemm_phase<pg8::EpiF32, pg8::StaticOrder, true, true>(ldsL, g, S, E, wave0); if (rep + 1 < REP_GEMM) __syncthreads(); }
        } SEAM(pb + 8);
        if (EN_R2 && IN(pb + 9)) { PH_IDS; phase_residual(a, l, 1, gw, NGW, lane); } SEAM(pb + 9);
    }
#if FFN_DBG
    if (bx == 0 && ltid(wave0) == 0) { const unsigned* chk = (const unsigned*)(ka->ws + WS_CTL) + CW_CHK; unsigned tot = 0; for (int i = 0; i < 16; ++i) tot += __hip_atomic_load(chk + i, __ATOMIC_RELAXED, __HIP_MEMORY_SCOPE_AGENT);
        ka->out[0] = DBG_REPORT; }
#endif
#undef IN
#undef SEAM
}

extern "C" void kernel_launch(void* const* d_in, const int* in_sizes, int n_in, void* d_out, int out_size, void* d_ws, size_t ws_size, hipStream_t stream) {
    static int grid = 0;
    if (grid == 0) {
        if (n_in != N_IN || (size_t)out_size != O_END || ws_size < WS_END) { fprintf(stderr, "kernel_launch: unexpected shapes: n_in %d out %d ws %zu (need %zu)\n", n_in, out_size, ws_size, (size_t)WS_END); grid = -1; return; }
        int dev = 0, cus = 0, per_cu = 0;
        if (hipGetDevice(&dev) != hipSuccess || hipDeviceGetAttribute(&cus, hipDeviceAttributeMultiprocessorCount, dev) != hipSuccess) { grid = -1; return; }
        if (hipFuncSetAttribute((const void*)fwd_kernel, hipFuncAttributeMaxDynamicSharedMemorySize, LDS_BYTES) != hipSuccess) { fprintf(stderr, "kernel_launch: hipFuncSetAttribute failed\n"); grid = -1; return; }
        if (hipOccupancyMaxActiveBlocksPerMultiprocessor(&per_cu, (const void*)fwd_kernel, NTHREADS, LDS_BYTES) != hipSuccess || per_cu < 1) { fprintf(stderr, "kernel_launch: occupancy query says %d blocks per CU\n", per_cu); (void)hipGetLastError(); grid = -1; return; }
        grid = cus;
    }
    if (grid < 0) return;
    (void)hipMemsetAsync((char*)d_ws + WS_CTL, 0, CTL_ZERO_BYTES, stream);
    Args a{};
    for (int i = 0; i < N_IN; ++i) a.in[i] = (const float*)d_in[i];
    a.out = (float*)d_out; a.ws = (unsigned char*)d_ws;
#if MK_MULTI
    for (int p = 0; p < PH_TOTAL; ++p) { a.ph_lo = p; a.ph_hi = p + 1; hipLaunchKernelGGL(fwd_kernel, dim3(grid), dim3(NTHREADS), LDS_BYTES, stream, a); }
#else
    a.ph_lo = 0; a.ph_hi = PH_TOTAL; hipLaunchKernelGGL(fwd_kernel, dim3(grid), dim3(NTHREADS), LDS_BYTES, stream, a);
#endif
    const hipError_t le = hipPeekAtLastError();
    if (le != hipSuccess) fprintf(stderr, "kernel_launch: launch failed: %s\n", hipGetErrorName(le));
}
```

```cpp
#include <hip/hip_runtime.h>
#include <cstdio>
#include <cstdint>
#ifndef MK_MULTI
#define MK_MULTI 0
#endif
__device__ __forceinline__ unsigned vlane() { unsigned lane; asm volatile("v_mbcnt_lo_u32_b32 %0, -1, 0\n\tv_mbcnt_hi_u32_b32 %0, -1, %0" : "=v"(lane)); return lane; }
__device__ __forceinline__ int ltid(int wave) { int lane; asm volatile("v_mbcnt_lo_u32_b32 %0, -1, 0\n\tv_mbcnt_hi_u32_b32 %0, -1, %0" : "=v"(lane));
    const int t = wave * 64 + lane; __builtin_assume(t >= 0 && t < 512); return t; }

#ifndef PG8_NT_STORE
#define PG8_NT_STORE 0
#endif
namespace pg8 {
#define PG8_LAS __attribute__((address_space(3)))
typedef unsigned short bf16_t;
typedef short bf16x8 __attribute__((ext_vector_type(8)));
typedef float f32x4 __attribute__((ext_vector_type(4)));
typedef unsigned u32x4 __attribute__((ext_vector_type(4)));
constexpr int BM = 256, BK = 64, HALF = 128, HTB = HALF * BK * 2  , STAGE_BYTES = 8 * HTB, NXCD = 8, WGM = 8;

__host__ __device__ __forceinline__ int lds_byte(int r, int c) { const int st = (r >> 4) * 2 + (c >> 5), rr = r & 15, cc = c & 31, ob = rr * 64 + cc * 2; return st * 1024 + (ob ^ (((ob >> 9) & 1) << 5)); }
__host__ __device__ __forceinline__ void stage_rc(int b, int& R, int& C) { const int st = b / 1024, sb = b % 1024, swz = sb ^ (((sb >> 9) & 1) << 5); R = (st >> 1) * 16 + swz / 64; C = (st & 1) * 32 + (swz % 64) / 2; }
__host__ __device__ __forceinline__ int perm32(int rho) { const int n = rho >> 4, i = rho & 15; return 8 * (i >> 2) + 4 * n + (i & 3); }

struct Unit { int pm, pn; };
struct Gemm { const bf16_t* A; const bf16_t* Bt; int M, N, K; };

struct StaticOrder {
    int nM, nN, nwg, G, c;
    __host__ __device__ void init(int M, int N, int G_, int c_) { nM = M / BM; nN = N / BM; nwg = nM * nN; G = G_; c = c_; }
    __host__ __device__ bool next(int i, Unit& u) const {
        const long L = (long)i * G + c; if (L >= nwg) return false;
        int wgid = (int)L; { const int q = nwg / NXCD, r = nwg % NXCD, xcd = wgid % NXCD, off = wgid / NXCD; wgid = (xcd < r ? xcd * (q + 1) : r * (q + 1) + (xcd - r) * q) + off; }
        const int nig = WGM * nN, gid = wgid / nig, fm = gid * WGM, gsz = (nM - fm) < WGM ? (nM - fm) : WGM;
        u.pm = fm + ((wgid % nig) % gsz); u.pn = (wgid % nig) / gsz; return true;
    }
    __device__ __forceinline__ void a_ready(const Unit&) const {}
    __device__ __forceinline__ void done(const Unit&) const {}
};

__device__ __forceinline__ unsigned cvt_pk_bf16(float lo, float hi) { unsigned r; asm volatile("v_cvt_pk_bf16_f32 %0, %1, %2" : "=v"(r) : "v"(lo), "v"(hi)); return r; }
typedef float f32x2 __attribute__((ext_vector_type(2)));
__device__ __forceinline__ f32x2 gelu_pk(f32x2 v) {
    const f32x2 av = __builtin_elementwise_abs(v), d = av * 0.2316418882f + 1.0f;
    f32x2 t; t.x = __builtin_amdgcn_rcpf(d.x); t.y = __builtin_amdgcn_rcpf(d.y);
    f32x2 q = t * 0.5307027145f + (-0.7265760135f); q = q * t + 0.7107068705f; q = q * t + (-0.142248368f); q = q * t + 0.127414796f; q = q * t;
    const f32x2 s = (v * v) * (-0.72134752044f);
    f32x2 e; e.x = __builtin_amdgcn_exp2f(s.x); e.y = __builtin_amdgcn_exp2f(s.y);
    const f32x2 m = v * (q * e), r = v - m;
    f32x2 o; o.x = v.x < 0.f ? m.x : r.x; o.y = v.y < 0.f ? m.y : r.y; return o;
}

template <int ACT  > struct EpiBf16 {
    static constexpr bool PERM = true, AFTER_DRAIN = false; static_assert(ACT == 0 || ACT == 1, "EpiBf16: ACT is 0 (none) or 1 (gelu_pk)");
    bf16_t* O; int ldc; const float* bias; int split_cols; size_t split_stride; float scale0;
    __device__ __forceinline__ void operator()(const f32x4 (&acc)[2][2][4][2], const Unit& u, int wr, int wc, int fr, int fq) const {
        const int row0 = u.pm * BM + wr * 64 + fr; int colt = u.pn * BM; bf16_t* base = O;
        float sc = 1.f; if (split_cols) { const int t = colt / split_cols; base += (size_t)t * split_stride; colt -= t * split_cols; if (t == 0) sc = scale0; }
        const int col0 = colt + wc * 32 + 8 * fq, bcol0 = u.pn * BM + wc * 32 + 8 * fq;
        f32x4 bv[2][2];
#pragma unroll
        for (int bj = 0; bj < 2; ++bj)
#pragma unroll
            for (int n = 0; n < 2; ++n) bv[bj][n] = bias ? *(const f32x4*)(bias + bcol0 + bj * HALF + 4 * n) : (f32x4){0.f, 0.f, 0.f, 0.f};
#pragma unroll
        for (int ai = 0; ai < 2; ++ai)
#pragma unroll
            for (int m = 0; m < 4; ++m) { bf16_t* rowp = base + (size_t)(row0 + ai * HALF + m * 16) * ldc + col0;
#pragma unroll
                for (int bj = 0; bj < 2; ++bj) { f32x4 v0 = acc[ai][bj][m][0] + bv[bj][0], v1 = acc[ai][bj][m][1] + bv[bj][1];
                    if (ACT == 1) { f32x2 a = gelu_pk((f32x2){v0[0], v0[1]}), b = gelu_pk((f32x2){v0[2], v0[3]}), c = gelu_pk((f32x2){v1[0], v1[1]}), d = gelu_pk((f32x2){v1[2], v1[3]});
                        v0 = (f32x4){a.x, a.y, b.x, b.y}; v1 = (f32x4){c.x, c.y, d.x, d.y}; }
                    v0 = v0 * sc; v1 = v1 * sc; u32x4 w; w.x = cvt_pk_bf16(v0[0], v0[1]); w.y = cvt_pk_bf16(v0[2], v0[3]); w.z = cvt_pk_bf16(v1[0], v1[1]); w.w = cvt_pk_bf16(v1[2], v1[3]);
                    if (PG8_NT_STORE) __builtin_nontemporal_store(w, (u32x4*)(rowp + bj * HALF)); else *(u32x4*)(rowp + bj * HALF) = w; } }
    }
};
#ifndef CONV_CENTER_ONLY
#define CONV_CENTER_ONLY 0
#endif
struct EpiF32 {
    static constexpr bool PERM = false, AFTER_DRAIN = false;
    float* C; int ldc; const float* bias;
    __device__ __forceinline__ void operator()(const f32x4 (&acc)[2][2][4][2], const Unit& u, int wr, int wc, int fr, int fq) const {
        const int row0 = u.pm * BM + wr * 64 + fr, col0 = u.pn * BM + wc * 32 + 4 * fq;
        f32x4 bv[2][2];
#pragma unroll
        for (int bj = 0; bj < 2; ++bj)
#pragma unroll
            for (int n = 0; n < 2; ++n) bv[bj][n] = bias ? *(const f32x4*)(bias + col0 + bj * HALF + n * 16) : (f32x4){0.f, 0.f, 0.f, 0.f};
#pragma unroll
        for (int ai = 0; ai < 2; ++ai)
#pragma unroll
            for (int m = 0; m < 4; ++m) { float* rowp = C + (size_t)(row0 + ai * HALF + m * 16) * ldc + col0;
#pragma unroll
                for (int bj = 0; bj < 2; ++bj)
#pragma unroll
                    for (int n = 0; n < 2; ++n) *(f32x4*)(rowp + bj * HALF + n * 16) = acc[ai][bj][m][n] + bv[bj][n]; }
    }
};

struct EpiFfnAct {
    static constexpr bool PERM = true, AFTER_DRAIN = false;
    bf16_t* ACT; int ldact; const float* cw; const float* cb; int nup, dff; bf16_t* HALO; PG8_LAS float* xr;
    __device__ __forceinline__ void operator()(const f32x4 (&acc)[2][2][4][2], const Unit& u, int wr, int wc, int fr_, int fq_) const {
        int fr = fr_, fq = fq_; asm volatile("" : "+v"(fr), "+v"(fq));
        const int lane = fq * 16 + fr, colw = wc * 32 + 8 * fq, ch0 = u.pn * 128 + colw;
        PG8_LAS float* cwl_lds = xr + 2048;
        { const int tid = (wr * 4 + wc) * 64 + lane;
          if (tid < 256) { const int sbj = tid >> 7, st = (tid >> 5) & 3, c4 = tid & 31;
              const float* src = (st < 3 ? cw + (size_t)st * nup : cb) + sbj * dff + u.pn * 128 + 4 * c4;
              *(PG8_LAS f32x4*)(cwl_lds + (sbj * 4 + st) * 128 + 4 * c4) = *(const f32x4*)src; } }
#pragma unroll
        for (int ai = 0; ai < 2; ++ai)
#pragma unroll
            for (int bj = 0; bj < 2; ++bj)
#pragma unroll
                for (int n = 0; n < 2; ++n) { const int idx = (ai * 2 + wr) * 256 + bj * 128 + colw + 4 * n;
                    if (fr == 0) *(PG8_LAS f32x4*)(xr + idx) = acc[ai][bj][0][n];
                    if (fr == 15) *(PG8_LAS f32x4*)(xr + 1024 + idx) = acc[ai][bj][3][n]; }
        asm volatile("s_waitcnt lgkmcnt(0)" ::: "memory"); __builtin_amdgcn_s_barrier(); asm volatile("" ::: "memory");
        const int srcP = ((lane & 48) | ((fr + 15) & 15)) * 4, srcN = ((lane & 48) | ((fr + 1) & 15)) * 4;
        const f32x4 z4 = (f32x4){0.f, 0.f, 0.f, 0.f};
        typedef unsigned u32x2_t __attribute__((ext_vector_type(2)));
#pragma unroll
        for (int ai = 0; ai < 2; ++ai) { const int blk = ai * 2 + wr;
            u32x2_t keep[4];
#pragma unroll
            for (int n = 0; n < 2; ++n) {
                f32x4 og[4];
#pragma unroll
                for (int bj = 0; bj < 2; ++bj) { const int xi = bj * 128 + colw + 4 * n; const PG8_LAS float* wl = cwl_lds + bj * 512 + colw + 4 * n;
                    const f32x4 w0 = *(const PG8_LAS f32x4*)(wl), w1 = *(const PG8_LAS f32x4*)(wl + 128), w2 = *(const PG8_LAS f32x4*)(wl + 256), bb = *(const PG8_LAS f32x4*)(wl + 384);
                    const f32x4 XP = blk > 0 ? *(const PG8_LAS f32x4*)(xr + 1024 + (blk - 1) * 256 + xi) : z4, XN = blk < 3 ? *(const PG8_LAS f32x4*)(xr + (blk + 1) * 256 + xi) : z4;
#pragma unroll
                    for (int c = 0; c < 4; ++c) { float R[4], L[4];
#pragma unroll
                        for (int m = 0; m < 4; ++m) { const float tv = acc[ai][bj][m][n][c]; const int ti = __float_as_int(tv);
                            R[m] = __int_as_float(__builtin_amdgcn_update_dpp(0, ti, 0x121, 0xf, 0xf, false));
                            L[m] = __int_as_float(__builtin_amdgcn_update_dpp(0, ti, 0x12F, 0xf, 0xf, false)); }
#pragma unroll
                        for (int m = 0; m < 4; ++m) { const float prev = fr > 0 ? R[m] : (m > 0 ? R[m > 0 ? m - 1 : 0] : XP[c]), next = fr < 15 ? L[m] : (m < 3 ? L[m < 3 ? m + 1 : 3] : XN[c]);
                            const float o = bb[c] + (CONV_CENTER_ONLY ? 0.f : w0[c] * prev) + w1[c] * acc[ai][bj][m][n][c] + (CONV_CENTER_ONLY ? 0.f : w2[c] * next);
                            if (bj == 0) og[m][c] = o * __builtin_amdgcn_rcpf(1.0f + __builtin_amdgcn_exp2f(o * -1.4426950408889634f)); else og[m][c] *= o; } }
                    __builtin_amdgcn_sched_barrier(0); }
#pragma unroll
                for (int m = 0; m < 4; ++m) { const size_t row = (size_t)u.pm * BM + ai * HALF + wr * 64 + m * 16 + fr;
                    u32x2_t w; w.x = cvt_pk_bf16(og[m][0], og[m][1]); w.y = cvt_pk_bf16(og[m][2], og[m][3]);
                    if (n == 0) keep[m] = w; else { u32x4 w4; w4.x = keep[m].x; w4.y = keep[m].y; w4.z = w.x; w4.w = w.y; if (PG8_NT_STORE) __builtin_nontemporal_store(w4, (u32x4*)(ACT + row * ldact + ch0)); else *(u32x4*)(ACT + row * ldact + ch0) = w4; } }
                __builtin_amdgcn_sched_barrier(0); } }
        if (u.pm >= 32) {
            const bool top = (wr == 0) && fr < 2, bot = (wr == 1) && fr >= 14;
            if (top || bot) { const int ai = top ? 0 : 1, m = top ? 0 : 3, hrow = top ? fr : 2 + (fr - 14);
#pragma unroll
                for (int bj = 0; bj < 2; ++bj) { const f32x4 v0 = top ? acc[0][bj][0][0] : acc[1][bj][3][0], v1 = top ? acc[0][bj][0][1] : acc[1][bj][3][1];
                    u32x4 w; w.x = cvt_pk_bf16(v0[0], v0[1]); w.y = cvt_pk_bf16(v0[2], v0[3]); w.z = cvt_pk_bf16(v1[0], v1[1]); w.w = cvt_pk_bf16(v1[2], v1[3]);
                    *(u32x4*)(HALO + ((size_t)((u.pm - 32) * 4 + hrow) * (nup / 256) + u.pn) * 256 + bj * 128 + colw) = w; }
                (void)ai; (void)m; } }
    }
};
template <class Epi, class Sched, bool ALIGN_EPI = false, bool SP2 = false>
__device__ __forceinline__ void gemm_phase(PG8_LAS unsigned char* lds, const Gemm g, const Sched& S, const Epi& E, const int wave_id) {
    const int tid = ltid(wave_id), wid = __builtin_amdgcn_readfirstlane(tid >> 6), lane = tid & 63, wr = wid >> 2, wc = wid & 3, fr = lane & 15, fq = lane >> 4;
    const int K = g.K, nt = K / BK;
    unsigned voffA[2], voffB[2];
#pragma unroll
    for (int i = 0; i < 2; ++i) { int R, C; stage_rc(tid * 16 + i * 8192, R, C); const int Rb = Epi::PERM ? ((R & ~31) + perm32(R & 31)) : R;
        voffA[i] = (unsigned)(R * K + C) * 2u; voffB[i] = (unsigned)(Rb * K + C) * 2u; }
    const size_t kstep = (size_t)(BK * 2);
    const size_t hstep = (size_t)HALF * K * 2;
    const size_t tstep = 2 * hstep;
    const unsigned ldsw = (unsigned)wid * 1024u;
    const int aoff = lds_byte(wr * 64 + fr, fq * 8), boff = lds_byte(wc * 32 + fr, fq * 8);
#define PG8_SA(b, h) (((b) * 2 + (h)) * HTB)
#define PG8_SB(b, h) ((4 + (b) * 2 + (h)) * HTB)
#define PG8_STAGE(bufoff, gbase, voff) do { _Pragma("unroll") for (int _i = 0; _i < 2; ++_i) \
        __builtin_amdgcn_global_load_lds((const unsigned*)((const char*)(gbase) + (voff)[_i]), (PG8_LAS unsigned*)(lds + (bufoff) + ldsw + _i * 8192), 16, 0, 0); } while (0)
#define PG8_LDA(dst, b, h) do { _Pragma("unroll") for (int m = 0; m < 4; ++m) _Pragma("unroll") for (int k = 0; k < 2; ++k) dst[m][k] = *(const PG8_LAS bf16x8*)(lds + PG8_SA(b, h) + aoff + m * 2048 + k * 1024); } while (0)
#define PG8_LDB(dst, b, h) do { _Pragma("unroll") for (int n = 0; n < 2; ++n) _Pragma("unroll") for (int k = 0; k < 2; ++k) dst[n][k] = *(const PG8_LAS bf16x8*)(lds + PG8_SB(b, h) + boff + n * 2048 + k * 1024); } while (0)
#define PG8_MMA(ai, bj, At, Bt) do { __builtin_amdgcn_s_setprio(1); _Pragma("unroll") for (int m = 0; m < 4; ++m) _Pragma("unroll") for (int n = 0; n < 2; ++n) _Pragma("unroll") for (int k = 0; k < 2; ++k) \
        acc[ai][bj][m][n] = __builtin_amdgcn_mfma_f32_16x16x32_bf16(Bt[n][k], At[m][k], acc[ai][bj][m][n], 0, 0, 0); __builtin_amdgcn_s_setprio(0); } while (0)
#define PG8_WAIT_V(n) asm volatile("s_waitcnt vmcnt(" #n ")" ::: "memory")
#define PG8_WAIT_L(n) asm volatile("s_waitcnt lgkmcnt(" #n ")" ::: "memory")
#define PG8_BAR __builtin_amdgcn_s_barrier()
#define PG8_SCHED __builtin_amdgcn_sched_barrier(0)
    Unit cur, nxt; int ui = 0;
    if (!S.next(0, cur)) return;
    f32x4 acc[2][2][4][2];
#pragma unroll
    for (int a = 0; a < 2; ++a)
#pragma unroll
        for (int b = 0; b < 2; ++b)
#pragma unroll
            for (int m = 0; m < 4; ++m)
#pragma unroll
                for (int n = 0; n < 2; ++n) acc[a][b][m][n] = (f32x4){0.f, 0.f, 0.f, 0.f};
    bf16x8 At[4][2], B0[2][2], B1[2][2];
    const char* cA = (const char*)g.A + (size_t)cur.pm * tstep; const char* cB = (const char*)g.Bt + (size_t)cur.pn * tstep;
    S.a_ready(cur);
    if constexpr (SP2) {
        PG8_STAGE(PG8_SB(0, 0), cB, voffB); PG8_STAGE(PG8_SB(0, 1), cB + hstep, voffB); PG8_STAGE(PG8_SA(0, 0), cA, voffA); PG8_STAGE(PG8_SA(0, 1), cA + hstep, voffA);
        if (wr == 1) PG8_BAR;
        PG8_WAIT_V(2); PG8_BAR;
        PG8_STAGE(PG8_SB(1, 0), cB + kstep, voffB); PG8_STAGE(PG8_SA(1, 0), cA + kstep, voffA); PG8_STAGE(PG8_SB(1, 1), cB + hstep + kstep, voffB);
        PG8_WAIT_V(6); PG8_BAR;
    } else {
        PG8_STAGE(PG8_SB(0, 0), cB, voffB); PG8_STAGE(PG8_SA(0, 0), cA, voffA); PG8_STAGE(PG8_SB(0, 1), cB + hstep, voffB); PG8_STAGE(PG8_SA(0, 1), cA + hstep, voffA);
        if (wr == 1) PG8_BAR;
        PG8_WAIT_V(4); PG8_BAR;
        PG8_STAGE(PG8_SB(1, 0), cB + kstep, voffB); PG8_STAGE(PG8_SA(1, 0), cA + kstep, voffA); PG8_STAGE(PG8_SB(1, 1), cB + hstep + kstep, voffB);
        PG8_WAIT_V(6); PG8_BAR;
    }
    for (;;) {
        const bool has_next = S.next(ui + 1, nxt);
        const char* nA = has_next ? (const char*)g.A + (size_t)nxt.pm * tstep : cA; const char* nB = has_next ? (const char*)g.Bt + (size_t)nxt.pn * tstep : cB;
        for (int t = 0; t < nt; t += 2) {
            const bool last = (t == nt - 2);
            const char* a1 = cA + (size_t)(t + 1) * kstep;
            const char* a2 = last ? nA : cA + (size_t)(t + 2) * kstep; const char* b2 = last ? nB : cB + (size_t)(t + 2) * kstep;
            const char* a3 = a2 + kstep; const char* b3 = b2 + kstep;
            if (last && has_next) S.a_ready(nxt);
            if constexpr (SP2) {
            PG8_LDB(B0, 0, 0); PG8_LDB(B1, 0, 1); PG8_SCHED; PG8_LDA(At, 0, 0); PG8_STAGE(PG8_SA(1, 1), a1 + hstep, voffA);
            PG8_WAIT_V(8); PG8_WAIT_L(0); PG8_BAR; PG8_MMA(0, 0, At, B0); PG8_MMA(0, 1, At, B1); PG8_BAR; PG8_SCHED;
            PG8_LDA(At, 0, 1); PG8_STAGE(PG8_SB(0, 0), b2, voffB); PG8_STAGE(PG8_SB(0, 1), b2 + hstep, voffB); PG8_STAGE(PG8_SA(0, 0), a2, voffA);
            PG8_WAIT_V(8); PG8_WAIT_L(0); PG8_BAR; PG8_MMA(1, 0, At, B0); PG8_MMA(1, 1, At, B1); PG8_BAR; PG8_SCHED;
            PG8_LDB(B0, 1, 0); PG8_LDB(B1, 1, 1); PG8_SCHED; PG8_LDA(At, 1, 0); PG8_STAGE(PG8_SA(0, 1), a2 + hstep, voffA);
            PG8_WAIT_V(8); PG8_WAIT_L(0); PG8_BAR; PG8_MMA(0, 0, At, B0); PG8_MMA(0, 1, At, B1); PG8_BAR; PG8_SCHED;
            PG8_LDA(At, 1, 1); PG8_STAGE(PG8_SB(1, 0), b3, voffB); PG8_STAGE(PG8_SB(1, 1), b3 + hstep, voffB); PG8_STAGE(PG8_SA(1, 0), a3, voffA);
            PG8_WAIT_V(8); PG8_WAIT_L(0); PG8_BAR; PG8_MMA(1, 0, At, B0); PG8_MMA(1, 1, At, B1); PG8_BAR; PG8_SCHED;
            } else {
            PG8_LDB(B0, 0, 0); PG8_SCHED; PG8_LDA(At, 0, 0); PG8_STAGE(PG8_SA(1, 1), a1 + hstep, voffA);
            PG8_WAIT_L(8); PG8_BAR; PG8_WAIT_L(0); PG8_MMA(0, 0, At, B0); PG8_BAR; PG8_SCHED;
            PG8_LDB(B1, 0, 1); PG8_STAGE(PG8_SB(0, 0), b2, voffB);
            PG8_BAR; PG8_WAIT_L(0); PG8_MMA(0, 1, At, B1); PG8_BAR;
            PG8_LDA(At, 0, 1); PG8_STAGE(PG8_SA(0, 0), a2, voffA);
            PG8_BAR; PG8_WAIT_L(0); PG8_MMA(1, 0, At, B0); PG8_BAR; PG8_SCHED;
            PG8_STAGE(PG8_SB(0, 1), b2 + hstep, voffB);
            PG8_WAIT_V(6); PG8_BAR; PG8_MMA(1, 1, At, B1); PG8_BAR;
            PG8_LDB(B0, 1, 0); PG8_SCHED; PG8_LDA(At, 1, 0); PG8_STAGE(PG8_SA(0, 1), a2 + hstep, voffA);
            PG8_WAIT_L(8); PG8_BAR; PG8_WAIT_L(0); PG8_MMA(0, 0, At, B0); PG8_BAR; PG8_SCHED;
            PG8_LDB(B1, 1, 1); PG8_STAGE(PG8_SB(1, 0), b3, voffB);
            PG8_BAR; PG8_WAIT_L(0); PG8_MMA(0, 1, At, B1); PG8_BAR;
            PG8_LDA(At, 1, 1); PG8_STAGE(PG8_SA(1, 0), a3, voffA);
            PG8_BAR; PG8_WAIT_L(0); PG8_MMA(1, 0, At, B0); PG8_BAR; PG8_SCHED;
            PG8_STAGE(PG8_SB(1, 1), b3 + hstep, voffB);
            PG8_WAIT_V(6); PG8_BAR; PG8_MMA(1, 1, At, B1); PG8_BAR;
            }
        }
        if constexpr (ALIGN_EPI) { if (wr == 0) PG8_BAR; }
        if constexpr (!Epi::AFTER_DRAIN) { E(acc, cur, wr, wc, fr, fq); S.done(cur); }
        if (!has_next) break;
#pragma unroll
        for (int a = 0; a < 2; ++a)
#pragma unroll
            for (int b = 0; b < 2; ++b)
#pragma unroll
                for (int m = 0; m < 4; ++m)
#pragma unroll
                    for (int n = 0; n < 2; ++n) acc[a][b][m][n] = (f32x4){0.f, 0.f, 0.f, 0.f};
        cur = nxt; cA = nA; cB = nB; ++ui;
        if constexpr (ALIGN_EPI) { if (wr == 1) PG8_BAR; }
    }
    PG8_WAIT_V(0);
    if constexpr (!ALIGN_EPI) { if (wr == 0) PG8_BAR; }
    PG8_BAR;
    if constexpr (Epi::AFTER_DRAIN) { E.fused(acc, cur, wr, wc, fr, fq, lds, wid, lane); S.done(cur); }
#undef PG8_SA
#undef PG8_SB
#undef PG8_STAGE
#undef PG8_LDA
#undef PG8_LDB
#undef PG8_MMA
#undef PG8_WAIT_V
#undef PG8_WAIT_L
#undef PG8_BAR
#undef PG8_SCHED
}
}

constexpr int DM = 2048, NB_C = 32, S_C = 256, NB_L = 4, S_L = 4096, PAST = 512, DEPTH = 4;
constexpr int M_C = NB_C * S_C;
constexpr int M_L = NB_L * S_L;
constexpr int MTOK = M_C + M_L;
constexpr int SKV_L = PAST + S_L;
constexpr int MKEY = M_C + NB_L * SKV_L;
constexpr int DIN = 4416, NPROJ = 4608;
constexpr int DFF = 5632, NUP = 2 * DFF;
constexpr int LRU_W = 1024;
constexpr int C_QA = 0, C_KA = 512, C_VA = 768, C_XR = 1024, C_GR = 2048, C_QM = 3072, C_CKV = 3840, C_KR = 4352;
constexpr float NORM_EPS = 1e-6f;
constexpr size_t O_Y = 0, O_K = 50331648, O_V = 58720256, O_CKV = 67108864, O_KR = 83886080, O_ST = 85983232, O_END = 86245376;
enum { I_XP = 0, I_XS, I_CK, I_CV, I_CCKV, I_CKR, I_ST, I_C, I_CCTX, I_WMOD, I_BMOD, I_GPM, I_GPOM, I_GPF, I_GPOF, I_WIN, I_GQ, I_GK, I_LCW, I_LCB, I_LWA, I_LBA, I_LWX, I_LBX, I_LLAM, I_GKV, I_WUK, I_WUV, I_WOUT, I_WUP, I_FCW, I_FCB, I_WDN, N_IN };

constexpr size_t MiB = 1u << 20;
constexpr size_t WS_CTL = 0, CTL_ZERO_BYTES = 2 * MiB;
constexpr size_t WS_MOD = 1 * MiB;
constexpr size_t WS_ROPE = 2 * MiB;
constexpr size_t WS_WIN = 3 * MiB, WS_WOUT = 75 * MiB, WS_WUP = 107 * MiB, WS_WDN = 283 * MiB, WS_WKV = 371 * MiB, WS_WG = 375 * MiB;
constexpr size_t WS_H = 379 * MiB, WS_KAL = 475 * MiB, WS_VAL = 484 * MiB, WS_KAC = 493 * MiB, WS_VAC = 497 * MiB, WS_CKV = 501 * MiB, WS_KR = 527 * MiB;
constexpr size_t WS_R1 = 531 * MiB;
constexpr size_t WS_PROJ = WS_R1, WS_QA = WS_R1 + 216 * MiB, WS_QM = WS_R1 + 240 * MiB, WS_XC = WS_R1 + 276 * MiB, WS_AU = WS_R1 + 324 * MiB, WS_HF = WS_R1 + 708 * MiB,
                 WS_KVM = WS_R1 + 804 * MiB, WS_MIX = WS_R1 + 856 * MiB, WS_SUMM = WS_R1 + 952 * MiB;
constexpr size_t WS_XB = WS_R1 + 324 * MiB;
constexpr size_t WS_MODP = WS_AU;
constexpr size_t WS_MO = WS_R1;
constexpr size_t WS_U = WS_R1, WS_ACT = WS_R1 + 528 * MiB;
constexpr size_t WS_HALO = WS_R1 + 792 * MiB;
constexpr size_t WS_DBG = WS_R1 + 953 * MiB;
constexpr size_t WS_END = WS_DBG + 8 * MiB;
static_assert(WS_ACT + (size_t)MTOK * DFF * 2 <= WS_DBG && WS_SUMM + MiB <= WS_DBG, "ws map");
constexpr int CW_TMO = 0, CW_CODE = 1, CW_BAR = 4096, CW_CHK = 65536, CW_LRUF = 131072;

constexpr int RING_BYTES = 155648, LDSCTL_OFF = RING_BYTES, MISC_OFF = LDSCTL_OFF + 320, LDS_BYTES = 163840;
static_assert(MISC_OFF + 128 <= LDS_BYTES, "LDS map");
constexpr int NWAVES = 8, NTHREADS = 512;

#define GAS __attribute__((address_space(1)))
#define LAS __attribute__((address_space(3)))
typedef unsigned short bf16;
typedef unsigned v4u __attribute__((ext_vector_type(4)));
typedef float f32x4 __attribute__((ext_vector_type(4)));
typedef short bf16x8 __attribute__((ext_vector_type(8)));
typedef float f32x16 __attribute__((ext_vector_type(16)));
typedef short s16x4 __attribute__((ext_vector_type(4)));
#define LDS_WAIT() asm volatile("s_waitcnt lgkmcnt(0)" ::: "memory")
#define VM_WAIT() asm volatile("s_waitcnt vmcnt(0)" ::: "memory")
__device__ __forceinline__ unsigned f2bf(float f) { unsigned u = __builtin_bit_cast(unsigned, f); return (u + 0x7fffu + ((u >> 16) & 1u)) >> 16; }
__device__ __forceinline__ unsigned pk2(float lo, float hi) { return f2bf(lo) | (f2bf(hi) << 16); }
__device__ __forceinline__ float bf2f(unsigned short b) { return __builtin_bit_cast(float, (unsigned)b << 16); }
__device__ __forceinline__ void ld8bf(const bf16* p, float (&x)[8]) { const v4u w = *(const v4u*)p;
    x[0] = __builtin_bit_cast(float, w.x << 16); x[1] = __builtin_bit_cast(float, w.x & 0xffff0000u); x[2] = __builtin_bit_cast(float, w.y << 16); x[3] = __builtin_bit_cast(float, w.y & 0xffff0000u);
    x[4] = __builtin_bit_cast(float, w.z << 16); x[5] = __builtin_bit_cast(float, w.z & 0xffff0000u); x[6] = __builtin_bit_cast(float, w.w << 16); x[7] = __builtin_bit_cast(float, w.w & 0xffff0000u); }
__device__ __forceinline__ void unpk8(const v4u w, float (&x)[8]) {
    x[0] = __builtin_bit_cast(float, w.x << 16); x[1] = __builtin_bit_cast(float, w.x & 0xffff0000u); x[2] = __builtin_bit_cast(float, w.y << 16); x[3] = __builtin_bit_cast(float, w.y & 0xffff0000u);
    x[4] = __builtin_bit_cast(float, w.z << 16); x[5] = __builtin_bit_cast(float, w.z & 0xffff0000u); x[6] = __builtin_bit_cast(float, w.w << 16); x[7] = __builtin_bit_cast(float, w.w & 0xffff0000u); }
__device__ __forceinline__ void st8bf(bf16* p, const float (&x)[8]) { v4u w; w.x = pk2(x[0], x[1]); w.y = pk2(x[2], x[3]); w.z = pk2(x[4], x[5]); w.w = pk2(x[6], x[7]); *(v4u*)p = w; }
__device__ __forceinline__ void ld8f(const float* p, float (&x)[8]) { const f32x4 a = *(const f32x4*)p, b = *(const f32x4*)(p + 4); x[0] = a.x; x[1] = a.y; x[2] = a.z; x[3] = a.w; x[4] = b.x; x[5] = b.y; x[6] = b.z; x[7] = b.w; }
__device__ __forceinline__ void st8f(float* p, const float (&x)[8]) { *(f32x4*)p = (f32x4){x[0], x[1], x[2], x[3]}; *(f32x4*)(p + 4) = (f32x4){x[4], x[5], x[6], x[7]}; }
__device__ __forceinline__ void st8f_nt(float* p, const float (&x)[8]) { __builtin_nontemporal_store((f32x4){x[0], x[1], x[2], x[3]}, (f32x4*)p); __builtin_nontemporal_store((f32x4){x[4], x[5], x[6], x[7]}, (f32x4*)(p + 4)); }
__device__ __forceinline__ float shfl_xor_(float v, int m) { return __int_as_float(__builtin_amdgcn_ds_bpermute((int)((vlane() ^ (unsigned)m) << 2), __float_as_int(v))); }
__device__ __forceinline__ float wave_sum(float v) {
#pragma unroll
    for (int o = 1; o < 64; o <<= 1) v += shfl_xor_(v, o);
    return v;
}
__device__ __forceinline__ float fexp(float x) { return __builtin_amdgcn_exp2f(x * 1.4426950408889634f); }
__device__ __forceinline__ float sigmoidf_(float x) { return __builtin_amdgcn_rcpf(1.0f + fexp(-x)); }
__device__ __forceinline__ float siluf_(float x) { return x * sigmoidf_(x); }
__device__ __forceinline__ float gelu_tanh(float x) { const float z = 0.7978845608028654f * (x + 0.044715f * x * x * x); const float t = 1.0f - 2.0f * __builtin_amdgcn_rcpf(fexp(2.0f * z) + 1.0f); return 0.5f * x * (1.0f + t); }

#define XB_TMO      128
#define XB_XCNT(j)  (256  + 64 * (j))
#define XB_XSUB(j)  (1280 + 64 * (j))
#define XB_XGEN(j)  (2304 + 64 * (j))
#define XB_TOP      3328
#define XB_TOPGEN   3392
#define XCD_BAR_WORDS 3456
#define XB_SPIN_CAP (1u << 18)

__device__ __forceinline__ unsigned xb_ld(unsigned* p)              { return __hip_atomic_load(p, __ATOMIC_RELAXED, __HIP_MEMORY_SCOPE_AGENT); }
__device__ __forceinline__ unsigned xb_add(unsigned* p, unsigned v) { return __hip_atomic_fetch_add(p, v, __ATOMIC_RELAXED, __HIP_MEMORY_SCOPE_AGENT); }
__device__ __forceinline__ unsigned xb_xcc_id() { return (unsigned)__builtin_amdgcn_s_getreg((3 << 11) | 20) & 0xFu; }
#define XB_SPIN(cond, bar) do { unsigned _sp = 0; while (cond) { __builtin_amdgcn_s_sleep(1); \
    if ((++_sp & 255u) == 0u) { if (xb_ld(&(bar)[XB_TMO])) break; if (_sp > XB_SPIN_CAP) { atomicAdd(&(bar)[XB_TMO], 1u); break; } } } } while (0)

struct XcdBarrier {
    unsigned* bar; unsigned x; unsigned w0;
    volatile LAS unsigned* st;
};

__device__ __forceinline__ XcdBarrier xcd_barrier_post(unsigned* bar, volatile LAS unsigned* st, int wave_id) {
    XcdBarrier b; b.bar = bar; b.x = xb_xcc_id(); b.st = st; b.w0 = (wave_id == 0);
    if (b.w0 && vlane() == 0u) (void)xb_add(&bar[XB_XCNT(b.x)], 1u);
    return b;
}
__device__ __forceinline__ void xcd_barrier_complete(unsigned* bar, unsigned x, unsigned& nloc, unsigned& nx) {
    const unsigned G = gridDim.x * gridDim.y * gridDim.z;
    unsigned sum, cnt, mine, sp = 0u;
    for (;;) {
        sum = 0u; cnt = 0u; mine = 0u;
#pragma unroll
        for (unsigned j = 0; j < 16; ++j) { const unsigned c = xb_ld(&bar[XB_XCNT(j)]); sum += c; cnt += (c > 0u) ? 1u : 0u; mine = (j == x) ? c : mine; }
        if (sum == G) break;
        __builtin_amdgcn_s_sleep(1);
        if ((++sp & 255u) == 0u) { if (xb_ld(&bar[XB_TMO])) break; if (sp > XB_SPIN_CAP) { atomicAdd(&bar[XB_TMO], 1u); break; } }
    }
    nloc = mine > 0u ? mine : 1u; nx = cnt > 0u ? cnt : 1u;
}

__device__ __forceinline__ void xcd_barrier(const XcdBarrier& b) {
    asm volatile("s_waitcnt vmcnt(0)" ::: "memory");
    __syncthreads();
    if (b.w0 && vlane() == 0u) {
        unsigned* bar = b.bar;
        __builtin_amdgcn_s_waitcnt(0);
        unsigned nloc = b.st[0], nx = b.st[1];
        if (nloc == 0u) { xcd_barrier_complete(bar, b.x, nloc, nx); b.st[0] = nloc; b.st[1] = nx; }
        const unsigned old = xb_add(&bar[XB_XSUB(b.x)], 1u);
        const unsigned gen = old / nloc;
        if (old + 1u == (gen + 1u) * nloc) {
            __builtin_amdgcn_fence(__ATOMIC_RELEASE, "agent");
            asm volatile("s_waitcnt vmcnt(0)" ::: "memory");
            const unsigned og = xb_add(&bar[XB_TOP], 1u);
            const unsigned tg = og / nx;
            if (og + 1u == (tg + 1u) * nx) xb_add(&bar[XB_TOPGEN], 1u);
            else XB_SPIN(xb_ld(&bar[XB_TOPGEN]) == tg, bar);
            __builtin_amdgcn_fence(__ATOMIC_ACQUIRE, "agent");
            xb_add(&bar[XB_XGEN(b.x)], 1u);
            asm volatile("s_waitcnt vmcnt(0)" ::: "memory");
        } else {
            XB_SPIN(xb_ld(&bar[XB_XGEN(b.x)]) == gen, bar);
            __builtin_amdgcn_fence(__ATOMIC_ACQUIRE, "agent");
            asm volatile("s_waitcnt vmcnt(0)" ::: "memory");
        }
    }
    __syncthreads();
}

#ifndef ATT_STAGGER
#define ATT_STAGGER 1
#endif
namespace att {
typedef __attribute__((ext_vector_type(4))) unsigned u32x4;
constexpr int NW = 8, QBLK = 32, KVBLK = 64;
constexpr int SHM_V = KVBLK * 128 * 2, SHM_K = KVBLK * 128 * 2, SHM_KR = KVBLK * 64 * 2;
constexpr int OFF_V = 0;
template <int NVB> struct Off { static constexpr int K = NVB * SHM_V, KR = K + 2 * SHM_K, WS = KR + 2 * SHM_KR, QR = WS + NW * 64 * 4; };
template <int NVB, int QL> constexpr int lds_attn() { return Off<NVB>::QR + NW * QL * 1024; }
#ifndef SWZ_NEW
#define SWZ_NEW 1
#endif
#if SWZ_NEW
#define KSWZ(row, colB) ((row) * 256 + ((colB) ^ ((((row) & 3) | ((((row) >> 3) & 3) << 2)) << 4)))
#else
#define KSWZ(row, colB) ((row) * 256 + ((colB) ^ (((row) & 7) << 4)))
#endif
#if SWZ_NEW
#define KRSWZ(row, colB) ((row) * 128 + ((colB) ^ (((((row) >> 1) & 1) | ((((row) >> 3) & 3) << 1)) << 4)))
#else
#define KRSWZ(row, colB) ((row) * 128 + ((colB) ^ (((row) & 7) << 4)))
#endif
#define SBAR() __builtin_amdgcn_sched_barrier(0)
constexpr float THR = 8.f;
__device__ __forceinline__ int crow(int r, int hi) { return (r & 3) + 8 * (r >> 2) + 4 * hi; }
__device__ __forceinline__ unsigned cvtpk(float lo, float hi) { unsigned r; asm volatile("v_cvt_pk_bf16_f32 %0, %1, %2" : "=v"(r) : "v"(lo), "v"(hi)); return r; }

template <int DQK> __device__ __forceinline__ void partialSM(f32x16& p0, f32x16& p1, float& m_reg, float& mn, float& alpha) {
  constexpr float SCALE = (DQK == 128) ? 0.088388347648318440f : 0.072168783648703220f;
  constexpr float C = SCALE * 1.4426950408889634f;
  float pmax = p0[0];
#pragma unroll
  for (int r = 1; r < 16; ++r) pmax = fmaxf(pmax, p0[r]);
#pragma unroll
  for (int r = 0; r < 16; ++r) pmax = fmaxf(pmax, p1[r]);
  { auto rr = __builtin_amdgcn_permlane32_swap(__float_as_uint(pmax), __float_as_uint(pmax), false, false);
    pmax = fmaxf(__uint_as_float(rr[0]), __uint_as_float(rr[1])); }
  if (__builtin_expect(__all(pmax - m_reg <= THR / SCALE), 1)) { mn = m_reg; alpha = 1.f; }
  else { mn = fmaxf(m_reg, pmax); alpha = __builtin_amdgcn_exp2f((m_reg - mn) * C); m_reg = mn; }
  float mnC = -mn * C;
#pragma unroll
  for (int r = 0; r < 16; ++r) p0[r] = fmaf(p0[r], C, mnC);
#pragma unroll
  for (int r = 0; r < 16; ++r) p1[r] = fmaf(p1[r], C, mnC);
#pragma unroll
  for (int r = 0; r < 16; ++r) p0[r] = __builtin_amdgcn_exp2f(p0[r]);
}
__device__ __forceinline__ void finishSM(f32x16& p0, f32x16& p1, float alpha, float& l_reg, bf16x8& pa0, bf16x8& pa1, bf16x8& pa2, bf16x8& pa3) {
#pragma unroll
  for (int r = 0; r < 16; ++r) p1[r] = __builtin_amdgcn_exp2f(p1[r]);
  float ps = 0;
#pragma unroll
  for (int r = 0; r < 16; ++r) ps += p0[r];
#pragma unroll
  for (int r = 0; r < 16; ++r) ps += p1[r];
  { auto rr = __builtin_amdgcn_permlane32_swap(__float_as_uint(ps), __float_as_uint(ps), false, false);
    ps = __uint_as_float(rr[0]) + __uint_as_float(rr[1]); }
  l_reg = l_reg * alpha + ps;
#define PK4(P, BASE, OUT) do { unsigned a0 = cvtpk(P[BASE + 0], P[BASE + 1]), a1 = cvtpk(P[BASE + 2], P[BASE + 3]);   \
    unsigned b0 = cvtpk(P[BASE + 4], P[BASE + 5]), b1 = cvtpk(P[BASE + 6], P[BASE + 7]);                              \
    auto r0 = __builtin_amdgcn_permlane32_swap(a0, b0, false, false); auto r1 = __builtin_amdgcn_permlane32_swap(a1, b1, false, false); \
    u32x4 w = {r0[0], r1[0], r0[1], r1[1]}; OUT = *reinterpret_cast<bf16x8*>(&w); } while (0)
  PK4(p0, 0, pa0); PK4(p0, 8, pa1); PK4(p1, 0, pa2); PK4(p1, 8, pa3);
#undef PK4
}
template <int DR, int NQR> __device__ __forceinline__ void qkt(f32x16& p0, f32x16& p1, const char* Ks, const char* KRs, const bf16x8* qr, const char* qrl, int r32, int hi) {
  p0 = f32x16{}; p1 = f32x16{};
#pragma unroll
  for (int d0 = 0; d0 < 8; ++d0) { int cb = (d0 * 16 + hi * 8) * 2;
    bf16x8 b0 = *reinterpret_cast<const bf16x8*>(Ks + KSWZ(r32, cb));
    bf16x8 b1 = *reinterpret_cast<const bf16x8*>(Ks + KSWZ(32 + r32, cb));
    bf16x8 qf; if constexpr (true) { if (d0 < NQR) qf = qr[d0]; else qf = *reinterpret_cast<const bf16x8*>(qrl + (d0 - NQR) * 1024); }
    p0 = __builtin_amdgcn_mfma_f32_32x32x16_bf16(b0, qf, p0, 0, 0, 0);
    p1 = __builtin_amdgcn_mfma_f32_32x32x16_bf16(b1, qf, p1, 0, 0, 0); }
  if constexpr (DR > 0) {
#pragma unroll
    for (int d0 = 0; d0 < DR / 16; ++d0) { int cb = (d0 * 16 + hi * 8) * 2;
      bf16x8 b0 = *reinterpret_cast<const bf16x8*>(KRs + KRSWZ(r32, cb));
      bf16x8 b1 = *reinterpret_cast<const bf16x8*>(KRs + KRSWZ(32 + r32, cb));
      const bf16x8 qf = *reinterpret_cast<const bf16x8*>(qrl + (8 - NQR + d0) * 1024);
      p0 = __builtin_amdgcn_mfma_f32_32x32x16_bf16(b0, qf, p0, 0, 0, 0);
      p1 = __builtin_amdgcn_mfma_f32_32x32x16_bf16(b1, qf, p1, 0, 0, 0); }
  }
}
__device__ __forceinline__ int v_st(int k, int c) { const int kk = (k & ~0xC) | ((k & 4) << 1) | ((k & 8) >> 1); return ((kk >> 3) * 4 + (c >> 5)) * 512 + ((kk & 7) * 32 + (c & 31)) * 2; }
__device__ __forceinline__ int v_rd_base(int lane) { return ((lane & 3) << 3) | (((lane >> 2) & 3) << 6) | (((lane >> 4) & 1) << 5) | (((lane >> 5) & 1) << 8); }
constexpr int v_rd_off(int d0, int ks, int half) { return d0 * 512 + ks * 4096 + half * 2048; }
template <int OFF> __device__ __forceinline__ s16x4 tr_read(int vb) {
  s16x4 r; asm volatile("ds_read_b64_tr_b16 %0, %1 offset:%2" : "=&v"(r) : "v"(vb), "i"(OFF) : "memory"); return r;
}
template <int D0> __device__ __forceinline__ void pv_one(f32x16& od, int vb, bf16x8 pa0, bf16x8 pa1, bf16x8 pa2, bf16x8 pa3) {
  const s16x4 l0 = tr_read<v_rd_off(D0, 0, 0)>(vb), h0 = tr_read<v_rd_off(D0, 0, 1)>(vb), l1 = tr_read<v_rd_off(D0, 1, 0)>(vb), h1 = tr_read<v_rd_off(D0, 1, 1)>(vb);
  const s16x4 l2 = tr_read<v_rd_off(D0, 2, 0)>(vb), h2 = tr_read<v_rd_off(D0, 2, 1)>(vb), l3 = tr_read<v_rd_off(D0, 3, 0)>(vb), h3 = tr_read<v_rd_off(D0, 3, 1)>(vb);
  asm volatile("s_waitcnt lgkmcnt(0)" ::: "memory"); SBAR();
#define PK(L, H) (bf16x8){L[0], L[1], L[2], L[3], H[0], H[1], H[2], H[3]}
  od = __builtin_amdgcn_mfma_f32_32x32x16_bf16(pa0, PK(l0, h0), od, 0, 0, 0);
  od = __builtin_amdgcn_mfma_f32_32x32x16_bf16(pa1, PK(l1, h1), od, 0, 0, 0);
  od = __builtin_amdgcn_mfma_f32_32x32x16_bf16(pa2, PK(l2, h2), od, 0, 0, 0);
  od = __builtin_amdgcn_mfma_f32_32x32x16_bf16(pa3, PK(l3, h3), od, 0, 0, 0);
#undef PK
}
__device__ __forceinline__ void pv_d0(f32x16* o, int vb, bf16x8 pa0, bf16x8 pa1, bf16x8 pa2, bf16x8 pa3) {
  pv_one<0>(o[0], vb, pa0, pa1, pa2, pa3); pv_one<1>(o[1], vb, pa0, pa1, pa2, pa3); pv_one<2>(o[2], vb, pa0, pa1, pa2, pa3); pv_one<3>(o[3], vb, pa0, pa1, pa2, pa3);
}

template <int DR, int SD, int NQR, int STG, int LDQ, int LDK, int LDKR, int LDV, int LDO>
__device__ __forceinline__ void attn_body(const bf16* __restrict__ Qb, const bf16* __restrict__ Kh, const bf16* __restrict__ KRh, const bf16* __restrict__ Vh,
                                          bf16* __restrict__ Ob, int seq, char* lds, const int wave_id) {
  constexpr int DQK = 128 + DR, NQ = NQR, QL = (8 - NQR) + DR / 16;
  constexpr int NVB = STG ? 3 : 2; typedef Off<NVB> OF; static_assert(lds_attn<NVB, QL>() <= RING_BYTES, "attention LDS");
  const int tid = ltid(wave_id), wid = tid >> 6, lane = tid & 63, r32 = lane & 31, hi = lane >> 5;
  char* V_lds = lds + OFF_V; char* K_lds = lds + OF::K; char* KR_lds = lds + OF::KR;
  float* ws = (float*)(lds + OF::WS) + wid * 64; float* li_l = ws; float* al_l = ws + 32;
  float m_reg = -1e30f, l_reg = 0; f32x16 o[4] = {}; bf16x8 qr[NQ];
  const bf16* Qw = Qb + (long)(wid * QBLK + r32) * LDQ + hi * 8;
#pragma unroll
  for (int d0 = 0; d0 < NQ; ++d0) qr[d0] = *reinterpret_cast<const bf16x8*>(Qw + d0 * 16);
  char* qrl = lds + OF::QR + wid * (QL * 1024) + lane * 16;
#pragma unroll
  for (int d0 = 0; d0 < QL; ++d0) *reinterpret_cast<bf16x8*>(qrl + d0 * 1024) = *reinterpret_cast<const bf16x8*>(Qw + (NQR + d0) * 16);
  const int sr = tid >> 4, sc = (tid & 15) * 8, vst0 = v_st(sr, sc), vst1 = v_st(32 + sr, sc);
  const int rr = tid >> 3, rc = (tid & 7) * 8;
  const int vb0 = (int)(uintptr_t)V_lds + v_rd_base(lane);
  struct { bf16x8 vs0, vs1, ks0, ks1, kr; } sr_[SD];
#define SLOAD(i, k0) do { sr_[i].vs0 = *reinterpret_cast<const bf16x8*>(&Vh[(long)((k0) + sr) * LDV + sc]); sr_[i].vs1 = *reinterpret_cast<const bf16x8*>(&Vh[(long)((k0) + 32 + sr) * LDV + sc]); \
    sr_[i].ks0 = *reinterpret_cast<const bf16x8*>(&Kh[(long)((k0) + sr) * LDK + sc]); sr_[i].ks1 = *reinterpret_cast<const bf16x8*>(&Kh[(long)((k0) + 32 + sr) * LDK + sc]); \
    if constexpr (DR > 0) sr_[i].kr = *reinterpret_cast<const bf16x8*>(&KRh[(long)((k0) + rr) * LDKR + rc]); } while (0)
#define SWRITE(b, i) do { *(bf16x8*)(V_lds + (b) * SHM_V + vst0) = sr_[i].vs0;          \
    *(bf16x8*)(V_lds + (b) * SHM_V + vst1) = sr_[i].vs1; int kc = sc * 2;               \
    *(bf16x8*)(K_lds + (b) * SHM_K + KSWZ(sr, kc)) = sr_[i].ks0;                       \
    *(bf16x8*)(K_lds + (b) * SHM_K + KSWZ(32 + sr, kc)) = sr_[i].ks1;                  \
    if constexpr (DR > 0) *(bf16x8*)(KR_lds + (b) * SHM_KR + KRSWZ(rr, rc * 2)) = sr_[i].kr; } while (0)
#define SWAIT() do { if constexpr (SD == 1) asm volatile("s_waitcnt vmcnt(0)" ::: "memory"); else if constexpr (DR > 0) asm volatile("s_waitcnt vmcnt(5)" ::: "memory"); else asm volatile("s_waitcnt vmcnt(4)" ::: "memory"); } while (0)
#define RESC(a) do { if (__any((a) < 1.f)) { if (hi == 0) al_l[r32] = (a); asm volatile("s_waitcnt lgkmcnt(0)" ::: "memory"); \
    _Pragma("unroll") for (int d = 0; d < 4; ++d) _Pragma("unroll") for (int r = 0; r < 16; ++r) o[d][r] *= al_l[crow(r, hi)]; } } while (0)
  f32x16 pA0, pA1, pB0, pB1; float mnA, mnB, alA, alB; bf16x8 pa0, pa1, pa2, pa3; const int NT = seq / KVBLK;
  constexpr int SE = 0, SO = SD - 1;
  SLOAD(SE, 0); asm volatile("s_waitcnt vmcnt(0)" ::: "memory"); SWRITE(0, SE); __syncthreads();
  qkt<DR, NQR>(pA0, pA1, K_lds, KR_lds, qr, qrl, r32, hi); partialSM<DQK>(pA0, pA1, m_reg, mnA, alA);
  SLOAD(SO, KVBLK); if constexpr (SD == 2) { if (2 < NT) SLOAD(SE, 2 * KVBLK); }
  SWAIT(); SWRITE(1, SO); __syncthreads();
  if constexpr (STG != 0) {
    int vp = 0, vc = (int)SHM_V, vn = 2 * (int)SHM_V;
    const bool hiw = wave_id >= 4;
#define HALFBAR() do { asm volatile("s_waitcnt lgkmcnt(0)" ::: "memory"); __builtin_amdgcn_s_barrier(); asm volatile("" ::: "memory"); } while (0)
#define SWRITE3(kb, voff, i) do { *(bf16x8*)(V_lds + (voff) + vst0) = sr_[i].vs0; *(bf16x8*)(V_lds + (voff) + vst1) = sr_[i].vs1; int kc = sc * 2;               \
    *(bf16x8*)(K_lds + (kb) * SHM_K + KSWZ(sr, kc)) = sr_[i].ks0; *(bf16x8*)(K_lds + (kb) * SHM_K + KSWZ(32 + sr, kc)) = sr_[i].ks1;                  \
    if constexpr (DR > 0) *(bf16x8*)(KR_lds + (kb) * SHM_KR + KRSWZ(rr, rc * 2)) = sr_[i].kr; } while (0)
    for (int j = 1; j + 1 < NT; j += 2) {
      SBAR(); qkt<DR, NQR>(pB0, pB1, K_lds + SHM_K, KR_lds + SHM_KR, qr, qrl, r32, hi);
      finishSM(pA0, pA1, alA, l_reg, pa0, pa1, pa2, pa3); SBAR();
      SLOAD(SO, (j + SD) * KVBLK); SBAR();
      if constexpr (STG == 2) {
        pv_d0(o, vb0 + vp, pa0, pa1, pa2, pa3); SBAR();
        SWAIT(); SWRITE3(0, vn, SE);
        if (hiw) HALFBAR();
        partialSM<DQK>(pB0, pB1, m_reg, mnB, alB); RESC(alB);
        if (!hiw) HALFBAR();
      } else {
      pv_d0(o, vb0 + vp, pa0, pa1, pa2, pa3); partialSM<DQK>(pB0, pB1, m_reg, mnB, alB);
      SWAIT(); SWRITE3(0, vn, SE);
      RESC(alB); __syncthreads(); }
      { const int t = vp; vp = vc; vc = vn; vn = t; }
      SBAR(); qkt<DR, NQR>(pA0, pA1, K_lds, KR_lds, qr, qrl, r32, hi);
      finishSM(pB0, pB1, alB, l_reg, pa0, pa1, pa2, pa3); SBAR();
      if (SD == 1 || j + 3 < NT) SLOAD(SE, (j + 1 + SD) * KVBLK); SBAR();
      if constexpr (STG == 2) {
        pv_d0(o, vb0 + vp, pa0, pa1, pa2, pa3); SBAR();
        SWAIT(); SWRITE3(1, vn, SO);
        if (hiw) HALFBAR();
        partialSM<DQK>(pA0, pA1, m_reg, mnA, alA); RESC(alA);
        if (!hiw) HALFBAR();
      } else {
      pv_d0(o, vb0 + vp, pa0, pa1, pa2, pa3); partialSM<DQK>(pA0, pA1, m_reg, mnA, alA);
      SWAIT(); SWRITE3(1, vn, SO);
      RESC(alA); __syncthreads(); }
      { const int t = vp; vp = vc; vc = vn; vn = t; }
    }
#undef SWRITE3
#undef HALFBAR
    SBAR(); qkt<DR, NQR>(pB0, pB1, K_lds + SHM_K, KR_lds + SHM_KR, qr, qrl, r32, hi);
    finishSM(pA0, pA1, alA, l_reg, pa0, pa1, pa2, pa3); SBAR();
    pv_d0(o, vb0 + vp, pa0, pa1, pa2, pa3); partialSM<DQK>(pB0, pB1, m_reg, mnB, alB);
    RESC(alB);
    finishSM(pB0, pB1, alB, l_reg, pa0, pa1, pa2, pa3); SBAR();
    pv_d0(o, vb0 + vc, pa0, pa1, pa2, pa3);
  } else {
  for (int j = 1; j + 1 < NT; j += 2) {
    SBAR(); qkt<DR, NQR>(pB0, pB1, K_lds + SHM_K, KR_lds + SHM_KR, qr, qrl, r32, hi);
    finishSM(pA0, pA1, alA, l_reg, pa0, pa1, pa2, pa3); SBAR();
    SLOAD(SO, (j + SD) * KVBLK); SBAR();
    pv_d0(o, vb0, pa0, pa1, pa2, pa3); partialSM<DQK>(pB0, pB1, m_reg, mnB, alB);
    __syncthreads(); SWAIT(); SWRITE(0, SE);
    RESC(alB); __syncthreads();
    SBAR(); qkt<DR, NQR>(pA0, pA1, K_lds, KR_lds, qr, qrl, r32, hi);
    finishSM(pB0, pB1, alB, l_reg, pa0, pa1, pa2, pa3); SBAR();
    if (SD == 1 || j + 3 < NT) SLOAD(SE, (j + 1 + SD) * KVBLK); SBAR();
    pv_d0(o, vb0 + (int)SHM_V, pa0, pa1, pa2, pa3); partialSM<DQK>(pA0, pA1, m_reg, mnA, alA);
    __syncthreads(); SWAIT(); SWRITE(1, SO);
    RESC(alA); __syncthreads();
  }
  SBAR(); qkt<DR, NQR>(pB0, pB1, K_lds + SHM_K, KR_lds + SHM_KR, qr, qrl, r32, hi);
    finishSM(pA0, pA1, alA, l_reg, pa0, pa1, pa2, pa3); SBAR();
    pv_d0(o, vb0, pa0, pa1, pa2, pa3); partialSM<DQK>(pB0, pB1, m_reg, mnB, alB);
    __syncthreads(); RESC(alB);
    finishSM(pB0, pB1, alB, l_reg, pa0, pa1, pa2, pa3); SBAR();
    pv_d0(o, vb0 + (int)SHM_V, pa0, pa1, pa2, pa3);
  }
  if (hi == 0) li_l[r32] = l_reg; asm volatile("s_waitcnt lgkmcnt(0)" ::: "memory");
  float rli[16];
#pragma unroll
  for (int r = 0; r < 16; ++r) rli[r] = __builtin_amdgcn_rcpf(li_l[crow(r, hi)]);
  bf16* Ow = Ob + (long)(wid * QBLK) * LDO;
#pragma unroll
  for (int r = 0; r < 16; ++r) { int orow = crow(r, hi);
#pragma unroll
    for (int d0 = 0; d0 < 4; ++d0) Ow[(long)orow * LDO + d0 * 32 + r32] = (bf16)f2bf(o[d0][r] * rli[r]); }
  __syncthreads();
#undef SLOAD
#undef SWRITE
#undef SWAIT
#undef RESC
}
}
#ifndef LRU_STAMPS
#define LRU_STAMPS 0
#define LS_A 0
#define LS_B 0
#define LS_NB 1
#endif
#ifndef LRU_LOOKBACK
#define LRU_LOOKBACK 1
#endif
#ifndef GQA_STG
#define GQA_STG 0
#endif
#ifndef MLA_STG
#define MLA_STG 0
#endif
#ifndef GQA_NQR
#define GQA_NQR 8
#endif
#ifndef GQA_SD
#define GQA_SD 2
#endif
#ifndef MLA_NQR
#define MLA_NQR 6
#endif
#ifndef MLA_SD
#define MLA_SD 1
#endif

struct Args { const float* in[N_IN]; float* out; unsigned char* ws; int ph_lo, ph_hi; };
constexpr int PH_PER_LAYER = 10, PH_PRE = 3, PH_TOTAL = PH_PRE + DEPTH * PH_PER_LAYER;
typedef const __attribute__((address_space(4))) Args* KArgs;
__device__ __forceinline__ KArgs launder(KArgs p) { asm volatile("" : "+s"(p)); return p; }

template <bool FFNUP = false>
__device__ __forceinline__ void transpose_item(const float* W, int K, int N, bf16* WT, LAS float* scr, int item, int lane) {
    const int nblk = N / 32, kb = item / nblk, nb = item % nblk, k0 = 64 * kb, n0 = 32 * nb;
    const int d0 = FFNUP ? ((n0 % DFF) / 128) * 256 + (n0 / DFF) * 128 + (n0 % DFF) % 128 : n0;
    { f32x4 v[8];
#pragma unroll
      for (int i = 0; i < 8; ++i) v[i] = __builtin_nontemporal_load((const f32x4*)&W[(size_t)(k0 + 8 * i + (lane >> 3)) * N + n0 + 4 * (lane & 7)]);
#pragma unroll
      for (int i = 0; i < 8; ++i) { LAS float* q = scr + (8 * i + (lane >> 3)) * 33 + 4 * (lane & 7); q[0] = v[i].x; q[1] = v[i].y; q[2] = v[i].z; q[3] = v[i].w; } }
    LDS_WAIT(); asm volatile("" ::: "memory");
    const int c = lane & 7;
#pragma unroll
    for (int j = 0; j < 4; ++j) { const int n = (lane >> 3) + 8 * j; const LAS float* s = scr + (8 * c) * 33 + n;
        v4u o; o.x = pk2(s[0 * 33], s[1 * 33]); o.y = pk2(s[2 * 33], s[3 * 33]); o.z = pk2(s[4 * 33], s[5 * 33]); o.w = pk2(s[6 * 33], s[7 * 33]);
        *(v4u*)(WT + (size_t)(d0 + n) * K + k0 + 8 * c) = o; }
    LDS_WAIT(); asm volatile("" ::: "memory");
}

struct TItem { const float* W; bf16* WT; int K, N, item, ffnup; };
__device__ __forceinline__ void ti_load(const TItem& d, f32x4 (&v)[8], int lane) {
    const int nblk = d.N / 32, kb = d.item / nblk, nb = d.item % nblk, k0 = 64 * kb, n0 = 32 * nb;
#pragma unroll
    for (int i = 0; i < 8; ++i) v[i] = __builtin_nontemporal_load((const f32x4*)&d.W[(size_t)(k0 + 8 * i + (lane >> 3)) * d.N + n0 + 4 * (lane & 7)]);
}
__device__ __forceinline__ void ti_to_lds(const f32x4 (&v)[8], LAS float* scr, int lane) {
#pragma unroll
    for (int i = 0; i < 8; ++i) { LAS float* q = scr + (8 * i + (lane >> 3)) * 33 + 4 * (lane & 7); q[0] = v[i].x; q[1] = v[i].y; q[2] = v[i].z; q[3] = v[i].w; }
}
__device__ __forceinline__ void ti_store(const TItem& d, LAS float* scr, int lane) {
    const int nblk = d.N / 32, kb = d.item / nblk, nb = d.item % nblk, k0 = 64 * kb, n0 = 32 * nb;
    const int d0 = d.ffnup ? ((n0 % DFF) / 128) * 256 + (n0 / DFF) * 128 + (n0 % DFF) % 128 : n0;
    LDS_WAIT(); asm volatile("" ::: "memory");
    const int c = lane & 7;
#pragma unroll
    for (int j = 0; j < 4; ++j) { const int n = (lane >> 3) + 8 * j; const LAS float* q = scr + (8 * c) * 33 + n;
        v4u o; o.x = pk2(q[0 * 33], q[1 * 33]); o.y = pk2(q[2 * 33], q[3 * 33]); o.z = pk2(q[4 * 33], q[5 * 33]); o.w = pk2(q[6 * 33], q[7 * 33]);
        *(v4u*)(d.WT + (size_t)(d0 + n) * d.K + k0 + 8 * c) = o; }
    LDS_WAIT(); asm volatile("" ::: "memory");
}

#ifndef TAILCONV
#define TAILCONV 1
#endif
constexpr int I_IN = 32 * 138, I_OUT = 32 * 64, I_UP = 32 * 352, I_DN = 88 * 64, I_KV = 2 * 128, I_G = 256;
constexpr int I_LAYER = I_IN + I_OUT + I_UP + I_DN + I_KV + I_G;
#ifndef TC_R1
#define TC_R1 7168
#endif
#ifndef TC_R2
#define TC_R2 10240
#endif
#ifndef TC_P0
#define TC_P0 8000
#endif
static_assert(TC_P0 >= I_IN && TC_P0 + TC_R2 >= I_IN + I_OUT + I_KV + I_G + I_UP && TC_R1 <= TC_R2 && TC_R2 <= I_LAYER && I_IN + I_OUT + I_KV + I_G <= TC_P0 + TC_R1, "conversion deadlines");
__device__ __forceinline__ TItem conv_decode(KArgs a, int it) {
    unsigned char* ws = a->ws;
    const int l = it / I_LAYER; int r = it % I_LAYER;
    if (r < I_IN) return TItem{a->in[I_WIN] + (size_t)l * DM * DIN, (bf16*)(ws + WS_WIN) + (size_t)l * NPROJ * DM, DM, DIN, r, 0}; r -= I_IN;
    if (r < I_OUT) return TItem{a->in[I_WOUT] + (size_t)l * DM * DM, (bf16*)(ws + WS_WOUT) + (size_t)l * DM * DM, DM, DM, r, 0}; r -= I_OUT;
    if (r < I_KV) { const int which = r / 128;
        return TItem{a->in[which ? I_WUV : I_WUK] + (size_t)l * 512 * 512, (bf16*)(ws + WS_WKV) + (size_t)l * 1024 * 512 + (size_t)which * 512 * 512, 512, 512, r % 128, 0}; } r -= I_KV;
    if (r < I_G) { const int mat = r / 8, sub = r % 8;
        const int ty = mat & 1, dir = (mat >> 1) & 1, n = mat >> 2;
        return TItem{a->in[ty ? I_LWX : I_LWA] + ((size_t)((l * 2 + dir) * 8 + n)) * 128 * 128, (bf16*)(ws + WS_WG) + (size_t)l * 32 * 16384 + (size_t)mat * 16384, 128, 128, sub, 0}; } r -= I_G;
    if (r < I_UP) return TItem{a->in[I_WUP] + (size_t)l * DM * NUP, (bf16*)(ws + WS_WUP) + (size_t)l * NUP * DM, DM, NUP, r, 1}; r -= I_UP;
    return TItem{a->in[I_WDN] + (size_t)l * DFF * DM, (bf16*)(ws + WS_WDN) + (size_t)l * DM * DFF, DFF, DM, r, 0};
}
__device__ __forceinline__ void convert_items(KArgs a, char* lds, int g0, int g1, int widx, int nw, int wave, int lane) {
    LAS float* scr = (LAS float*)(lds + wave * 16384);
    if (g1 > DEPTH * I_LAYER) g1 = DEPTH * I_LAYER;
    int it = g0 + widx;
    if (it >= g1) return;
    TItem d = conv_decode(a, it); f32x4 v[8]; ti_load(d, v, lane);
    for (;;) {
        ti_to_lds(v, scr, lane);
        const int itn = it + nw; TItem dn = d;
        if (itn < g1) { dn = conv_decode(a, itn); ti_load(dn, v, lane); }
        ti_store(d, scr, lane);
        if (itn >= g1) break;
        d = dn; it = itn;
    }
}
__device__ __forceinline__ void tail_convert(KArgs a, char* lds, int g0, int g1, int nwg, int G, int bx, int wave, int lane) {
    const int used = nwg % G;
    if (bx < used) return;
    convert_items(a, lds, g0, g1, (bx - used) * NWAVES + wave, (G - used) * NWAVES, wave, lane);
}
#ifndef MODSHIFT
#define MODSHIFT 0
#endif
static_assert(!MODSHIFT || TAILCONV, "MODSHIFT runs in the TAILCONV tail rounds");
constexpr size_t WS_MODP2 = WS_DBG;
__device__ __forceinline__ void modp_items(KArgs a, int l, float* MODP, int widx, int nw, int lane) {
      for (int it = widx; it < 32 * 48; it += nw) {
        const int kc = it / 48, jb = it % 48, j = jb * 256 + 4 * lane, k = kc * 64 + lane;
        float cv[5];
#pragma unroll
        for (int cr = 0; cr < 4; ++cr) cv[cr] = siluf_(a->in[I_C][cr * DM + k]);
        cv[4] = siluf_(a->in[I_CCTX][k]);
        f32x4 acc[5];
#pragma unroll
        for (int cr = 0; cr < 5; ++cr) acc[cr] = (f32x4){0.f, 0.f, 0.f, 0.f};
        const float* wp = a->in[I_WMOD] + ((size_t)l * DM + (size_t)kc * 64) * 12288 + j;
#pragma unroll 16
        for (int kk = 0; kk < 64; ++kk) { const f32x4 w = __builtin_nontemporal_load((const f32x4*)(wp + (size_t)kk * 12288));
#pragma unroll
            for (int cr = 0; cr < 5; ++cr) { const float s = __int_as_float(__builtin_amdgcn_readlane(__float_as_int(cv[cr]), kk)); acc[cr] += w * s; } }
        if (kc == 0) { const f32x4 b = *(const f32x4*)(a->in[I_BMOD] + (size_t)l * 12288 + j);
#pragma unroll
            for (int cr = 0; cr < 5; ++cr) acc[cr] += b; }
#pragma unroll
        for (int cr = 0; cr < 5; ++cr) *(f32x4*)(MODP + ((size_t)kc * 5 + cr) * 12288 + j) = acc[cr];
      }
}
__device__ __forceinline__ void mod_reduce_layer(KArgs a, int l, const float* MODP, int tidx, int nthr) {
    float* MOD = (float*)(a->ws + WS_MOD) + (size_t)l * 5 * 12288;
    for (int i = tidx; i < 5 * 12288 / 4; i += nthr) {
        f32x4 s = (f32x4){0.f, 0.f, 0.f, 0.f};
#pragma unroll 8
        for (int kc = 0; kc < 32; ++kc) s += *((const f32x4*)(MODP + (size_t)kc * 5 * 12288) + i);
        *((f32x4*)MOD + i) = s; }
}
__device__ __forceinline__ void phase_prologue(KArgs a, char* lds, int gw, int NGW, int wave, int lane) {
    unsigned char* ws = a->ws;
    convert_items(a, lds, 0, TAILCONV ? TC_P0 : DEPTH * I_LAYER, gw, NGW, wave, lane);
    { const int gt = gw * 64 + lane, NT = NGW * 64; constexpr int PER = (NPROJ - DIN) * DM / 8;
      for (int i = gt; i < DEPTH * PER; i += NT) { const int l = i / PER, j = i % PER; *((v4u*)((bf16*)(ws + WS_WIN) + (size_t)l * NPROJ * DM + (size_t)DIN * DM) + j) = (v4u){0u, 0u, 0u, 0u}; } }
    if (MODSHIFT) modp_items(a, 0, (float*)(ws + WS_MODP), gw, NGW, lane);
    else for (int l = 0; l < DEPTH; ++l) modp_items(a, l, (float*)(ws + WS_MODP) + (size_t)l * 32 * 5 * 12288, gw, NGW, lane);
    { const int gt = gw * 64 + lane;
      if (gt < 64 * 32 + 64 * 16) { const bool big = gt < 2048; const int e = big ? gt : gt - 2048, nf = big ? 32 : 16, pos = e / nf, f = e % nf;
        const float inv = exp2f(-(float)f / (float)nf * 13.287712379549449f);
        const float ang = (float)pos * inv;
        double rev = (double)ang * 0.15915494309189535; rev -= floor(rev);
        const float rf = (float)rev; const float sn = __builtin_amdgcn_sinf(rf), cs = __builtin_amdgcn_cosf(rf);
        float2* tab = (float2*)(ws + WS_ROPE + (big ? 0 : 32768)); tab[e] = make_float2(cs, sn); } }
}

__device__ __forceinline__ void phase_mod_reduce(KArgs a, int gtid, int NTHR) {
    for (int l = 0; l < (MODSHIFT ? 1 : DEPTH); ++l) mod_reduce_layer(a, l, (const float*)(a->ws + WS_MODP) + (size_t)l * 32 * 5 * 12288, gtid, NTHR);
}

#ifndef MO_NT
#define MO_NT 1
#endif
#ifndef R_NT
#define R_NT 1
#endif
#ifndef XBF16
#define XBF16 1
#endif
__device__ __forceinline__ f32x4 ld4bf(const bf16* p) { const unsigned long long w = *(const unsigned long long*)p; const unsigned lo = (unsigned)w, hi = (unsigned)(w >> 32);
    return (f32x4){__builtin_bit_cast(float, lo << 16), __builtin_bit_cast(float, lo & 0xffff0000u), __builtin_bit_cast(float, hi << 16), __builtin_bit_cast(float, hi & 0xffff0000u)}; }
__device__ __forceinline__ f32x4 ld4bf_nt(const bf16* p) { const unsigned long long w = __builtin_nontemporal_load((const unsigned long long*)p); const unsigned lo = (unsigned)w, hi = (unsigned)(w >> 32);
    return (f32x4){__builtin_bit_cast(float, lo << 16), __builtin_bit_cast(float, lo & 0xffff0000u), __builtin_bit_cast(float, hi << 16), __builtin_bit_cast(float, hi & 0xffff0000u)}; }
__device__ __forceinline__ void st4bf(bf16* p, const f32x4 h) { *(unsigned long long*)p = (unsigned long long)pk2(h.x, h.y) | ((unsigned long long)pk2(h.z, h.w) << 32); }
__device__ __forceinline__ void row_update(const float* xsrc, const bf16* xsrc_b, const bf16* msrc, float* xdst, bf16* xdst_b, const float* g_post, const float* gate,
                                           const float* g_pre, const float* sc, const float* sh, bf16* hdst, int lane) {
    f32x4 x[8];
    if (xsrc) {
#pragma unroll
        for (int j = 0; j < 8; ++j) x[j] = R_NT ? __builtin_nontemporal_load((const f32x4*)xsrc + lane + 64 * j) : *((const f32x4*)xsrc + lane + 64 * j);
    } else {
#pragma unroll
        for (int j = 0; j < 8; ++j) x[j] = ld4bf(xsrc_b + 4 * (lane + 64 * j));
    }
    if (msrc) {
        f32x4 m[8]; float ss = 0.f;
#pragma unroll
        for (int j = 0; j < 8; ++j) { m[j] = R_NT ? ld4bf_nt(msrc + 4 * (lane + 64 * j)) : ld4bf(msrc + 4 * (lane + 64 * j)); ss += (m[j].x * m[j].x + m[j].y * m[j].y) + (m[j].z * m[j].z + m[j].w * m[j].w); }
        const float rs = rsqrtf(wave_sum(ss) * (1.0f / DM) + NORM_EPS);
#pragma unroll
        for (int j = 0; j < 8; ++j) { const f32x4 g = *((const f32x4*)g_post + lane + 64 * j), gt = *((const f32x4*)gate + lane + 64 * j); x[j] = x[j] + gt * (m[j] * rs * g); }
    }
    if (xdst) {
#pragma unroll
        for (int j = 0; j < 8; ++j) { if (R_NT) __builtin_nontemporal_store(x[j], (f32x4*)xdst + lane + 64 * j); else *((f32x4*)xdst + lane + 64 * j) = x[j]; }
    }
    if (xdst_b) {
#pragma unroll
        for (int j = 0; j < 8; ++j) st4bf(xdst_b + 4 * (lane + 64 * j), x[j]);
    }
    if (hdst) {
        float ss = 0.f;
#pragma unroll
        for (int j = 0; j < 8; ++j) ss += (x[j].x * x[j].x + x[j].y * x[j].y) + (x[j].z * x[j].z + x[j].w * x[j].w);
        const float rs = rsqrtf(wave_sum(ss) * (1.0f / DM) + NORM_EPS);
#pragma unroll
        for (int j = 0; j < 8; ++j) { const f32x4 g = *((const f32x4*)g_pre + lane + 64 * j), s1 = *((const f32x4*)sc + lane + 64 * j), s0 = *((const f32x4*)sh + lane + 64 * j);
            st4bf(hdst + 4 * (lane + 64 * j), x[j] * rs * g * (1.0f + s1) + s0); }
    }
}
__device__ __forceinline__ int cond_row(int r) { return r < M_C ? 4 : (r - M_C) / S_L; }
__device__ __forceinline__ const float* mod_ptr(KArgs a, int l, int cr, int which) { return (const float*)(a->ws + WS_MOD) + ((size_t)(l * 5 + cr) * 6 + which) * DM; }

__device__ __forceinline__ void phase_first_norm(KArgs a, char* lds, int wg, int G, int tid) {
    const int lane = tid & 63, wave = __builtin_amdgcn_readfirstlane(tid >> 6);
    const int rows_per = (MTOK + G - 1) / G, r0 = wg * rows_per, r1 = (r0 + rows_per < MTOK) ? r0 + rows_per : MTOK;
    float* V = (float*)lds;
    const int cr0 = r0 < MTOK ? cond_row(r0) : 0, cr1 = r1 > r0 ? cond_row(r1 - 1) : cr0;
    if (r0 < r1) {
#pragma unroll
        for (int s = 0; s < 2; ++s) { const int cr = s ? cr1 : cr0; const int c4 = 4 * tid;
            const f32x4 gpre = *(const f32x4*)(a->in[I_GPM] + c4), sc = *(const f32x4*)(mod_ptr(a, 0, cr, 1) + c4), sh = *(const f32x4*)(mod_ptr(a, 0, cr, 0) + c4);
            *(f32x4*)(V + (s * 2 + 0) * DM + c4) = gpre * (1.0f + sc); *(f32x4*)(V + (s * 2 + 1) * DM + c4) = sh; } }
    __syncthreads();
    for (int r = r0 + wave; r < r1; r += NWAVES) {
        const int set = cond_row(r) == cr0 ? 0 : 1; const float* gp = V + (set * 2 + 0) * DM; const float* shv = V + (set * 2 + 1) * DM;
        const float* xs = r < M_C ? a->in[I_XP] + (size_t)r * DM : a->in[I_XS] + (size_t)(r - M_C) * DM; bf16* hr = (bf16*)(a->ws + WS_H) + (size_t)r * DM;
        float x[4][8]; float ss = 0.f;
#pragma unroll
        for (int j = 0; j < 4; ++j) { const f32x4 a0 = __builtin_nontemporal_load((const f32x4*)(xs + 8 * (lane + 64 * j))), a1 = __builtin_nontemporal_load((const f32x4*)(xs + 8 * (lane + 64 * j) + 4));
            x[j][0] = a0.x; x[j][1] = a0.y; x[j][2] = a0.z; x[j][3] = a0.w; x[j][4] = a1.x; x[j][5] = a1.y; x[j][6] = a1.z; x[j][7] = a1.w;
#pragma unroll
            for (int e = 0; e < 8; ++e) ss += x[j][e] * x[j][e]; }
        const float rs = rsqrtf(wave_sum(ss) * (1.0f / DM) + NORM_EPS);
#pragma unroll
        for (int j = 0; j < 4; ++j) { float g[8], s0[8], h[8]; ld8f(gp + 8 * (lane + 64 * j), g); ld8f(shv + 8 * (lane + 64 * j), s0);
#pragma unroll
            for (int e = 0; e < 8; ++e) h[e] = x[j][e] * rs * g[e] + s0[e];
            st8bf(hr + 8 * (lane + 64 * j), h); }
    }
    __syncthreads();
}
__device__ __forceinline__ void phase_residual(KArgs a, int l, int which, char* lds, int wg, int G, int tid) {
    const bf16* MO = (const bf16*)(a->ws + WS_MO);
    const int lane = tid & 63, wave = __builtin_amdgcn_readfirstlane(tid >> 6);
    const int rows_per = (MTOK + G - 1) / G, r0 = wg * rows_per, r1 = (r0 + rows_per < MTOK) ? r0 + rows_per : MTOK;
    const bool last = (which == 1) && (l + 1 == DEPTH);
    float* V = (float*)lds;
    const int cr0 = r0 < MTOK ? cond_row(r0) : 0, cr1 = r1 > r0 ? cond_row(r1 - 1) : cr0;
    if (r0 < r1) {
#pragma unroll
        for (int s = 0; s < 2; ++s) { const int cr = s ? cr1 : cr0; const int c4 = 4 * tid;
            const f32x4 gt = *(const f32x4*)(mod_ptr(a, l, cr, which ? 5 : 2) + c4), gpo = *(const f32x4*)(a->in[which ? I_GPOF : I_GPOM] + l * DM + c4);
            *(f32x4*)(V + (s * 3 + 0) * DM + c4) = gt * gpo;
            if (!last) { const int ln = which ? l + 1 : l;
                const f32x4 gpre = *(const f32x4*)(a->in[which ? I_GPM : I_GPF] + ln * DM + c4), sc = *(const f32x4*)(mod_ptr(a, ln, cr, which ? 1 : 4) + c4), sh = *(const f32x4*)(mod_ptr(a, ln, cr, which ? 0 : 3) + c4);
                *(f32x4*)(V + (s * 3 + 1) * DM + c4) = gpre * (1.0f + sc); *(f32x4*)(V + (s * 3 + 2) * DM + c4) = sh; } }
    }
    __syncthreads();
    for (int r = r0 + wave; r < r1; r += NWAVES) {
        const int set = cond_row(r) == cr0 ? 0 : 1; const float* gg = V + (set * 3 + 0) * DM; const float* gp = V + (set * 3 + 1) * DM; const float* shv = V + (set * 3 + 2) * DM;
        float* xr = a->out + (size_t)r * DM; bf16* hr = (bf16*)(a->ws + WS_H) + (size_t)r * DM;
        const float* xin = r < M_C ? a->in[I_XP] + (size_t)r * DM : a->in[I_XS] + (size_t)(r - M_C) * DM;
        const float* xs = (l == 0 && which == 0) ? xin : xr; bf16* xb = (bf16*)(a->ws + WS_XB) + (size_t)r * DM;
        float x[4][8], m[4][8]; float ss = 0.f;
        if (XBF16 && !(l == 0 && which == 0)) {
#pragma unroll
            for (int j = 0; j < 4; ++j) unpk8(__builtin_nontemporal_load((const v4u*)(xb + 8 * (lane + 64 * j))), x[j]);
        } else {
#pragma unroll
            for (int j = 0; j < 4; ++j) { const f32x4 a0 = __builtin_nontemporal_load((const f32x4*)(xs + 8 * (lane + 64 * j))), a1 = __builtin_nontemporal_load((const f32x4*)(xs + 8 * (lane + 64 * j) + 4));
                x[j][0] = a0.x; x[j][1] = a0.y; x[j][2] = a0.z; x[j][3] = a0.w; x[j][4] = a1.x; x[j][5] = a1.y; x[j][6] = a1.z; x[j][7] = a1.w; }
        }
#pragma unroll
        for (int j = 0; j < 4; ++j) { unpk8(__builtin_nontemporal_load((const v4u*)(MO + (size_t)r * DM + 8 * (lane + 64 * j))), m[j]);
#pragma unroll
            for (int e = 0; e < 8; ++e) ss += m[j][e] * m[j][e]; }
        const float rs = rsqrtf(wave_sum(ss) * (1.0f / DM) + NORM_EPS);
        float s2 = 0.f;
#pragma unroll
        for (int j = 0; j < 4; ++j) { float g[8]; ld8f(gg + 8 * (lane + 64 * j), g);
#pragma unroll
            for (int e = 0; e < 8; ++e) { x[j][e] = x[j][e] + g[e] * (m[j][e] * rs); s2 += x[j][e] * x[j][e]; }
            if (XBF16 && !last) st8bf(xb + 8 * (lane + 64 * j), x[j]);
            else { __builtin_nontemporal_store((f32x4){x[j][0], x[j][1], x[j][2], x[j][3]}, (f32x4*)(xr + 8 * (lane + 64 * j))); __builtin_nontemporal_store((f32x4){x[j][4], x[j][5], x[j][6], x[j][7]}, (f32x4*)(xr + 8 * (lane + 64 * j) + 4)); } }
        if (!last) { const float rs2 = rsqrtf(wave_sum(s2) * (1.0f / DM) + NORM_EPS);
#pragma unroll
            for (int j = 0; j < 4; ++j) { float g[8], s0[8], h[8]; ld8f(gp + 8 * (lane + 64 * j), g); ld8f(shv + 8 * (lane + 64 * j), s0);
#pragma unroll
                for (int e = 0; e < 8; ++e) h[e] = x[j][e] * rs2 * g[e] + s0[e];
                st8bf(hr + 8 * (lane + 64 * j), h); } }
    }
    __syncthreads();
}

__device__ __forceinline__ void rope8(float (&y)[8], int pxor, bool first, const float2* tab) {
#pragma unroll
    for (int i = 0; i < 8; ++i) { const float yp = shfl_xor_(y[i], pxor); const float2 cs = tab[i]; y[i] = first ? y[i] * cs.x - yp * cs.y : y[i] * cs.x + yp * cs.y; }
}

__device__ __forceinline__ void phase_postproj(KArgs a, int l, int gw, int NGW, int lane, char* lds, int tid) {
    unsigned char* ws = a->ws;
    float* LCW = (float*)lds; float* LCB = LCW + 4 * LRU_W; float* LGQ = LCB + LRU_W; float* LGK = LGQ + 128; float* LGKV = LGK + 128;
    { const float* s0 = a->in[I_LCW] + (size_t)l * 4 * LRU_W;
      for (int i = tid; i < 4 * LRU_W / 4; i += NTHREADS) *((f32x4*)LCW + i) = *((const f32x4*)s0 + i);
      if (tid < LRU_W / 4) *((f32x4*)LCB + tid) = *((const f32x4*)(a->in[I_LCB] + l * LRU_W) + tid);
      if (tid < 32) *((f32x4*)LGQ + tid) = *((const f32x4*)(a->in[I_GQ] + l * 128) + tid);
      else if (tid < 64) *((f32x4*)LGK + (tid - 32)) = *((const f32x4*)(a->in[I_GK] + l * 128) + (tid - 32));
      else if (tid < 192) *((f32x4*)LGKV + (tid - 64)) = *((const f32x4*)(a->in[I_GKV] + l * 512) + (tid - 64)); }
    __syncthreads();
    const bf16* PROJ = (const bf16*)(ws + WS_PROJ);
    float2* R128 = (float2*)(LGKV + 512); float2* R64 = R128 + 64 * 32;
    { const float2* g128 = (const float2*)(ws + WS_ROPE); const float2* g64 = (const float2*)(ws + WS_ROPE + 32768);
      for (int i = tid; i < 64 * 32 / 2; i += NTHREADS) *((f32x4*)R128 + i) = *((const f32x4*)g128 + i);
      for (int i = tid; i < 64 * 16 / 2; i += NTHREADS) *((f32x4*)R64 + i) = *((const f32x4*)g64 + i); }
    __syncthreads();
    bf16* QA = (bf16*)(ws + WS_QA); bf16* QM = (bf16*)(ws + WS_QM); bf16* XC = (bf16*)(ws + WS_XC);
    bf16* KAL = (bf16*)(ws + WS_KAL); bf16* VAL = (bf16*)(ws + WS_VAL); bf16* KAC = (bf16*)(ws + WS_KAC); bf16* VAC = (bf16*)(ws + WS_VAC);
    bf16* CKV = (bf16*)(ws + WS_CKV); bf16* KR = (bf16*)(ws + WS_KR);
    for (int job = gw; job < NB_L * PAST; job += NGW) {
            const int cb = job / PAST, p = job % PAST; float x[8];
            const size_t crow_ = ((size_t)(cb * DEPTH + l) * PAST + p);
            if (lane < 32) { ld8f(a->in[I_CK] + crow_ * 256 + 8 * lane, x); st8bf(KAL + ((size_t)cb * SKV_L + p) * 256 + 8 * lane, x);
                             ld8f(a->in[I_CV] + crow_ * 256 + 8 * lane, x); st8bf(VAL + ((size_t)cb * SKV_L + p) * 256 + 8 * lane, x); }
            const size_t krow = (size_t)M_C + (size_t)cb * SKV_L + p;
            ld8f(a->in[I_CCKV] + crow_ * 512 + 8 * lane, x); st8bf(CKV + krow * 512 + 8 * lane, x);
            if (lane < 8) { ld8f(a->in[I_CKR] + crow_ * 64 + 8 * lane, x); st8bf(KR + krow * 64 + 8 * lane, x); }
    }
    const int rpw = (MTOK + NGW - 1) / NGW, rbeg = gw * rpw, rend = (rbeg + rpw < MTOK) ? rbeg + rpw : MTOK;
    const v4u z4u = (v4u){0u, 0u, 0u, 0u};
    v4u win[2][4];
#pragma unroll
    for (int k = 0; k < 2; ++k)
#pragma unroll
        for (int j = 0; j < 4; ++j) { const int q = rbeg + j - 1; win[k][j] = (rbeg < rend && q >= 0 && q < MTOK) ? *(const v4u*)(PROJ + (size_t)q * NPROJ + C_XR + 8 * lane + 512 * k) : z4u; }
    v4u cur6[6];
#define PP_LOAD6(dst, rowi) do { const bf16* p_ = PROJ + (size_t)(rowi) * NPROJ; const bool ok_ = (rowi) < rend; \
      dst[0] = ok_ ? __builtin_nontemporal_load((const v4u*)(p_ + C_QA + 8 * lane)) : z4u; dst[1] = ok_ ? __builtin_nontemporal_load((const v4u*)(p_ + C_KA + 8 * lane)) : z4u; \
      dst[2] = ok_ ? __builtin_nontemporal_load((const v4u*)(p_ + C_CKV + 8 * lane)) : z4u; dst[3] = ok_ ? __builtin_nontemporal_load((const v4u*)(p_ + C_KR + 8 * (lane & 7))) : z4u; \
      dst[4] = ok_ ? __builtin_nontemporal_load((const v4u*)(p_ + C_QM + 8 * lane)) : z4u; dst[5] = (ok_ && lane < 32) ? __builtin_nontemporal_load((const v4u*)(p_ + C_QM + 8 * (64 + lane))) : z4u; } while (0)
    PP_LOAD6(cur6, rbeg);
    for (int job = rbeg; job < rend; ++job) {
        const int r = job; const bool lat = r >= M_C;
        const int b = lat ? (r - M_C) / S_L : r / S_C, t = lat ? (r - M_C) % S_L : r % S_C, slen = lat ? S_L : S_C;
        const int prow = t >> 6, pcol = t & 63;
        const bf16* pr = PROJ + (size_t)r * NPROJ;
        const size_t krow = lat ? (size_t)M_C + (size_t)b * SKV_L + PAST + t : (size_t)r;
        const size_t orow = ((size_t)(b * DEPTH + l) * S_C + t);
        float x[8];
        const v4u rq = cur6[0], rkv = cur6[1], rckv = cur6[2], rkr = cur6[3], rqm0 = cur6[4], rqm1 = cur6[5];
        PP_LOAD6(cur6, job + 1);
        v4u nxt[2];
#pragma unroll
        for (int k = 0; k < 2; ++k) nxt[k] = (job + 1 < rend && r + 3 < MTOK) ? *(const v4u*)(pr + (ptrdiff_t)3 * NPROJ + C_XR + 8 * lane + 512 * k) : z4u;
        v4u rx[2][4];
#pragma unroll
        for (int k = 0; k < 2; ++k)
#pragma unroll
            for (int j = 0; j < 4; ++j) { const int tt = t + j - 1; rx[k][j] = (tt >= 0 && tt < slen) ? win[k][j] : z4u; }
#pragma unroll
        for (int k = 0; k < 2; ++k) { win[k][0] = win[k][1]; win[k][1] = win[k][2]; win[k][2] = win[k][3]; win[k][3] = nxt[k]; }
        { unpk8(rq, x); float ss = 0.f;
#pragma unroll
          for (int i = 0; i < 8; ++i) ss += x[i] * x[i];
          ss += shfl_xor_(ss, 1); ss += shfl_xor_(ss, 2); ss += shfl_xor_(ss, 4); ss += shfl_xor_(ss, 8);
          const float rs = rsqrtf(ss * (1.0f / 128.0f) + NORM_EPS); float g[8]; ld8f(LGQ + 8 * (lane & 15), g);
#pragma unroll
          for (int i = 0; i < 8; ++i) x[i] = x[i] * rs * g[i];
          if (lat) { const int s = lane & 15; rope8(x, 4, (s & 7) < 4, R128 + ((s >> 3) ? pcol : prow) * 32 + 8 * (s & 3)); }
          st8bf(QA + (size_t)r * 512 + 8 * lane, x); }
        { unpk8(rkv, x); float ss = 0.f;
#pragma unroll
          for (int i = 0; i < 8; ++i) ss += x[i] * x[i];
          ss += shfl_xor_(ss, 1); ss += shfl_xor_(ss, 2); ss += shfl_xor_(ss, 4); ss += shfl_xor_(ss, 8);
          const float rs = rsqrtf(ss * (1.0f / 128.0f) + NORM_EPS); float g[8]; ld8f(LGK + 8 * (lane & 15), g);
          float y[8];
#pragma unroll
          for (int i = 0; i < 8; ++i) y[i] = x[i] * rs * g[i];
          if (lat) { const int s = lane & 15; rope8(y, 4, (s & 7) < 4, R128 + ((s >> 3) ? pcol : prow) * 32 + 8 * (s & 3)); }
          if (lane < 32) {
              if (lat) st8bf(KAL + ((size_t)b * SKV_L + PAST + t) * 256 + 8 * lane, y);
              else { st8bf(KAC + (size_t)r * 256 + 8 * lane, y); st8f_nt(a->out + O_K + orow * 256 + 8 * lane, y); }
          } else { const int c = 8 * (lane - 32);
              if (lat) st8bf(VAL + ((size_t)b * SKV_L + PAST + t) * 256 + c, x);
              else { st8bf(VAC + (size_t)r * 256 + c, x); st8f_nt(a->out + O_V + orow * 256 + c, x); }
          } }
#pragma unroll
        for (int k = 0; k < 2; ++k) { const int c = 8 * lane + 512 * k; float acc[8]; ld8f(LCB + c, acc);
#pragma unroll
          for (int j = 0; j < 4; ++j) { float xv[8], w[8]; unpk8(rx[k][j], xv); ld8f(LCW + j * LRU_W + c, w);
#pragma unroll
              for (int i = 0; i < 8; ++i) acc[i] += w[i] * xv[i]; }
          st8bf(XC + (size_t)r * LRU_W + c, acc); }
#pragma unroll
        for (int ps = 0; ps < 2; ++ps) { const int s = 64 * ps + lane; const bool act = (ps == 0) || lane < 32; const int s24 = s % 24;
          unpk8(ps == 0 ? rqm0 : rqm1, x);
          if (lat) { float y[8];
#pragma unroll
              for (int i = 0; i < 8; ++i) y[i] = x[i];
              const int sr = (s24 - 16) & 7; rope8(y, 2, (sr & 3) < 2, R64 + ((sr >> 2) ? pcol : prow) * 16 + 8 * (sr & 1));
              if (s24 >= 16) {
#pragma unroll
                  for (int i = 0; i < 8; ++i) x[i] = y[i]; } }
          if (act) st8bf(QM + (size_t)r * 768 + 8 * s, x); }
        { unpk8(rckv, x); float ss = 0.f;
#pragma unroll
          for (int i = 0; i < 8; ++i) ss += x[i] * x[i];
          const float rs = rsqrtf(wave_sum(ss) * (1.0f / 512.0f) + NORM_EPS); float g[8]; ld8f(LGKV + 8 * lane, g);
#pragma unroll
          for (int i = 0; i < 8; ++i) x[i] = x[i] * rs * g[i];
          st8bf(CKV + krow * 512 + 8 * lane, x); if (!lat) st8f_nt(a->out + O_CKV + orow * 512 + 8 * lane, x); }
        { const int ll = lane & 7; unpk8(rkr, x);
          if (lat) rope8(x, 2, (ll & 3) < 2, R64 + ((ll >> 2) ? pcol : prow) * 16 + 8 * (ll & 1));
          if (lane < 8) { st8bf(KR + krow * 64 + 8 * lane, x); if (!lat) st8f_nt(a->out + O_KR + orow * 64 + 8 * lane, x); } }
    }
}

namespace lru {
__device__ __forceinline__ void swap2(float x, float& lo, float& hh) { auto rr = __builtin_amdgcn_permlane32_swap(__float_as_uint(x), __float_as_uint(x), false, false); lo = __uint_as_float(rr[0]); hh = __uint_as_float(rr[1]); }
template <int DIR> __device__ __forceinline__ void compose(const f32x16& av, const f32x16& uv, float (&Aq)[4], float (&Bq)[4]) {
#pragma unroll
    for (int q = 0; q < 4; ++q) {
        if (DIR == 0) { float A = av[4 * q], B = uv[4 * q];
#pragma unroll
            for (int i = 1; i < 4; ++i) { B = B * av[4 * q + i] + uv[4 * q + i]; A *= av[4 * q + i]; }
            Aq[q] = A; Bq[q] = B; }
        else { float A = av[4 * q + 3], B = uv[4 * q + 3];
#pragma unroll
            for (int i = 2; i >= 0; --i) { B = B * av[4 * q + i] + uv[4 * q + i]; A *= av[4 * q + i]; }
            Aq[q] = A; Bq[q] = B; }
    }
}
template <int DIR> __device__ __forceinline__ float chain(const float (&Aq)[4], const float (&Bq)[4], float h0, int hi, float (&hin)[4]) {
    float hcur = h0;
#pragma unroll
    for (int qq = 0; qq < 4; ++qq) { const int q = DIR == 0 ? qq : 3 - qq;
        float lo, hh; const float t0 = Aq[q] * hcur + Bq[q]; swap2(t0, lo, hh);
        const float x0 = DIR == 0 ? lo : hh;
        const float t1 = Aq[q] * x0 + Bq[q]; swap2(t1, lo, hh);
        const bool first = DIR == 0 ? (hi == 0) : (hi == 1);
        hin[q] = first ? hcur : x0;
        hcur = DIR == 0 ? hh : lo; }
    return hcur;
}
template <int DIR> __device__ __forceinline__ void expand(const f32x16& av, const f32x16& uv, const float (&hin)[4], f32x16& h) {
#pragma unroll
    for (int q = 0; q < 4; ++q) { float s = hin[q];
        if (DIR == 0) {
#pragma unroll
            for (int i = 0; i < 4; ++i) { s = av[4 * q + i] * s + uv[4 * q + i]; h[4 * q + i] = s; } }
        else {
#pragma unroll
            for (int i = 3; i >= 0; --i) { s = av[4 * q + i] * s + uv[4 * q + i]; h[4 * q + i] = s; } }
    }
}
constexpr int LDS_W = 0, LDS_S = 131072, LDS_TIN = LDS_S + 8192, LDS_LC = LDS_TIN + 2048, LDS_LRU = LDS_LC + 4096;
static_assert(LDS_LRU <= RING_BYTES, "LRU LDS");
}

template <bool FINAL, bool LOOKBACK = false>
__device__ __forceinline__ void phase_lru(KArgs a, int l, char* lds, int wg, int G, int tid) {
    unsigned char* ws = a->ws; const bf16* XC = (const bf16*)(ws + WS_XC); const bf16* WGl = (const bf16*)(ws + WS_WG) + (size_t)l * 32 * 16384;
    const bf16* PROJ = (const bf16*)(ws + WS_PROJ); bf16* MIX = (bf16*)(ws + WS_MIX); float2* SUMM = (float2*)(ws + WS_SUMM);
    const int lane = tid & 63, w = __builtin_amdgcn_readfirstlane(tid >> 6), r32 = lane & 31, hi = lane >> 5;
    float2* S = (float2*)(lds + lru::LDS_S); float* TIN = (float*)(lds + lru::LDS_TIN);
    bf16x8 idb[2];
#pragma unroll
    for (int s = 0; s < 2; ++s)
#pragma unroll
        for (int i = 0; i < 8; ++i) idb[s][i] = (r32 - 16 * s - 8 * hi == i) ? (short)0x3F80 : (short)0;
#if LRU_STAMPS
    unsigned long long* lts = (unsigned long long*)(ws + WS_DBG); const bool lst = FINAL && l == 1 && wg == 0 && tid == 0;
#define LSTAMP(k) do { if (lst) lts[k] = __builtin_amdgcn_s_memrealtime(); } while (0)
#else
#define LSTAMP(k) do { } while (0)
#endif
    LSTAMP(0);
    const int nunits = FINAL ? 96 * 8 : 64 * 8;
    const bool staged = (G & 7) == 0;
    if (staged) { const bf16* src = WGl + (size_t)(wg & 7) * 4 * 16384;
#pragma unroll 4
        for (int i = 0; i < 16; ++i) { const int q = tid + 512 * i, mat = q >> 11, row = (q >> 4) & 127, c16 = q & 15;
            *(bf16x8*)(lds + lru::LDS_W + mat * 32768 + KSWZ(row, c16 * 16)) = *(const bf16x8*)(src + (size_t)q * 8); }
        if (tid < 256) { const int dir = tid >> 7, ch = tid & 127, c = (wg & 7) * 128 + ch; const float lam = a->in[I_LLAM][(l * 2 + dir) * LRU_W + c];
            ((f32x4*)(lds + lru::LDS_LC))[tid] = (f32x4){a->in[I_LBA][(l * 2 + dir) * LRU_W + c], a->in[I_LBX][(l * 2 + dir) * LRU_W + c], -log1pf(__expf(-lam)) * (8.0f * 1.4426950408889634f), 0.f}; }
        __syncthreads(); }
    LSTAMP(1);
    int par = 0;
    for (int u = wg; u < nunits; u += G, par ^= 1) {
        const int n = u & 7, tile = FINAL ? (u >> 3) : 32 + (u >> 3); const bool lat = tile >= 32;
        const size_t row0 = (size_t)tile * 256 + (size_t)w * 32;
        if (FINAL && !LOOKBACK && tid < 256) {
            const int dir = tid >> 7, ch = tid & 127, c = n * 128 + ch; float h = 0.f;
            if (lat) { const int b = (tile - 32) >> 4, jt = (tile - 32) & 15; h = a->in[I_ST][((size_t)(b * DEPTH + l) * 2 + dir) * LRU_W + c];
                float2 sv[15];
#pragma unroll
                for (int k = 0; k < 15; ++k) { const int jj = dir == 0 ? k : 15 - k; const bool use = dir == 0 ? (jj < jt) : (jj > jt);
                    sv[k] = use ? SUMM[(size_t)(dir * 64 + b * 16 + jj) * LRU_W + c] : make_float2(1.f, 0.f); }
#pragma unroll
                for (int k = 0; k < 15; ++k) h = sv[k].x * h + sv[k].y; }
            TIN[(par * 2 + dir) * 128 + ch] = h; }
        bf16x8 af[8];
        { const bf16* ap = XC + (row0 + r32) * LRU_W + n * 128 + hi * 8;
#pragma unroll
          for (int ks = 0; ks < 8; ++ks) af[ks] = *(const bf16x8*)(ap + ks * 16); }
#pragma unroll 1
        for (int nb = 0; nb < 4; ++nb) {
            if (u == wg && nb == LS_NB) LSTAMP(2);
            const int c = n * 128 + nb * 32 + r32, buf = nb & 1;
            f32x16 av[2], uv[2];
            bf16x8 gf0, gf1;
            if (FINAL) { const bf16* gp = PROJ + (row0 + r32) * NPROJ + C_GR + n * 128 + hi * 8; gf0 = *(const bf16x8*)(gp + (2 * nb) * 16); gf1 = *(const bf16x8*)(gp + (2 * nb + 1) * 16); }
            {
                f32x16 xv = f32x16{};
#pragma unroll
                for (int ks = 0; ks < 8; ++ks) { if ((ks >> 1) == nb) xv = __builtin_amdgcn_mfma_f32_32x32x16_bf16(af[ks], idb[ks & 1], xv, 0, 0, 0); }
#pragma unroll
                for (int dir = 0; dir < 2; ++dir) {
                    f32x16 ga = f32x16{}, gx = f32x16{};
                    const bf16* bp0 = WGl + (size_t)((n * 2 + dir) * 2 + 0) * 16384 + (size_t)(nb * 32 + r32) * 128 + hi * 8; const bf16* bp1 = bp0 + 16384;
                    if (staged) { const char* lw = lds + lru::LDS_W + (dir * 2) * 32768; const int rw = nb * 32 + r32;
#pragma unroll
                        for (int kh = 0; kh < 4; ++kh) {
                            bf16x8 b0[2], b1[2];
#pragma unroll
                            for (int k4 = 0; k4 < 2; ++k4) { const int cb = ((kh * 2 + k4) * 16 + hi * 8) * 2; b0[k4] = *(const bf16x8*)(lw + KSWZ(rw, cb)); b1[k4] = *(const bf16x8*)(lw + 32768 + KSWZ(rw, cb)); }
                            __builtin_amdgcn_sched_barrier(0);
#pragma unroll
                            for (int k4 = 0; k4 < 2; ++k4) { ga = __builtin_amdgcn_mfma_f32_32x32x16_bf16(af[kh * 2 + k4], b0[k4], ga, 0, 0, 0); gx = __builtin_amdgcn_mfma_f32_32x32x16_bf16(af[kh * 2 + k4], b1[k4], gx, 0, 0, 0); }
                            __builtin_amdgcn_sched_barrier(0); }
                    } else {
#pragma unroll
                        for (int ks = 0; ks < 8; ++ks) { const bf16x8 b0 = *(const bf16x8*)(bp0 + ks * 16), b1 = *(const bf16x8*)(bp1 + ks * 16);
                            ga = __builtin_amdgcn_mfma_f32_32x32x16_bf16(af[ks], b0, ga, 0, 0, 0); gx = __builtin_amdgcn_mfma_f32_32x32x16_bf16(af[ks], b1, gx, 0, 0, 0); } }
                    float ba, bx, lsg;
                    if (staged) { const f32x4 lc = ((const f32x4*)(lds + lru::LDS_LC))[dir * 128 + nb * 32 + r32]; ba = lc.x; bx = lc.y; lsg = lc.z; }
                    else { const float lam = a->in[I_LLAM][(l * 2 + dir) * LRU_W + c]; ba = a->in[I_LBA][(l * 2 + dir) * LRU_W + c]; bx = a->in[I_LBX][(l * 2 + dir) * LRU_W + c]; lsg = -log1pf(__expf(-lam)) * (8.0f * 1.4426950408889634f); }
                    {
                        typedef float f32x2 __attribute__((ext_vector_type(2)));
                        const float nL = -1.4426950408889634f, nbaL = ba * nL, nbxL = bx * nL;
#pragma unroll
                        for (int r = 0; r < 16; r += 2) {
                            const f32x2 g1 = (f32x2){ga[r], ga[r + 1]}, g2 = (f32x2){gx[r], gx[r + 1]}, x2 = (f32x2){xv[r], xv[r + 1]};
                            const f32x2 t1 = g1 * nL + nbaL, t2 = g2 * nL + nbxL;
                            const f32x2 d1 = (f32x2){__builtin_amdgcn_exp2f(t1.x), __builtin_amdgcn_exp2f(t1.y)} + 1.0f, d2 = (f32x2){__builtin_amdgcn_exp2f(t2.x), __builtin_amdgcn_exp2f(t2.y)} + 1.0f;
                            const f32x2 pr = d1 * d2; const f32x2 rr = (f32x2){__builtin_amdgcn_rcpf(pr.x), __builtin_amdgcn_rcpf(pr.y)};
                            const f32x2 rg = rr * d2, ig = rr * d1, ta = rg * lsg;
                            const f32x2 aa = (f32x2){__builtin_amdgcn_exp2f(ta.x), __builtin_amdgcn_exp2f(ta.y)};
                            f32x2 om = 1.0f - aa * aa; om.x = fmaxf(om.x, 0.f); om.y = fmaxf(om.y, 0.f);
                            const f32x2 uu = (f32x2){__builtin_amdgcn_sqrtf(om.x), __builtin_amdgcn_sqrtf(om.y)} * (ig * x2);
                            av[dir][r] = aa.x; av[dir][r + 1] = aa.y; uv[dir][r] = uu.x; uv[dir][r + 1] = uu.y; } }
                    float Aq[4], Bq[4], hin[4]; float Bsb;
                    if (dir == 0) { lru::compose<0>(av[0], uv[0], Aq, Bq); Bsb = lru::chain<0>(Aq, Bq, 0.f, hi, hin); }
                    else { lru::compose<1>(av[1], uv[1], Aq, Bq); Bsb = lru::chain<1>(Aq, Bq, 0.f, hi, hin); }
                    float lo, hh; lru::swap2((Aq[0] * Aq[1]) * (Aq[2] * Aq[3]), lo, hh);
                    if (hi == 0) S[((buf * 2 + dir) * 8 + w) * 32 + r32] = make_float2(lo * hh, Bsb);
                }
            }
            if (u == wg && nb == LS_NB) LSTAMP(3);
            __syncthreads();
            if (FINAL && LOOKBACK) {
                if (lat) {
                    if (w == 0) {
                        const int dir = lane >> 5, chl = lane & 31, cc = n * 128 + nb * 32 + chl, lt = tile - 32, b = lt >> 4, jt = lt & 15;
                        float hA = 0.f, PA = 1.f;
                        if (dir == 0) { for (int ww = 0; ww < 8; ++ww) { const float2 s = S[((buf * 2 + 0) * 8 + ww) * 32 + chl]; hA = s.x * hA + s.y; PA *= s.x; } }
                        else { for (int ww = 7; ww >= 0; --ww) { const float2 s = S[((buf * 2 + 1) * 8 + ww) * 32 + chl]; hA = s.x * hA + s.y; PA *= s.x; } }
                        unsigned long long* AGG = (unsigned long long*)SUMM;
                        __hip_atomic_store(AGG + (size_t)(dir * 64 + lt) * LRU_W + cc, ((unsigned long long)__float_as_uint(hA) << 32) | __float_as_uint(PA), __ATOMIC_RELAXED, __HIP_MEMORY_SCOPE_AGENT);
                        asm volatile("s_waitcnt vmcnt(0)" ::: "memory");
                        unsigned* FLG = (unsigned*)(ws + WS_CTL) + CW_LRUF;
                        if (lane == 0) __hip_atomic_store(FLG + (size_t)((lt * 8 + n) * 4 + nb) * 16, (unsigned)(l + 1), __ATOMIC_RELAXED, __HIP_MEMORY_SCOPE_AGENT);
                        {   unsigned spins = 0; const unsigned* fp = FLG + (size_t)(((b * 16 + (lane & 15)) * 8 + n) * 4 + nb) * 16;
                            while (!__all(__hip_atomic_load(fp, __ATOMIC_RELAXED, __HIP_MEMORY_SCOPE_AGENT) >= (unsigned)(l + 1))) {
                                __builtin_amdgcn_s_sleep(1);
                                if (++spins > (1u << 20)) { if (lane == 0) __hip_atomic_store((unsigned*)(ws + WS_CTL) + CW_TMO, 0x1b00u, __ATOMIC_RELAXED, __HIP_MEMORY_SCOPE_AGENT); break; } } }
                        __builtin_amdgcn_fence(__ATOMIC_ACQUIRE, "agent");
                        float h = a->in[I_ST][((size_t)(b * DEPTH + l) * 2 + dir) * LRU_W + cc];
#pragma unroll 1
                        for (int k0 = 0; k0 < 15; k0 += 5) {
                            unsigned long long sv[5];
#pragma unroll
                            for (int k = 0; k < 5; ++k) { const int jj = dir == 0 ? k0 + k : 15 - (k0 + k); const bool use = dir == 0 ? (jj < jt) : (jj > jt);
                                sv[k] = use ? __hip_atomic_load(AGG + (size_t)(dir * 64 + b * 16 + jj) * LRU_W + cc, __ATOMIC_RELAXED, __HIP_MEMORY_SCOPE_AGENT) : 0x000000003f800000ull; }
#pragma unroll
                            for (int k = 0; k < 5; ++k) h = __uint_as_float((unsigned)sv[k]) * h + __uint_as_float((unsigned)(sv[k] >> 32)); }
                        TIN[(par * 2 + dir) * 128 + nb * 32 + chl] = h;
                    }
                    __syncthreads();
                } else if (tid < 64) TIN[(par * 2 + (tid >> 5)) * 128 + nb * 32 + (tid & 31)] = 0.f;
                if (!lat) __syncthreads();
            }
            if (u == wg && nb == LS_NB) LSTAMP(4);
            if (!FINAL) {
                if (tid < 64) { const int dir = tid >> 5, chl = tid & 31; float h = 0.f, P = 1.f;
                    if (dir == 0) { for (int ww = 0; ww < 8; ++ww) { const float2 s = S[((buf * 2 + 0) * 8 + ww) * 32 + chl]; h = s.x * h + s.y; P *= s.x; } }
                    else { for (int ww = 7; ww >= 0; --ww) { const float2 s = S[((buf * 2 + 1) * 8 + ww) * 32 + chl]; h = s.x * h + s.y; P *= s.x; } }
                    SUMM[(size_t)(dir * 64 + (tile - 32)) * LRU_W + n * 128 + nb * 32 + chl] = make_float2(P, h); }
            } else {
                float hf_in = TIN[(par * 2 + 0) * 128 + nb * 32 + r32], hb_in = TIN[(par * 2 + 1) * 128 + nb * 32 + r32];
                for (int ww = 0; ww < w; ++ww) { const float2 s = S[((buf * 2 + 0) * 8 + ww) * 32 + r32]; hf_in = s.x * hf_in + s.y; }
                for (int ww = 7; ww > w; --ww) { const float2 s = S[((buf * 2 + 1) * 8 + ww) * 32 + r32]; hb_in = s.x * hb_in + s.y; }
                f32x16 hsum;
                {   float Aq[4], Bq[4], hin[4]; f32x16 hf, hb;
                    lru::compose<0>(av[0], uv[0], Aq, Bq); const float endf = lru::chain<0>(Aq, Bq, hf_in, hi, hin); lru::expand<0>(av[0], uv[0], hin, hf);
                    lru::compose<1>(av[1], uv[1], Aq, Bq); const float endb = lru::chain<1>(Aq, Bq, hb_in, hi, hin); lru::expand<1>(av[1], uv[1], hin, hb);
                    hsum = hf + hb;
                    if (!lat && hi == 0) {
                        if (w == 7) a->out[O_ST + ((size_t)(tile * DEPTH + l) * 2 + 0) * LRU_W + c] = endf;
                        if (w == 0) a->out[O_ST + ((size_t)(tile * DEPTH + l) * 2 + 1) * LRU_W + c] = endb; } }
                f32x16 gv = f32x16{};
                gv = __builtin_amdgcn_mfma_f32_32x32x16_bf16(gf0, idb[0], gv, 0, 0, 0);
                gv = __builtin_amdgcn_mfma_f32_32x32x16_bf16(gf1, idb[1], gv, 0, 0, 0);
#pragma unroll
                for (int r = 0; r < 16; ++r) MIX[(row0 + att::crow(r, hi)) * DM + 512 + c] = (bf16)f2bf(hsum[r] * gelu_tanh(gv[r]));
            }
            if (u == wg && nb == LS_NB) LSTAMP(5);
        }
        if (u == wg) LSTAMP(6);
    }
    LSTAMP(7);
    __syncthreads();
#undef LSTAMP
}

__device__ __forceinline__ void phase_attention_gqa(KArgs a, char* lds, int wg, int G, int wave_id) {
    unsigned char* ws = a->ws;
    const bf16* QA = (const bf16*)(ws + WS_QA); const bf16* KAL = (const bf16*)(ws + WS_KAL); const bf16* VAL = (const bf16*)(ws + WS_VAL); const bf16* KAC = (const bf16*)(ws + WS_KAC); const bf16* VAC = (const bf16*)(ws + WS_VAC);
    bf16* MIX = (bf16*)(ws + WS_MIX);
    for (int u = wg; u < 384; u += G) {
        const bool lat = u < 256; int b, head, seq; size_t row0;
        if (lat) { const int x = u & 7, idx = u >> 3, qb = idx & 15; seq = SKV_L; b = x >> 1; head = (x & 1) * 2 + (idx >> 4); row0 = (size_t)M_C + (size_t)b * S_L + (size_t)qb * 256; }
        else { const int v = u - 256; b = v >> 2; head = v & 3; seq = S_C; row0 = (size_t)b * S_C; }
        const int kvh = head >> 1;
        const bf16* Kp = lat ? KAL + (size_t)b * SKV_L * 256 + kvh * 128 : KAC + (size_t)b * S_C * 256 + kvh * 128;
        const bf16* Vp = lat ? VAL + (size_t)b * SKV_L * 256 + kvh * 128 : VAC + (size_t)b * S_C * 256 + kvh * 128;
        att::attn_body<0, GQA_SD, GQA_NQR, GQA_STG, 512, 256, 64, 256, DM>(QA + row0 * 512 + head * 128, Kp, nullptr, Vp, MIX + row0 * DM + head * 128, seq, lds, wave_id);
    }
}
__device__ __forceinline__ void phase_attention_mla(KArgs a, char* lds, int wg, int G, int wave_id) {
    unsigned char* ws = a->ws;
    const bf16* QM = (const bf16*)(ws + WS_QM); const bf16* KVM = (const bf16*)(ws + WS_KVM); const bf16* KR = (const bf16*)(ws + WS_KR); bf16* MIX = (bf16*)(ws + WS_MIX);
    const int wgc = ((wg - 128) % G + G) % G, nlat = (256 - wg + G - 1) / G;
    for (int i = 0, u = wg; ; ++i) {
        if (i < nlat) u = wg + i * G; else { u = 256 + wgc + (i - nlat) * G; if (u >= 384) break; }
        const bool lat = u < 256; int b, head, seq; size_t row0, key0;
        if (lat) { const int x = u & 7, idx = u >> 3, qb = idx & 15, p = x * 2 + (idx >> 4); seq = SKV_L; b = p >> 2; head = p & 3; row0 = (size_t)M_C + (size_t)b * S_L + (size_t)qb * 256; key0 = (size_t)M_C + (size_t)b * SKV_L; }
        else { const int v = u - 256; b = v >> 2; head = v & 3; seq = S_C; row0 = (size_t)b * S_C; key0 = row0; }
        att::attn_body<64, MLA_SD, MLA_NQR, MLA_STG, 768, 1024, 64, 1024, DM>(QM + row0 * 768 + head * 192, KVM + key0 * 1024 + head * 128, KR + key0 * 64, KVM + key0 * 1024 + 512 + head * 128,
                                                                  MIX + row0 * DM + 1536 + head * 128, seq, lds, wave_id);
    }
}


#ifndef KVM_COUNTER
#define KVM_COUNTER 1
#endif
constexpr int CW_KVMC = 8192;
#ifndef NPASS
#define NPASS 1
#endif
#ifndef SKEW_PROBE
#define SKEW_PROBE 0
#endif
#ifndef SK_LO
#define SK_LO 0
#endif
#ifndef SK_HI
#define SK_HI 42
#endif
#ifndef SK_USED
#define SK_USED 0
#endif
#ifndef SK_MASK
#define SK_MASK 0x7ff
#endif
#ifndef STAMP_OFF
#define STAMP_OFF 0.0f
#endif
#ifndef STAMP_SCALE
#define STAMP_SCALE 1.0f
#endif
#ifndef STAMP_A
#define STAMP_A -1
#define STAMP_B -1
#endif
#ifndef FFN_DBG
#define FFN_DBG 0
#endif
#ifndef DBG_SEL
#define DBG_SEL(r, c) 0
#endif
#ifndef DBG_REPORT
#define DBG_REPORT (10000.0f * (float)tot / (24576.0f * 5632.0f))
#endif
#ifndef FFN_UNFUSED
#define FFN_UNFUSED 0
#endif
__device__ __forceinline__ void phase_ffn_act_dbg(KArgs a, int l, int gtid, int NTHR) {
    const bf16* U = (const bf16*)(a->ws + WS_U); bf16* ACT = (bf16*)(a->ws + WS_ACT);
    const float* cw = a->in[I_FCW] + (size_t)l * 3 * NUP; const float* cb = a->in[I_FCB] + (size_t)l * NUP;
    constexpr int CG = DFF / 8;
    for (long i = gtid; i < (long)MTOK * CG; i += NTHR) {
        const int r = (int)(i / CG), c = (int)(i % CG) * 8; const bool lat = r >= M_C; const int t = lat ? (r - M_C) % S_L : r % S_C, slen = lat ? S_L : S_C;
        const int ucol = (c / 128) * 256 + (c % 128);
        float g[8], v[8]; ld8f(cb + c, g); ld8f(cb + DFF + c, v);
#pragma unroll
        for (int j = 0; j < 3; ++j) { const int tt = t + j - 1; if (tt >= 0 && tt < slen) { float xg[8], xv[8], wg_[8], wv[8]; const bf16* ur = U + (size_t)(r + j - 1) * NUP;
            ld8bf(ur + ucol, xg); ld8bf(ur + ucol + 128, xv); ld8f(cw + (size_t)j * NUP + c, wg_); ld8f(cw + (size_t)j * NUP + DFF + c, wv);
#pragma unroll
            for (int e = 0; e < 8; ++e) { g[e] += wg_[e] * xg[e]; v[e] += wv[e] * xv[e]; } } }
        float o[8];
#pragma unroll
        for (int e = 0; e < 8; ++e) o[e] = siluf_(g[e]) * v[e];
        st8bf(ACT + (size_t)r * DFF + c, o);
    }
}
__device__ __forceinline__ void phase_ffn_cmp_dbg(KArgs a, int l, int gtid, int NTHR) {
    const bf16* U = (const bf16*)(a->ws + WS_U); bf16* ACT = (bf16*)(a->ws + WS_ACT);
    const float* cw = a->in[I_FCW] + (size_t)l * 3 * NUP; const float* cb = a->in[I_FCB] + (size_t)l * NUP;
    constexpr int CG = DFF / 8;
    for (long i = gtid; i < (long)MTOK * CG; i += NTHR) {
        const int r = (int)(i / CG), c = (int)(i % CG) * 8; const bool lat = r >= M_C; const int t = lat ? (r - M_C) % S_L : r % S_C, slen = lat ? S_L : S_C;
        const int ucol = (c / 128) * 256 + (c % 128);
        float g[8], v[8]; ld8f(cb + c, g); ld8f(cb + DFF + c, v);
#pragma unroll
        for (int j = 0; j < 3; ++j) { const int tt = t + j - 1; if (tt >= 0 && tt < slen && (!CONV_CENTER_ONLY || j == 1)) { float xg[8], xv[8], wg_[8], wv[8]; const bf16* ur = U + (size_t)(r + j - 1) * NUP;
            ld8bf(ur + ucol, xg); ld8bf(ur + ucol + 128, xv); ld8f(cw + (size_t)j * NUP + c, wg_); ld8f(cw + (size_t)j * NUP + DFF + c, wv);
#pragma unroll
            for (int e = 0; e < 8; ++e) { g[e] += wg_[e] * xg[e]; v[e] += wv[e] * xv[e]; } } }
        float o[8];
#pragma unroll
        for (int e = 0; e < 8; ++e) o[e] = siluf_(g[e]) * v[e];
        if ((t & 255) != 0 && (t & 255) != 255) { float f[8]; ld8bf(ACT + (size_t)r * DFF + c, f); unsigned bad = 0;
#pragma unroll
            for (int e = 0; e < 8; ++e) bad += (fabsf(f[e] - o[e]) > 0.02f * (fabsf(o[e]) + 0.05f)) ? 1u : 0u;
            if (bad) atomicAdd((unsigned*)(a->ws + WS_CTL) + CW_CHK + DBG_SEL(r, c), bad); }
    }
}
__device__ __forceinline__ void phase_ffn_fix(KArgs a, int l, int gtid, int NTHR) {
    const bf16* HALO = (const bf16*)(a->ws + WS_HALO); bf16* ACT = (bf16*)(a->ws + WS_ACT);
    const float* cw = a->in[I_FCW] + (size_t)l * 3 * NUP; const float* cb = a->in[I_FCB] + (size_t)l * NUP;
    constexpr int CG = DFF / 8;
    for (int i = gtid; i < 64 * 2 * CG; i += NTHR) {
        const int lt = i / (2 * CG), side = (i / CG) & 1, c = (i % CG) * 8, jt = lt & 15;
        if ((side == 0 && jt == 0) || (side == 1 && jt == 15)) continue;
        const int pn = c / 128, cl = c % 128;
        const int t0 = side == 0 ? lt - 1 : lt, h0 = side == 0 ? 3 : 2, t1 = lt, h1 = side == 0 ? 0 : 3, t2 = side == 0 ? lt : lt + 1, h2 = side == 0 ? 1 : 0;
        float g[8], v[8]; ld8f(cb + c, g); ld8f(cb + DFF + c, v);
        const int tt[3] = {t0, t1, t2}, hh[3] = {h0, h1, h2};
#pragma unroll
        for (int j = 0; j < 3; ++j) { const bf16* hr = HALO + ((size_t)(tt[j] * 4 + hh[j]) * 44 + pn) * 256 + cl; float xg[8], xv[8], wg_[8], wv[8];
            ld8bf(hr, xg); ld8bf(hr + 128, xv); ld8f(cw + (size_t)j * NUP + c, wg_); ld8f(cw + (size_t)j * NUP + DFF + c, wv);
#pragma unroll
            for (int e = 0; e < 8; ++e) { g[e] += wg_[e] * xg[e]; v[e] += wv[e] * xv[e]; } }
        float o[8];
#pragma unroll
        for (int e = 0; e < 8; ++e) o[e] = siluf_(g[e]) * v[e];
        const size_t row = (size_t)M_C + (size_t)lt * 256 + (side ? 255 : 0);
        st8bf(ACT + row * DFF + c, o);
    }
}

#ifndef EN_AT2
#define EN_AT2 1
#endif
#ifndef REP_GEMM
#define REP_GEMM 1
#endif
#ifndef REP_AT
#define REP_AT 1
#endif
#ifndef REP_LRU
#define REP_LRU 1
#endif
#ifndef REP_RW
#define REP_RW 1
#endif
#ifndef EN_P0
#define EN_P0 1
#endif
#ifndef EN_P1
#define EN_P1 1
#endif
#ifndef EN_G1
#define EN_G1 1
#endif
#ifndef EN_PP
#define EN_PP 1
#endif
#ifndef EN_LG
#define EN_LG 1
#endif
#ifndef EN_LS
#define EN_LS 1
#endif
#ifndef EN_AT
#define EN_AT 1
#endif
#ifndef EN_LF
#define EN_LF 1
#endif
#ifndef EN_G2
#define EN_G2 1
#endif
#ifndef EN_R1
#define EN_R1 1
#endif
#ifndef EN_G3
#define EN_G3 1
#endif
#ifndef EN_FA
#define EN_FA 1
#endif
#ifndef EN_G4
#define EN_G4 1
#endif
#ifndef EN_R2
#define EN_R2 1
#endif
__global__ void __launch_bounds__(NTHREADS, 2) fwd_kernel(Args args) {
    extern __shared__ __attribute__((aligned(16))) unsigned char lds_raw[];
    const KArgs ka = (KArgs)__builtin_amdgcn_kernarg_segment_ptr();
    const int wave0 = __builtin_amdgcn_readfirstlane((int)threadIdx.x >> 6);
    const int G = gridDim.x, bx = blockIdx.x;
    const int vcu = (G % 8 == 0) ? (bx % 8) * (G / 8) + bx / 8 : bx;
    const int NGW = G * NWAVES, NTHR = G * NTHREADS;
#define PH_IDS const int tid = ltid(wave0), lane = tid & 63, wave = __builtin_amdgcn_readfirstlane(tid >> 6), gw = vcu * NWAVES + wave, gtid = vcu * NTHREADS + tid; (void)lane; (void)wave; (void)gw; (void)gtid; const KArgs a = launder(ka)
    LAS unsigned char* ldsL = (LAS unsigned char*)lds_raw; char* lds = (char*)lds_raw;
    volatile LAS unsigned* MISC = (volatile LAS unsigned*)(ldsL + MISC_OFF);
    for (int u = ltid(wave0); u < (LDS_BYTES - LDSCTL_OFF) / 4; u += NTHREADS) ((LAS unsigned*)(ldsL + LDSCTL_OFF))[u] = 0u;
    __syncthreads();
    unsigned* ctl = (unsigned*)(ka->ws + WS_CTL);
#if MK_MULTI
#define GRID_BAR() do { } while (0)
#else
    XcdBarrier bar = xcd_barrier_post(ctl + CW_BAR, MISC + 8, wave0);
#define GRID_BAR() xcd_barrier(bar)
#endif
    const int lo = ka->ph_lo, hi = ka->ph_hi;
#define IN(k) (lo <= (k) && (k) < hi)
#define SEAM(k) do { if (SKEW_PROBE) { if (ltid(wave0) == 0) ((unsigned long long*)(ka->ws + WS_DBG))[(k) * 256 + bx] = __builtin_amdgcn_s_memrealtime(); } if (IN(k) && IN((k) + 1)) GRID_BAR(); else __syncthreads(); if (STAMP_A >= 0) { if ((k) + 1 == STAMP_A) tsA = __builtin_amdgcn_s_memrealtime(); if ((k) + 1 == STAMP_B) tsB = __builtin_amdgcn_s_memrealtime(); } } while (0)
    unsigned long long tsA = 0, tsB = 0; if (STAMP_A == 0) tsA = __builtin_amdgcn_s_memrealtime();
#ifdef CAL_SPIN_TICKS
    if (bx == 0) { const unsigned long long t0 = __builtin_amdgcn_s_memrealtime(); while (__builtin_amdgcn_s_memrealtime() - t0 < (unsigned long long)CAL_SPIN_TICKS) __builtin_amdgcn_s_sleep(8); }
#endif
#if NPASS > 1
    for (int pass = 0; pass < NPASS; ++pass) {
#endif
    if (EN_P0 && IN(0)) { PH_IDS; phase_prologue(a, lds, gw, NGW, wave, lane); } SEAM(0);
    if (EN_P0 && IN(1)) { PH_IDS; phase_mod_reduce(a, gtid, NTHR); } SEAM(1);
    if (EN_P1 && IN(2)) { PH_IDS; phase_first_norm(a, lds, bx, G, tid); } SEAM(2);

    for (int l = 0; l < DEPTH; ++l) {
        const int pb = PH_PRE + l * PH_PER_LAYER;
        if (EN_G1 && IN(pb + 0)) {
            unsigned char* ws = launder(ka)->ws;
            pg8::Gemm g{(const bf16*)(ws + WS_H), (const bf16*)(ws + WS_WIN) + (size_t)l * NPROJ * DM, MTOK, NPROJ, DM}; pg8::StaticOrder S; S.init(MTOK, NPROJ, G, bx);
            pg8::EpiBf16<0> E{(bf16*)(ws + WS_PROJ), NPROJ, nullptr, 0, 0, 1.f};
            for (int rep = 0; rep < REP_GEMM; ++rep) { pg8::gemm_phase<pg8::EpiBf16<0>, pg8::StaticOrder, true, true>(ldsL, g, S, E, wave0); if (rep + 1 < REP_GEMM) __syncthreads(); }
            if (TAILCONV) { __syncthreads(); PH_IDS; tail_convert(a, lds, TC_P0 + l * I_LAYER, TC_P0 + l * I_LAYER + TC_R1, S.nwg, G, bx, wave, lane);
                if (MODSHIFT && l + 1 < DEPTH) { const int used = S.nwg % G; if (bx >= used) modp_items(a, l + 1, (float*)(a->ws + WS_MODP2), (bx - used) * NWAVES + wave, (G - used) * NWAVES, lane); } }
        } SEAM(pb + 0);
        if (EN_PP && IN(pb + 1)) { PH_IDS; for (int rep = 0; rep < REP_RW; ++rep) phase_postproj(a, l, gw, NGW, lane, lds, tid); } SEAM(pb + 1);
        if (EN_LG && IN(pb + 2)) {
            if (!LRU_LOOKBACK) { PH_IDS; for (int rep = 0; rep < REP_LRU; ++rep) phase_lru<false>(a, l, lds, bx, G, tid); }
            __syncthreads();
            unsigned char* ws = launder(ka)->ws;
            pg8::Gemm g{(const bf16*)(ws + WS_CKV), (const bf16*)(ws + WS_WKV) + (size_t)l * 1024 * 512, MKEY, 1024, 512}; pg8::StaticOrder S; S.init(MKEY, 1024, G, bx);
            pg8::EpiBf16<0> E{(bf16*)(ws + WS_KVM), 1024, nullptr, 0, 0, 1.f};
            for (int rep = 0; rep < REP_GEMM; ++rep) { pg8::gemm_phase<pg8::EpiBf16<0>, pg8::StaticOrder, true, true>(ldsL, g, S, E, wave0); if (rep + 1 < REP_GEMM) __syncthreads(); }
#if KVM_COUNTER
            asm volatile("s_waitcnt vmcnt(0)" ::: "memory"); __syncthreads();
            if (wave0 == 0 && vlane() == 0u) { __builtin_amdgcn_fence(__ATOMIC_RELEASE, "agent"); asm volatile("s_waitcnt vmcnt(0)" ::: "memory");
                (void)__hip_atomic_fetch_add((unsigned*)(ws + WS_CTL) + CW_KVMC + l * 16, 1u, __ATOMIC_RELAXED, __HIP_MEMORY_SCOPE_AGENT); }
#endif
            if (TAILCONV) { __syncthreads(); PH_IDS; tail_convert(a, lds, TC_P0 + l * I_LAYER + TC_R1, TC_P0 + l * I_LAYER + TC_R2, S.nwg, G, bx, wave, lane); }
        }
        if (KVM_COUNTER && !MK_MULTI && IN(pb + 2) && IN(pb + 3)) __syncthreads(); else SEAM(pb + 2);
        if (IN(pb + 3)) { if (EN_LS) { PH_IDS; for (int rep = 0; rep < REP_LRU; ++rep) phase_lru<true, LRU_LOOKBACK != 0>(a, l, lds, bx, G, tid); } __syncthreads();
            if (EN_AT) { PH_IDS; for (int rep = 0; rep < REP_AT; ++rep) phase_attention_gqa(a, lds, bx, G, wave0); }
#if KVM_COUNTER
            if (!MK_MULTI && IN(pb + 2)) { __syncthreads();
                if (wave0 == 0 && vlane() == 0u) { unsigned* cp = (unsigned*)(launder(ka)->ws + WS_CTL) + CW_KVMC + l * 16; unsigned sp = 0u;
                    while (__hip_atomic_load(cp, __ATOMIC_RELAXED, __HIP_MEMORY_SCOPE_AGENT) < (unsigned)G) { __builtin_amdgcn_s_sleep(2);
                        if (++sp > (1u << 22)) { __hip_atomic_store((unsigned*)(launder(ka)->ws + WS_CTL) + CW_TMO, 0x2b00u, __ATOMIC_RELAXED, __HIP_MEMORY_SCOPE_AGENT); break; } }
                    __builtin_amdgcn_fence(__ATOMIC_ACQUIRE, "agent"); asm volatile("s_waitcnt vmcnt(0)" ::: "memory"); }
                __syncthreads(); }
#endif
            if (EN_AT2) { PH_IDS; for (int rep = 0; rep < REP_AT; ++rep) phase_attention_mla(a, lds, bx, G, wave0); } } SEAM(pb + 3);
        if (EN_G2 && IN(pb + 4)) {
            unsigned char* ws = launder(ka)->ws;
            pg8::Gemm g{(const bf16*)(ws + WS_MIX), (const bf16*)(ws + WS_WOUT) + (size_t)l * DM * DM, MTOK, DM, DM}; pg8::StaticOrder S; S.init(MTOK, DM, G, bx);
            pg8::EpiBf16<0> E{(bf16*)(ws + WS_MO), DM, nullptr, 0, 0, 1.f};
            for (int rep = 0; rep < REP_GEMM; ++rep) { pg8::gemm_phase<pg8::EpiBf16<0>, pg8::StaticOrder, true, true>(ldsL, g, S, E, wave0); if (rep + 1 < REP_GEMM) __syncthreads(); }
        } SEAM(pb + 4);
        if (EN_R1 && IN(pb + 5)) { PH_IDS; phase_residual(a, l, 0, lds, bx, G, tid); } SEAM(pb + 5);
        if (EN_G3 && IN(pb + 6)) {
            const KArgs a = launder(ka); unsigned char* ws = a->ws;
            pg8::Gemm g{(const bf16*)(ws + WS_H), (const bf16*)(ws + WS_WUP) + (size_t)l * NUP * DM, MTOK, NUP, DM}; pg8::StaticOrder S; S.init(MTOK, NUP, G, bx);
#if FFN_UNFUSED
            pg8::EpiBf16<0> E{(bf16*)(ws + WS_U), NUP, nullptr, 0, 0, 1.f};
            pg8::gemm_phase<pg8::EpiBf16<0>, pg8::StaticOrder, true, true>(ldsL, g, S, E, wave0);
#else
            pg8::EpiFfnAct E{(bf16*)(ws + WS_ACT), DFF, a->in[I_FCW] + (size_t)l * 3 * NUP, a->in[I_FCB] + (size_t)l * NUP, NUP, DFF, (bf16*)(ws + WS_HALO), (LAS float*)(ldsL + 131072)};
            for (int rep = 0; rep < REP_GEMM; ++rep) { pg8::gemm_phase<pg8::EpiFfnAct, pg8::StaticOrder, true, true>(ldsL, g, S, E, wave0); if (rep + 1 < REP_GEMM) __syncthreads(); }
            if (TAILCONV) { __syncthreads(); const int tid = ltid(wave0); const int used = S.nwg % G;
                if (MODSHIFT && l + 1 < DEPTH && bx >= used) mod_reduce_layer(a, l + 1, (const float*)(ws + WS_MODP2), (bx - used) * NTHREADS + tid, (G - used) * NTHREADS);
                tail_convert(a, lds, TC_P0 + l * I_LAYER + TC_R2, TC_P0 + (l + 1) * I_LAYER, S.nwg, G, bx, __builtin_amdgcn_readfirstlane(tid >> 6), tid & 63); }
#endif
#if FFN_DBG
            if (l == 0) { __syncthreads(); pg8::EpiBf16<0> E2{(bf16*)(ws + WS_U), NUP, nullptr, 0, 0, 1.f};
                pg8::gemm_phase<pg8::EpiBf16<0>, pg8::StaticOrder, true, true>(ldsL, g, S, E2, wave0); }
#endif
        } SEAM(pb + 6);
        if (EN_FA && IN(pb + 7)) { PH_IDS; for (int rep = 0; rep < REP_RW; ++rep) { if (FFN_UNFUSED) phase_ffn_act_dbg(a, l, gtid, NTHR); else { if (FFN_DBG && l == 0) phase_ffn_cmp_dbg(a, l, gtid, NTHR); phase_ffn_fix(a, l, gtid, NTHR); } } } SEAM(pb + 7);
        if (EN_G4 && IN(pb + 8)) {
            unsigned char* ws = launder(ka)->ws;
            pg8::Gemm g{(const bf16*)(ws + WS_ACT), (const bf16*)(ws + WS_WDN) + (size_t)l * DM * DFF, MTOK, DM, DFF}; pg8::StaticOrder S; S.init(MTOK, DM, G, bx);
            pg8::EpiBf16<0> E{(bf16*)(ws + WS_MO), DM, nullptr, 0, 0, 1.f};
            for (int rep = 0; rep < REP_GEMM; ++rep) { pg8::gemm_phase<pg8::EpiBf16<0>, pg8::StaticOrder, true, true>(ldsL, g, S, E, wave0); if (rep + 1 < REP_GEMM) __syncthreads(); }
        } SEAM(pb + 8);
        if (EN_R2 && IN(pb + 9)) { PH_IDS; phase_residual(a, l, 1, lds, bx, G, tid); } SEAM(pb + 9);
    }
#if NPASS > 1
    if (pass + 1 < NPASS) { GRID_BAR(); { unsigned* FLG = (unsigned*)(ka->ws + WS_CTL) + CW_LRUF; for (int i = bx * NTHREADS + ltid(wave0); i < 32768; i += G * NTHREADS) FLG[i] = 0u; } GRID_BAR(); }
    }
#endif
#if SKEW_PROBE
    if (bx == 0 && ltid(wave0) == 0) { const unsigned long long* ts = (const unsigned long long*)(ka->ws + WS_DBG); float tot = 0.f;
        for (int k = SK_LO; k < SK_HI; ++k) { { const int ty = k < PH_PRE ? 10 : (k - PH_PRE) % PH_PER_LAYER; if (!((SK_MASK >> ty) & 1)) continue; }
            unsigned long long mx = 0, sum = 0; for (int b = 0; b < G; ++b) { const unsigned long long v = ts[k * 256 + b]; mx = v > mx ? v : mx; sum += v; }
            if (SK_USED > 0) { long long s0 = 0, s1 = 0; for (int b = 0; b < G; ++b) { const long long v = (long long)(ts[k * 256 + b] - ts[k * 256]); if (b < SK_USED) s0 += v; else s1 += v; }
                tot += (float)s1 / (float)(G - SK_USED) - (float)s0 / (float)SK_USED; }
            else tot += (float)(mx * (unsigned long long)G - sum) / (float)G; }
        if (SK_USED > 0) tot = rintf(tot * 0.25f * 1e-3f) * 1e3f;
        ka->out[0] += STAMP_SCALE * (tot * 1e-4f - STAMP_OFF); }
#endif
#if STAMP_A >= 0
    if (bx == 0 && ltid(wave0) == 0) ka->out[0] += STAMP_SCALE * ((float)(tsB - tsA) * 1e-4f - STAMP_OFF);
#endif
#if LRU_STAMPS
    if (bx == 0 && ltid(wave0) == 0) { const unsigned long long* lts = (const unsigned long long*)(ka->ws + WS_DBG); ka->out[0] += (float)(lts[LS_B] - lts[LS_A]) * 1e-2f; }
#endif
#if FFN_DBG
    if (bx == 0 && ltid(wave0) == 0) { const unsigned* chk = (const unsigned*)(ka->ws + WS_CTL) + CW_CHK; unsigned tot = 0; for (int i = 0; i < 16; ++i) tot += __hip_atomic_load(chk + i, __ATOMIC_RELAXED, __HIP_MEMORY_SCOPE_AGENT);
        ka->out[0] = DBG_REPORT; }
#endif
#undef IN
#undef SEAM
}

extern "C" void kernel_launch(void* const* d_in, const int* in_sizes, int n_in, void* d_out, int out_size, void* d_ws, size_t ws_size, hipStream_t stream) {
    static int grid = 0;
    if (grid == 0) {
        if (n_in != N_IN || (size_t)out_size != O_END || ws_size < WS_END) { fprintf(stderr, "kernel_launch: unexpected shapes: n_in %d out %d ws %zu (need %zu)\n", n_in, out_size, ws_size, (size_t)WS_END); grid = -1; return; }
        int dev = 0, cus = 0, per_cu = 0;
        if (hipGetDevice(&dev) != hipSuccess || hipDeviceGetAttribute(&cus, hipDeviceAttributeMultiprocessorCount, dev) != hipSuccess) { grid = -1; return; }
        if (hipFuncSetAttribute((const void*)fwd_kernel, hipFuncAttributeMaxDynamicSharedMemorySize, LDS_BYTES) != hipSuccess) { fprintf(stderr, "kernel_launch: hipFuncSetAttribute failed\n"); grid = -1; return; }
        if (hipOccupancyMaxActiveBlocksPerMultiprocessor(&per_cu, (const void*)fwd_kernel, NTHREADS, LDS_BYTES) != hipSuccess || per_cu < 1) { fprintf(stderr, "kernel_launch: occupancy query says %d blocks per CU\n", per_cu); (void)hipGetLastError(); grid = -1; return; }
        grid = cus;
    }
    if (grid < 0) return;
    (void)hipMemsetAsync((char*)d_ws + WS_CTL, 0, CTL_ZERO_BYTES, stream);
    Args a{};
    for (int i = 0; i < N_IN; ++i) a.in[i] = (const float*)d_in[i];
    a.out = (float*)d_out; a.ws = (unsigned char*)d_ws;
#if MK_MULTI
    for (int p = 0; p < PH_TOTAL; ++p) { a.ph_lo = p; a.ph_hi = p + 1; hipLaunchKernelGGL(fwd_kernel, dim3(grid), dim3(NTHREADS), LDS_BYTES, stream, a); }
#else
    a.ph_lo = 0; a.ph_hi = PH_TOTAL; hipLaunchKernelGGL(fwd_kernel, dim3(grid), dim3(NTHREADS), LDS_BYTES, stream, a);
#endif
    const hipError_t le = hipPeekAtLastError();
    if (le != hipSuccess) fprintf(stderr, "kernel_launch: launch failed: %s\n", hipGetErrorName(le));
}
```

```cpp
#include <hip/hip_runtime.h>
#include <cstdio>
#include <cstdint>
#ifndef MK_MULTI
#define MK_MULTI 0
#endif
__device__ __forceinline__ unsigned vlane() { unsigned lane; asm volatile("v_mbcnt_lo_u32_b32 %0, -1, 0\n\tv_mbcnt_hi_u32_b32 %0, -1, %0" : "=v"(lane)); return lane; }
__device__ __forceinline__ int ltid(int wave) { int lane; asm volatile("v_mbcnt_lo_u32_b32 %0, -1, 0\n\tv_mbcnt_hi_u32_b32 %0, -1, %0" : "=v"(lane));
    const int t = wave * 64 + lane; __builtin_assume(t >= 0 && t < 512); return t; }

#ifndef PG8_WT_STORE
#define PG8_WT_STORE 0
#endif
#ifndef PG8_NT_STORE
#define PG8_NT_STORE 0
#endif
namespace pg8 {
#define PG8_LAS __attribute__((address_space(3)))
typedef unsigned short bf16_t;
typedef short bf16x8 __attribute__((ext_vector_type(8)));
typedef float f32x4 __attribute__((ext_vector_type(4)));
typedef unsigned u32x4 __attribute__((ext_vector_type(4)));
constexpr int BM = 256, BK = 64, HALF = 128, HTB = HALF * BK * 2  , STAGE_BYTES = 8 * HTB, NXCD = 8, WGM = 8;

__host__ __device__ __forceinline__ int lds_byte(int r, int c) { const int st = (r >> 4) * 2 + (c >> 5), rr = r & 15, cc = c & 31, ob = rr * 64 + cc * 2; return st * 1024 + (ob ^ (((ob >> 9) & 1) << 5)); }
__host__ __device__ __forceinline__ void stage_rc(int b, int& R, int& C) { const int st = b / 1024, sb = b % 1024, swz = sb ^ (((sb >> 9) & 1) << 5); R = (st >> 1) * 16 + swz / 64; C = (st & 1) * 32 + (swz % 64) / 2; }
__host__ __device__ __forceinline__ int perm32(int rho) { const int n = rho >> 4, i = rho & 15; return 8 * (i >> 2) + 4 * n + (i & 3); }

struct Unit { int pm, pn; };
struct Gemm { const bf16_t* A; const bf16_t* Bt; int M, N, K; };

struct StaticOrder {
    int nM, nN, nwg, G, c;
    __host__ __device__ void init(int M, int N, int G_, int c_) { nM = M / BM; nN = N / BM; nwg = nM * nN; G = G_; c = c_; }
    __host__ __device__ bool next(int i, Unit& u) const {
        const long L = (long)i * G + c; if (L >= nwg) return false;
        int wgid = (int)L; { const int q = nwg / NXCD, r = nwg % NXCD, xcd = wgid % NXCD, off = wgid / NXCD; wgid = (xcd < r ? xcd * (q + 1) : r * (q + 1) + (xcd - r) * q) + off; }
        const int nig = WGM * nN, gid = wgid / nig, fm = gid * WGM, gsz = (nM - fm) < WGM ? (nM - fm) : WGM;
        u.pm = fm + ((wgid % nig) % gsz); u.pn = (wgid % nig) / gsz; return true;
    }
    __device__ __forceinline__ void a_ready(const Unit&) const {}
    __device__ __forceinline__ void done(const Unit&) const {}
};

__device__ __forceinline__ unsigned cvt_pk_bf16(float lo, float hi) { unsigned r; asm volatile("v_cvt_pk_bf16_f32 %0, %1, %2" : "=v"(r) : "v"(lo), "v"(hi)); return r; }
typedef float f32x2 __attribute__((ext_vector_type(2)));
__device__ __forceinline__ f32x2 gelu_pk(f32x2 v) {
    const f32x2 av = __builtin_elementwise_abs(v), d = av * 0.2316418882f + 1.0f;
    f32x2 t; t.x = __builtin_amdgcn_rcpf(d.x); t.y = __builtin_amdgcn_rcpf(d.y);
    f32x2 q = t * 0.5307027145f + (-0.7265760135f); q = q * t + 0.7107068705f; q = q * t + (-0.142248368f); q = q * t + 0.127414796f; q = q * t;
    const f32x2 s = (v * v) * (-0.72134752044f);
    f32x2 e; e.x = __builtin_amdgcn_exp2f(s.x); e.y = __builtin_amdgcn_exp2f(s.y);
    const f32x2 m = v * (q * e), r = v - m;
    f32x2 o; o.x = v.x < 0.f ? m.x : r.x; o.y = v.y < 0.f ? m.y : r.y; return o;
}

template <int ACT  > struct EpiBf16 {
    static constexpr bool PERM = true, AFTER_DRAIN = false, PREFETCH = false, PERMA = false; static_assert(ACT == 0 || ACT == 1, "EpiBf16: ACT is 0 (none) or 1 (gelu_pk)");
    bf16_t* O; int ldc; const float* bias; int split_cols; size_t split_stride; float scale0;
    __device__ __forceinline__ void operator()(const f32x4 (&acc)[2][2][4][2], const Unit& u, int wr, int wc, int fr, int fq) const {
        const int row0 = u.pm * BM + wr * 64 + fr; int colt = u.pn * BM; bf16_t* base = O;
        float sc = 1.f; if (split_cols) { const int t = colt / split_cols; base += (size_t)t * split_stride; colt -= t * split_cols; if (t == 0) sc = scale0; }
        const int col0 = colt + wc * 32 + 8 * fq, bcol0 = u.pn * BM + wc * 32 + 8 * fq;
        f32x4 bv[2][2];
#pragma unroll
        for (int bj = 0; bj < 2; ++bj)
#pragma unroll
            for (int n = 0; n < 2; ++n) bv[bj][n] = bias ? *(const f32x4*)(bias + bcol0 + bj * HALF + 4 * n) : (f32x4){0.f, 0.f, 0.f, 0.f};
#pragma unroll
        for (int ai = 0; ai < 2; ++ai)
#pragma unroll
            for (int m = 0; m < 4; ++m) { bf16_t* rowp = base + (size_t)(row0 + ai * HALF + m * 16) * ldc + col0;
#pragma unroll
                for (int bj = 0; bj < 2; ++bj) { f32x4 v0 = acc[ai][bj][m][0], v1 = acc[ai][bj][m][1]; if (bias) { v0 += bv[bj][0]; v1 += bv[bj][1]; }
                    if (ACT == 1) { f32x2 a = gelu_pk((f32x2){v0[0], v0[1]}), b = gelu_pk((f32x2){v0[2], v0[3]}), c = gelu_pk((f32x2){v1[0], v1[1]}), d = gelu_pk((f32x2){v1[2], v1[3]});
                        v0 = (f32x4){a.x, a.y, b.x, b.y}; v1 = (f32x4){c.x, c.y, d.x, d.y}; }
                    v0 = v0 * sc; v1 = v1 * sc; u32x4 w; w.x = cvt_pk_bf16(v0[0], v0[1]); w.y = cvt_pk_bf16(v0[2], v0[3]); w.z = cvt_pk_bf16(v1[0], v1[1]); w.w = cvt_pk_bf16(v1[2], v1[3]);
                    if (PG8_WT_STORE) { u32x4* sp = (u32x4*)(rowp + bj * HALF); asm volatile("global_store_dwordx4 %0, %1, off sc1\n\ts_nop 1" :: "v"(sp), "v"(w) : "memory"); }
                    else if (PG8_NT_STORE) __builtin_nontemporal_store(w, (u32x4*)(rowp + bj * HALF)); else *(u32x4*)(rowp + bj * HALF) = w; } }
    }
};
#ifndef FFN_PERMA
#define FFN_PERMA 1
#endif
#ifndef FFN_PK
#define FFN_PK 1
#endif
#ifndef FFN_CW_PREFETCH
#define FFN_CW_PREFETCH 1
#endif
#ifndef CONV_CENTER_ONLY
#define CONV_CENTER_ONLY 0
#endif
struct EpiF32 {
    static constexpr bool PERM = false, AFTER_DRAIN = false, PREFETCH = false, PERMA = false;
    float* C; int ldc; const float* bias;
    __device__ __forceinline__ void operator()(const f32x4 (&acc)[2][2][4][2], const Unit& u, int wr, int wc, int fr, int fq) const {
        const int row0 = u.pm * BM + wr * 64 + fr, col0 = u.pn * BM + wc * 32 + 4 * fq;
        f32x4 bv[2][2];
#pragma unroll
        for (int bj = 0; bj < 2; ++bj)
#pragma unroll
            for (int n = 0; n < 2; ++n) bv[bj][n] = bias ? *(const f32x4*)(bias + col0 + bj * HALF + n * 16) : (f32x4){0.f, 0.f, 0.f, 0.f};
#pragma unroll
        for (int ai = 0; ai < 2; ++ai)
#pragma unroll
            for (int m = 0; m < 4; ++m) { float* rowp = C + (size_t)(row0 + ai * HALF + m * 16) * ldc + col0;
#pragma unroll
                for (int bj = 0; bj < 2; ++bj)
#pragma unroll
                    for (int n = 0; n < 2; ++n) *(f32x4*)(rowp + bj * HALF + n * 16) = acc[ai][bj][m][n] + bv[bj][n]; }
    }
};

struct EpiFfnAct {
    static constexpr bool PERM = true, AFTER_DRAIN = false, PREFETCH = (FFN_CW_PREFETCH != 0), PERMA = (FFN_PERMA != 0);
    bf16_t* ACT; int ldact; const float* cw; const float* cb; int nup, dff; bf16_t* HALO; PG8_LAS float* xr;
    __device__ __forceinline__ void prefetch(const Unit& u, int wr, int wc, int fr, int fq, f32x4& pf) const {
        if (wr == 0) { const int tid = wc * 64 + fq * 16 + fr, sbj = tid >> 7, st = (tid >> 5) & 3, c4 = tid & 31;
            const float* src = (st < 3 ? cw + (size_t)st * nup : cb) + sbj * dff + u.pn * 128 + 4 * c4; pf = *(const f32x4*)src; } }
    __device__ __forceinline__ void operator()(const f32x4 (&acc)[2][2][4][2], const Unit& u, int wr, int wc, int fr_, int fq_, const f32x4& pf) const {
        int fr = fr_, fq = fq_; asm volatile("" : "+v"(fr), "+v"(fq));
        const int lane = fq * 16 + fr, colw = wc * 32 + 8 * fq, ch0 = u.pn * 128 + colw;
        PG8_LAS float* cwl_lds = xr + 2048;
        { const int tid = (wr * 4 + wc) * 64 + lane;
          if (tid < 256) { const int sbj = tid >> 7, st = (tid >> 5) & 3, c4 = tid & 31;
              const float* src = (st < 3 ? cw + (size_t)st * nup : cb) + sbj * dff + u.pn * 128 + 4 * c4;
              *(PG8_LAS f32x4*)(cwl_lds + (sbj * 4 + st) * 128 + 4 * c4) = PREFETCH ? pf : *(const f32x4*)src; } }
#pragma unroll
        for (int ai = 0; ai < 2; ++ai)
#pragma unroll
            for (int bj = 0; bj < 2; ++bj)
#pragma unroll
                for (int n = 0; n < 2; ++n) { const int idx = (ai * 2 + wr) * 256 + bj * 128 + colw + 4 * n;
                    if (fr == 0) *(PG8_LAS f32x4*)(xr + idx) = acc[ai][bj][0][n];
                    if (fr == 15) *(PG8_LAS f32x4*)(xr + 1024 + idx) = acc[ai][bj][3][n]; }
        asm volatile("s_waitcnt lgkmcnt(0)" ::: "memory"); __builtin_amdgcn_s_barrier(); asm volatile("" ::: "memory");
        const int srcP = ((lane & 48) | ((fr + 15) & 15)) * 4, srcN = ((lane & 48) | ((fr + 1) & 15)) * 4;
        const f32x4 z4 = (f32x4){0.f, 0.f, 0.f, 0.f};
        typedef unsigned u32x2_t __attribute__((ext_vector_type(2)));
#pragma unroll
        for (int ai = 0; ai < 2; ++ai) { const int blk = ai * 2 + wr;
            u32x2_t keep[4];
#pragma unroll
            for (int n = 0; n < 2; ++n) {
                f32x4 og[4];
#pragma unroll
                for (int bj = 0; bj < 2; ++bj) { const int xi = bj * 128 + colw + 4 * n; const PG8_LAS float* wl = cwl_lds + bj * 512 + colw + 4 * n;
                    const f32x4 w0 = *(const PG8_LAS f32x4*)(wl), w1 = *(const PG8_LAS f32x4*)(wl + 128), w2 = *(const PG8_LAS f32x4*)(wl + 256), bb = *(const PG8_LAS f32x4*)(wl + 384);
                    const f32x4 XP = blk > 0 ? *(const PG8_LAS f32x4*)(xr + 1024 + (blk - 1) * 256 + xi) : z4, XN = blk < 3 ? *(const PG8_LAS f32x4*)(xr + (blk + 1) * 256 + xi) : z4;
#if FFN_PERMA && FFN_PK
                    typedef float f32x2_t __attribute__((ext_vector_type(2)));
#pragma unroll
                    for (int cp = 0; cp < 4; cp += 2) {
                        f32x2_t x2[4];
#pragma unroll
                        for (int m = 0; m < 4; ++m) { const float ta = acc[ai][bj][m][n][cp], tb = acc[ai][bj][m][n][cp + 1]; x2[m] = (f32x2_t){ta, tb}; }
                        const float p3a = x2[3].x, p3b = x2[3].y, n0a = x2[0].x, n0b = x2[0].y;
                        const float xpa = XP[cp], xpb = XP[cp + 1], xna = XN[cp], xnb = XN[cp + 1];
                        const float P3a = __int_as_float(__builtin_amdgcn_update_dpp(__float_as_int(xpa), __float_as_int(p3a), 0x111, 0xf, 0xf, false)), P3b = __int_as_float(__builtin_amdgcn_update_dpp(__float_as_int(xpb), __float_as_int(p3b), 0x111, 0xf, 0xf, false));
                        const float N0a = __int_as_float(__builtin_amdgcn_update_dpp(__float_as_int(xna), __float_as_int(n0a), 0x101, 0xf, 0xf, false)), N0b = __int_as_float(__builtin_amdgcn_update_dpp(__float_as_int(xnb), __float_as_int(n0b), 0x101, 0xf, 0xf, false));
                        const f32x2_t pe = (f32x2_t){P3a, P3b}, ne = (f32x2_t){N0a, N0b};
                        const f32x2_t w0p = (f32x2_t){w0[cp], w0[cp + 1]}, w1p = (f32x2_t){w1[cp], w1[cp + 1]}, w2p = (f32x2_t){w2[cp], w2[cp + 1]}, bbp = (f32x2_t){bb[cp], bb[cp + 1]};
#pragma unroll
                        for (int m = 0; m < 4; ++m) { const f32x2_t prev = m > 0 ? x2[m > 0 ? m - 1 : 0] : pe, next = m < 3 ? x2[m < 3 ? m + 1 : 3] : ne;
                            const f32x2_t o = bbp + w0p * prev + w1p * x2[m] + w2p * next;
                            if (bj == 0) { const f32x2_t t = o * -1.4426950408889634f; const f32x2_t d = (f32x2_t){__builtin_amdgcn_exp2f(t.x), __builtin_amdgcn_exp2f(t.y)} + 1.0f;
                                const f32x2_t g = o * (f32x2_t){__builtin_amdgcn_rcpf(d.x), __builtin_amdgcn_rcpf(d.y)}; og[m][cp] = g.x; og[m][cp + 1] = g.y; }
                            else { const f32x2_t g = (f32x2_t){og[m][cp], og[m][cp + 1]} * o; og[m][cp] = g.x; og[m][cp + 1] = g.y; } } }
#else
#pragma unroll
                    for (int c = 0; c < 4; ++c) { float R[4], L[4];
#if FFN_PERMA
                        const float t3 = acc[ai][bj][3][n][c], t0 = acc[ai][bj][0][n][c];
                        const float P3 = __int_as_float(__builtin_amdgcn_update_dpp(0, __float_as_int(t3), 0x121, 0xf, 0xf, false));
                        const float N0 = __int_as_float(__builtin_amdgcn_update_dpp(0, __float_as_int(t0), 0x12F, 0xf, 0xf, false));
                        (void)R; (void)L;
#pragma unroll
                        for (int m = 0; m < 4; ++m) { const float prev = m > 0 ? acc[ai][bj][m > 0 ? m - 1 : 0][n][c] : (fr > 0 ? P3 : XP[c]), next = m < 3 ? acc[ai][bj][m < 3 ? m + 1 : 3][n][c] : (fr < 15 ? N0 : XN[c]);
#else
#pragma unroll
                        for (int m = 0; m < 4; ++m) { const float tv = acc[ai][bj][m][n][c]; const int ti = __float_as_int(tv);
                            R[m] = __int_as_float(__builtin_amdgcn_update_dpp(0, ti, 0x121, 0xf, 0xf, false));
                            L[m] = __int_as_float(__builtin_amdgcn_update_dpp(0, ti, 0x12F, 0xf, 0xf, false)); }
#pragma unroll
                        for (int m = 0; m < 4; ++m) { const float prev = fr > 0 ? R[m] : (m > 0 ? R[m > 0 ? m - 1 : 0] : XP[c]), next = fr < 15 ? L[m] : (m < 3 ? L[m < 3 ? m + 1 : 3] : XN[c]);
#endif
                            const float o = bb[c] + (CONV_CENTER_ONLY ? 0.f : w0[c] * prev) + w1[c] * acc[ai][bj][m][n][c] + (CONV_CENTER_ONLY ? 0.f : w2[c] * next);
                            if (bj == 0) og[m][c] = o * __builtin_amdgcn_rcpf(1.0f + __builtin_amdgcn_exp2f(o * -1.4426950408889634f)); else og[m][c] *= o; } }
#endif
                    __builtin_amdgcn_sched_barrier(0); }
#pragma unroll
                for (int m = 0; m < 4; ++m) { const size_t row = (size_t)u.pm * BM + ai * HALF + wr * 64 + (FFN_PERMA ? 4 * fr + m : m * 16 + fr);
                    u32x2_t w; w.x = cvt_pk_bf16(og[m][0], og[m][1]); w.y = cvt_pk_bf16(og[m][2], og[m][3]);
                    if (n == 0) keep[m] = w; else { u32x4 w4; w4.x = keep[m].x; w4.y = keep[m].y; w4.z = w.x; w4.w = w.y; if (PG8_NT_STORE) __builtin_nontemporal_store(w4, (u32x4*)(ACT + row * ldact + ch0)); else *(u32x4*)(ACT + row * ldact + ch0) = w4; } }
                __builtin_amdgcn_sched_barrier(0); } }
        if (u.pm >= 32) {
#if FFN_PERMA
            const bool top = (wr == 0) && fr == 0, bot = (wr == 1) && fr == 15;
            if (top || bot) {
#pragma unroll
                for (int q = 0; q < 2; ++q) { const int hrow = top ? q : 2 + q;
#pragma unroll
                    for (int bj = 0; bj < 2; ++bj) { const f32x4 v0 = top ? acc[0][bj][q][0] : acc[1][bj][2 + q][0], v1 = top ? acc[0][bj][q][1] : acc[1][bj][2 + q][1];
                        u32x4 w; w.x = cvt_pk_bf16(v0[0], v0[1]); w.y = cvt_pk_bf16(v0[2], v0[3]); w.z = cvt_pk_bf16(v1[0], v1[1]); w.w = cvt_pk_bf16(v1[2], v1[3]);
                        *(u32x4*)(HALO + ((size_t)((u.pm - 32) * 4 + hrow) * (nup / 256) + u.pn) * 256 + bj * 128 + colw) = w; } } } }
#else
            const bool top = (wr == 0) && fr < 2, bot = (wr == 1) && fr >= 14;
            if (top || bot) { const int ai = top ? 0 : 1, m = top ? 0 : 3, hrow = top ? fr : 2 + (fr - 14);
#pragma unroll
                for (int bj = 0; bj < 2; ++bj) { const f32x4 v0 = top ? acc[0][bj][0][0] : acc[1][bj][3][0], v1 = top ? acc[0][bj][0][1] : acc[1][bj][3][1];
                    u32x4 w; w.x = cvt_pk_bf16(v0[0], v0[1]); w.y = cvt_pk_bf16(v0[2], v0[3]); w.z = cvt_pk_bf16(v1[0], v1[1]); w.w = cvt_pk_bf16(v1[2], v1[3]);
                    *(u32x4*)(HALO + ((size_t)((u.pm - 32) * 4 + hrow) * (nup / 256) + u.pn) * 256 + bj * 128 + colw) = w; }
                (void)ai; (void)m; } }
#endif
    }
};
template <class Epi, class Sched, bool ALIGN_EPI = false, bool SP2 = false>
__device__ __forceinline__ void gemm_phase(PG8_LAS unsigned char* lds, const Gemm g, const Sched& S, const Epi& E, const int wave_id) {
    const int tid = ltid(wave_id), wid = __builtin_amdgcn_readfirstlane(tid >> 6), lane = tid & 63, wr = wid >> 2, wc = wid & 3, fr = lane & 15, fq = lane >> 4;
    const int K = g.K, nt = K / BK;
    unsigned voffA[2], voffB[2];
#pragma unroll
    for (int i = 0; i < 2; ++i) { int R, C; stage_rc(tid * 16 + i * 8192, R, C); const int Rb = Epi::PERM ? ((R & ~31) + perm32(R & 31)) : R;
        const int Ra = Epi::PERMA ? ((R & ~63) + 4 * (R & 15) + ((R >> 4) & 3)) : R;
        voffA[i] = (unsigned)(Ra * K + C) * 2u; voffB[i] = (unsigned)(Rb * K + C) * 2u; }
    const size_t kstep = (size_t)(BK * 2);
    const size_t hstep = (size_t)HALF * K * 2;
    const size_t tstep = 2 * hstep;
    const unsigned ldsw = (unsigned)wid * 1024u;
    const int aoff = lds_byte(wr * 64 + fr, fq * 8), boff = lds_byte(wc * 32 + fr, fq * 8);
#define PG8_SA(b, h) (((b) * 2 + (h)) * HTB)
#define PG8_SB(b, h) ((4 + (b) * 2 + (h)) * HTB)
#define PG8_STAGE(bufoff, gbase, voff) do { _Pragma("unroll") for (int _i = 0; _i < 2; ++_i) \
        __builtin_amdgcn_global_load_lds((const unsigned*)((const char*)(gbase) + (voff)[_i]), (PG8_LAS unsigned*)(lds + (bufoff) + ldsw + _i * 8192), 16, 0, 0); } while (0)
#define PG8_LDA(dst, b, h) do { _Pragma("unroll") for (int m = 0; m < 4; ++m) _Pragma("unroll") for (int k = 0; k < 2; ++k) dst[m][k] = *(const PG8_LAS bf16x8*)(lds + PG8_SA(b, h) + aoff + m * 2048 + k * 1024); } while (0)
#define PG8_LDB(dst, b, h) do { _Pragma("unroll") for (int n = 0; n < 2; ++n) _Pragma("unroll") for (int k = 0; k < 2; ++k) dst[n][k] = *(const PG8_LAS bf16x8*)(lds + PG8_SB(b, h) + boff + n * 2048 + k * 1024); } while (0)
#define PG8_MMA(ai, bj, At, Bt) do { __builtin_amdgcn_s_setprio(1); _Pragma("unroll") for (int m = 0; m < 4; ++m) _Pragma("unroll") for (int n = 0; n < 2; ++n) _Pragma("unroll") for (int k = 0; k < 2; ++k) \
        acc[ai][bj][m][n] = __builtin_amdgcn_mfma_f32_16x16x32_bf16(Bt[n][k], At[m][k], acc[ai][bj][m][n], 0, 0, 0); __builtin_amdgcn_s_setprio(0); } while (0)
#define PG8_WAIT_V(n) asm volatile("s_waitcnt vmcnt(" #n ")" ::: "memory")
#define PG8_WAIT_L(n) asm volatile("s_waitcnt lgkmcnt(" #n ")" ::: "memory")
#define PG8_BAR __builtin_amdgcn_s_barrier()
#define PG8_SCHED __builtin_amdgcn_sched_barrier(0)
    Unit cur, nxt; int ui = 0;
    if (!S.next(0, cur)) return;
    f32x4 acc[2][2][4][2];
#pragma unroll
    for (int a = 0; a < 2; ++a)
#pragma unroll
        for (int b = 0; b < 2; ++b)
#pragma unroll
            for (int m = 0; m < 4; ++m)
#pragma unroll
                for (int n = 0; n < 2; ++n) acc[a][b][m][n] = (f32x4){0.f, 0.f, 0.f, 0.f};
    bf16x8 At[4][2], B0[2][2], B1[2][2];
    const char* cA = (const char*)g.A + (size_t)cur.pm * tstep; const char* cB = (const char*)g.Bt + (size_t)cur.pn * tstep;
    S.a_ready(cur);
    if constexpr (SP2) {
        PG8_STAGE(PG8_SB(0, 0), cB, voffB); PG8_STAGE(PG8_SB(0, 1), cB + hstep, voffB); PG8_STAGE(PG8_SA(0, 0), cA, voffA); PG8_STAGE(PG8_SA(0, 1), cA + hstep, voffA);
        if (wr == 1) PG8_BAR;
        PG8_WAIT_V(2); PG8_BAR;
        PG8_STAGE(PG8_SB(1, 0), cB + kstep, voffB); PG8_STAGE(PG8_SA(1, 0), cA + kstep, voffA); PG8_STAGE(PG8_SB(1, 1), cB + hstep + kstep, voffB);
        PG8_WAIT_V(6); PG8_BAR;
    } else {
        PG8_STAGE(PG8_SB(0, 0), cB, voffB); PG8_STAGE(PG8_SA(0, 0), cA, voffA); PG8_STAGE(PG8_SB(0, 1), cB + hstep, voffB); PG8_STAGE(PG8_SA(0, 1), cA + hstep, voffA);
        if (wr == 1) PG8_BAR;
        PG8_WAIT_V(4); PG8_BAR;
        PG8_STAGE(PG8_SB(1, 0), cB + kstep, voffB); PG8_STAGE(PG8_SA(1, 0), cA + kstep, voffA); PG8_STAGE(PG8_SB(1, 1), cB + hstep + kstep, voffB);
        PG8_WAIT_V(6); PG8_BAR;
    }
    f32x4 epf = (f32x4){0.f, 0.f, 0.f, 0.f};
    for (;;) {
        const bool has_next = S.next(ui + 1, nxt);
        const char* nA = has_next ? (const char*)g.A + (size_t)nxt.pm * tstep : cA; const char* nB = has_next ? (const char*)g.Bt + (size_t)nxt.pn * tstep : cB;
        for (int t = 0; t < nt; t += 2) {
            const bool last = (t == nt - 2);
            const char* a1 = cA + (size_t)(t + 1) * kstep;
            const char* a2 = last ? nA : cA + (size_t)(t + 2) * kstep; const char* b2 = last ? nB : cB + (size_t)(t + 2) * kstep;
            const char* a3 = a2 + kstep; const char* b3 = b2 + kstep;
            if (last && has_next) S.a_ready(nxt);
            if constexpr (Epi::PREFETCH) { if (last) E.prefetch(cur, wr, wc, fr, fq, epf); }
            if constexpr (SP2) {
            PG8_LDB(B0, 0, 0); PG8_LDB(B1, 0, 1); PG8_SCHED; PG8_LDA(At, 0, 0); PG8_STAGE(PG8_SA(1, 1), a1 + hstep, voffA);
            PG8_WAIT_V(8); PG8_WAIT_L(0); PG8_BAR; PG8_MMA(0, 0, At, B0); PG8_MMA(0, 1, At, B1); PG8_BAR; PG8_SCHED;
            PG8_LDA(At, 0, 1); PG8_STAGE(PG8_SB(0, 0), b2, voffB); PG8_STAGE(PG8_SB(0, 1), b2 + hstep, voffB); PG8_STAGE(PG8_SA(0, 0), a2, voffA);
            PG8_WAIT_V(8); PG8_WAIT_L(0); PG8_BAR; PG8_MMA(1, 0, At, B0); PG8_MMA(1, 1, At, B1); PG8_BAR; PG8_SCHED;
            PG8_LDB(B0, 1, 0); PG8_LDB(B1, 1, 1); PG8_SCHED; PG8_LDA(At, 1, 0); PG8_STAGE(PG8_SA(0, 1), a2 + hstep, voffA);
            PG8_WAIT_V(8); PG8_WAIT_L(0); PG8_BAR; PG8_MMA(0, 0, At, B0); PG8_MMA(0, 1, At, B1); PG8_BAR; PG8_SCHED;
            PG8_LDA(At, 1, 1); PG8_STAGE(PG8_SB(1, 0), b3, voffB); PG8_STAGE(PG8_SB(1, 1), b3 + hstep, voffB); PG8_STAGE(PG8_SA(1, 0), a3, voffA);
            PG8_WAIT_V(8); PG8_WAIT_L(0); PG8_BAR; PG8_MMA(1, 0, At, B0); PG8_MMA(1, 1, At, B1); PG8_BAR; PG8_SCHED;
            } else {
            PG8_LDB(B0, 0, 0); PG8_SCHED; PG8_LDA(At, 0, 0); PG8_STAGE(PG8_SA(1, 1), a1 + hstep, voffA);
            PG8_WAIT_L(8); PG8_BAR; PG8_WAIT_L(0); PG8_MMA(0, 0, At, B0); PG8_BAR; PG8_SCHED;
            PG8_LDB(B1, 0, 1); PG8_STAGE(PG8_SB(0, 0), b2, voffB);
            PG8_BAR; PG8_WAIT_L(0); PG8_MMA(0, 1, At, B1); PG8_BAR;
            PG8_LDA(At, 0, 1); PG8_STAGE(PG8_SA(0, 0), a2, voffA);
            PG8_BAR; PG8_WAIT_L(0); PG8_MMA(1, 0, At, B0); PG8_BAR; PG8_SCHED;
            PG8_STAGE(PG8_SB(0, 1), b2 + hstep, voffB);
            PG8_WAIT_V(6); PG8_BAR; PG8_MMA(1, 1, At, B1); PG8_BAR;
            PG8_LDB(B0, 1, 0); PG8_SCHED; PG8_LDA(At, 1, 0); PG8_STAGE(PG8_SA(0, 1), a2 + hstep, voffA);
            PG8_WAIT_L(8); PG8_BAR; PG8_WAIT_L(0); PG8_MMA(0, 0, At, B0); PG8_BAR; PG8_SCHED;
            PG8_LDB(B1, 1, 1); PG8_STAGE(PG8_SB(1, 0), b3, voffB);
            PG8_BAR; PG8_WAIT_L(0); PG8_MMA(0, 1, At, B1); PG8_BAR;
            PG8_LDA(At, 1, 1); PG8_STAGE(PG8_SA(1, 0), a3, voffA);
            PG8_BAR; PG8_WAIT_L(0); PG8_MMA(1, 0, At, B0); PG8_BAR; PG8_SCHED;
            PG8_STAGE(PG8_SB(1, 1), b3 + hstep, voffB);
            PG8_WAIT_V(6); PG8_BAR; PG8_MMA(1, 1, At, B1); PG8_BAR;
            }
        }
        if constexpr (ALIGN_EPI) { if (wr == 0) PG8_BAR; }
        if constexpr (!Epi::AFTER_DRAIN) { if constexpr (Epi::PREFETCH) E(acc, cur, wr, wc, fr, fq, epf); else E(acc, cur, wr, wc, fr, fq); S.done(cur); }
        if (!has_next) break;
#pragma unroll
        for (int a = 0; a < 2; ++a)
#pragma unroll
            for (int b = 0; b < 2; ++b)
#pragma unroll
                for (int m = 0; m < 4; ++m)
#pragma unroll
                    for (int n = 0; n < 2; ++n) acc[a][b][m][n] = (f32x4){0.f, 0.f, 0.f, 0.f};
        cur = nxt; cA = nA; cB = nB; ++ui;
        if constexpr (ALIGN_EPI) { if (wr == 1) PG8_BAR; }
    }
    PG8_WAIT_V(0);
    if constexpr (!ALIGN_EPI) { if (wr == 0) PG8_BAR; }
    PG8_BAR;
    if constexpr (Epi::AFTER_DRAIN) { E.fused(acc, cur, wr, wc, fr, fq, lds, wid, lane); S.done(cur); }
#undef PG8_SA
#undef PG8_SB
#undef PG8_STAGE
#undef PG8_LDA
#undef PG8_LDB
#undef PG8_MMA
#undef PG8_WAIT_V
#undef PG8_WAIT_L
#undef PG8_BAR
#undef PG8_SCHED
}
}

constexpr int DM = 2048, NB_C = 32, S_C = 256, NB_L = 4, S_L = 4096, PAST = 512, DEPTH = 4;
constexpr int M_C = NB_C * S_C;
constexpr int M_L = NB_L * S_L;
constexpr int MTOK = M_C + M_L;
constexpr int SKV_L = PAST + S_L;
constexpr int MKEY = M_C + NB_L * SKV_L;
constexpr int DIN = 4416, NPROJ = 4608;
constexpr int DFF = 5632, NUP = 2 * DFF;
constexpr int LRU_W = 1024;
constexpr int C_QA = 0, C_KA = 512, C_VA = 768, C_XR = 1024, C_GR = 2048, C_QM = 3072, C_CKV = 3840, C_KR = 4352;
constexpr float NORM_EPS = 1e-6f;
constexpr size_t O_Y = 0, O_K = 50331648, O_V = 58720256, O_CKV = 67108864, O_KR = 83886080, O_ST = 85983232, O_END = 86245376;
enum { I_XP = 0, I_XS, I_CK, I_CV, I_CCKV, I_CKR, I_ST, I_C, I_CCTX, I_WMOD, I_BMOD, I_GPM, I_GPOM, I_GPF, I_GPOF, I_WIN, I_GQ, I_GK, I_LCW, I_LCB, I_LWA, I_LBA, I_LWX, I_LBX, I_LLAM, I_GKV, I_WUK, I_WUV, I_WOUT, I_WUP, I_FCW, I_FCB, I_WDN, N_IN };

constexpr size_t MiB = 1u << 20;
constexpr size_t WS_CTL = 0, CTL_ZERO_BYTES = 2 * MiB;
constexpr size_t WS_MOD = 1 * MiB;
constexpr size_t WS_ROPE = 2 * MiB;
constexpr size_t WS_WIN = 3 * MiB, WS_WOUT = 75 * MiB, WS_WUP = 107 * MiB, WS_WDN = 283 * MiB, WS_WKV = 371 * MiB, WS_WG = 375 * MiB;
constexpr size_t WS_H = 379 * MiB, WS_KAL = 475 * MiB, WS_VAL = 484 * MiB, WS_KAC = 493 * MiB, WS_VAC = 497 * MiB, WS_CKV = 501 * MiB, WS_KR = 527 * MiB;
constexpr size_t WS_R1 = 531 * MiB;
constexpr size_t WS_PROJ = WS_R1, WS_QA = WS_R1 + 216 * MiB, WS_QM = WS_R1 + 240 * MiB, WS_XC = WS_R1 + 276 * MiB, WS_AU = WS_R1 + 324 * MiB, WS_HF = WS_R1 + 708 * MiB,
                 WS_KVM = WS_R1 + 804 * MiB, WS_MIX = WS_R1 + 856 * MiB, WS_SUMM = WS_R1 + 952 * MiB;
constexpr size_t WS_XB = WS_R1 + 324 * MiB;
constexpr size_t WS_MODP = WS_AU;
constexpr size_t WS_MO = WS_R1;
constexpr size_t WS_U = WS_R1, WS_ACT = WS_R1 + 528 * MiB;
constexpr size_t WS_HALO = WS_R1 + 792 * MiB;
constexpr size_t WS_DBG = WS_R1 + 953 * MiB;
constexpr size_t WS_END = WS_DBG + 8 * MiB;
static_assert(WS_ACT + (size_t)MTOK * DFF * 2 <= WS_DBG && WS_SUMM + MiB <= WS_DBG, "ws map");
constexpr int CW_TMO = 0, CW_CODE = 1, CW_BAR = 4096, CW_CHK = 65536, CW_LRUF = 131072;

constexpr int RING_BYTES = 155648, LDSCTL_OFF = RING_BYTES, MISC_OFF = LDSCTL_OFF + 320, LDS_BYTES = 163840;
static_assert(MISC_OFF + 128 <= LDS_BYTES, "LDS map");
constexpr int NWAVES = 8, NTHREADS = 512;

#define GAS __attribute__((address_space(1)))
#define LAS __attribute__((address_space(3)))
typedef unsigned short bf16;
typedef unsigned v4u __attribute__((ext_vector_type(4)));
typedef float f32x4 __attribute__((ext_vector_type(4)));
typedef short bf16x8 __attribute__((ext_vector_type(8)));
typedef float f32x16 __attribute__((ext_vector_type(16)));
typedef short s16x4 __attribute__((ext_vector_type(4)));
#define LDS_WAIT() asm volatile("s_waitcnt lgkmcnt(0)" ::: "memory")
#define VM_WAIT() asm volatile("s_waitcnt vmcnt(0)" ::: "memory")
#ifndef HW_CVT
#define HW_CVT 1
#endif
#if HW_CVT
__device__ __forceinline__ unsigned pk2(float lo, float hi) { unsigned r; asm("v_cvt_pk_bf16_f32 %0, %1, %2" : "=v"(r) : "v"(lo), "v"(hi)); return r; }
__device__ __forceinline__ unsigned f2bf(float f) { return pk2(f, f) & 0xffffu; }
#else
__device__ __forceinline__ unsigned f2bf(float f) { unsigned u = __builtin_bit_cast(unsigned, f); return (u + 0x7fffu + ((u >> 16) & 1u)) >> 16; }
__device__ __forceinline__ unsigned pk2(float lo, float hi) { return f2bf(lo) | (f2bf(hi) << 16); }
#endif
__device__ __forceinline__ float bf2f(unsigned short b) { return __builtin_bit_cast(float, (unsigned)b << 16); }
__device__ __forceinline__ void ld8bf(const bf16* p, float (&x)[8]) { const v4u w = *(const v4u*)p;
    x[0] = __builtin_bit_cast(float, w.x << 16); x[1] = __builtin_bit_cast(float, w.x & 0xffff0000u); x[2] = __builtin_bit_cast(float, w.y << 16); x[3] = __builtin_bit_cast(float, w.y & 0xffff0000u);
    x[4] = __builtin_bit_cast(float, w.z << 16); x[5] = __builtin_bit_cast(float, w.z & 0xffff0000u); x[6] = __builtin_bit_cast(float, w.w << 16); x[7] = __builtin_bit_cast(float, w.w & 0xffff0000u); }
__device__ __forceinline__ void unpk8(const v4u w, float (&x)[8]) {
    x[0] = __builtin_bit_cast(float, w.x << 16); x[1] = __builtin_bit_cast(float, w.x & 0xffff0000u); x[2] = __builtin_bit_cast(float, w.y << 16); x[3] = __builtin_bit_cast(float, w.y & 0xffff0000u);
    x[4] = __builtin_bit_cast(float, w.z << 16); x[5] = __builtin_bit_cast(float, w.z & 0xffff0000u); x[6] = __builtin_bit_cast(float, w.w << 16); x[7] = __builtin_bit_cast(float, w.w & 0xffff0000u); }
__device__ __forceinline__ void st8bf(bf16* p, const float (&x)[8]) { v4u w; w.x = pk2(x[0], x[1]); w.y = pk2(x[2], x[3]); w.z = pk2(x[4], x[5]); w.w = pk2(x[6], x[7]); *(v4u*)p = w; }
__device__ __forceinline__ void ld8f(const float* p, float (&x)[8]) { const f32x4 a = *(const f32x4*)p, b = *(const f32x4*)(p + 4); x[0] = a.x; x[1] = a.y; x[2] = a.z; x[3] = a.w; x[4] = b.x; x[5] = b.y; x[6] = b.z; x[7] = b.w; }
__device__ __forceinline__ void st8f(float* p, const float (&x)[8]) { *(f32x4*)p = (f32x4){x[0], x[1], x[2], x[3]}; *(f32x4*)(p + 4) = (f32x4){x[4], x[5], x[6], x[7]}; }
__device__ __forceinline__ void st8f_nt(float* p, const float (&x)[8]) { __builtin_nontemporal_store((f32x4){x[0], x[1], x[2], x[3]}, (f32x4*)p); __builtin_nontemporal_store((f32x4){x[4], x[5], x[6], x[7]}, (f32x4*)(p + 4)); }
__device__ __forceinline__ float shfl_xor_(float v, int m) { return __int_as_float(__builtin_amdgcn_ds_bpermute((int)((vlane() ^ (unsigned)m) << 2), __float_as_int(v))); }
#ifndef DPP_SUM
#define DPP_SUM 1
#endif
__device__ __forceinline__ float wave_sum(float v) {
#if DPP_SUM
#define WS_DPP(ctrl, rowmask) v += __int_as_float(__builtin_amdgcn_update_dpp(0, __float_as_int(v), ctrl, rowmask, 0xf, false))
    WS_DPP(0xB1, 0xf);
    WS_DPP(0x4E, 0xf);
    WS_DPP(0x141, 0xf);
    WS_DPP(0x140, 0xf);
    WS_DPP(0x142, 0xa);
    WS_DPP(0x143, 0xc);
#undef WS_DPP
    return __int_as_float(__builtin_amdgcn_readlane(__float_as_int(v), 63));
#else
#pragma unroll
    for (int o = 1; o < 64; o <<= 1) v += shfl_xor_(v, o);
    return v;
#endif
}
__device__ __forceinline__ float fexp(float x) { return __builtin_amdgcn_exp2f(x * 1.4426950408889634f); }
__device__ __forceinline__ float sigmoidf_(float x) { return __builtin_amdgcn_rcpf(1.0f + fexp(-x)); }
__device__ __forceinline__ float siluf_(float x) { return x * sigmoidf_(x); }
__device__ __forceinline__ float gelu_tanh(float x) { const float z = 0.7978845608028654f * (x + 0.044715f * x * x * x); const float t = 1.0f - 2.0f * __builtin_amdgcn_rcpf(fexp(2.0f * z) + 1.0f); return 0.5f * x * (1.0f + t); }

#define XB_TMO      128
#define XB_XCNT(j)  (256  + 64 * (j))
#define XB_XSUB(j)  (1280 + 64 * (j))
#define XB_XGEN(j)  (2304 + 64 * (j))
#define XB_TOP      3328
#define XB_TOPGEN   3392
#define XCD_BAR_WORDS 3456
#define XB_SPIN_CAP (1u << 18)

__device__ __forceinline__ unsigned xb_ld(unsigned* p)              { return __hip_atomic_load(p, __ATOMIC_RELAXED, __HIP_MEMORY_SCOPE_AGENT); }
__device__ __forceinline__ unsigned xb_add(unsigned* p, unsigned v) { return __hip_atomic_fetch_add(p, v, __ATOMIC_RELAXED, __HIP_MEMORY_SCOPE_AGENT); }
__device__ __forceinline__ unsigned xb_xcc_id() { return (unsigned)__builtin_amdgcn_s_getreg((3 << 11) | 20) & 0xFu; }
#define XB_SPIN(cond, bar) do { unsigned _sp = 0; while (cond) { __builtin_amdgcn_s_sleep(1); \
    if ((++_sp & 255u) == 0u) { if (xb_ld(&(bar)[XB_TMO])) break; if (_sp > XB_SPIN_CAP) { atomicAdd(&(bar)[XB_TMO], 1u); break; } } } } while (0)

struct XcdBarrier {
    unsigned* bar; unsigned x; unsigned w0;
    volatile LAS unsigned* st;
};

__device__ __forceinline__ XcdBarrier xcd_barrier_post(unsigned* bar, volatile LAS unsigned* st, int wave_id) {
    XcdBarrier b; b.bar = bar; b.x = xb_xcc_id(); b.st = st; b.w0 = (wave_id == 0);
    if (b.w0 && vlane() == 0u) (void)xb_add(&bar[XB_XCNT(b.x)], 1u);
    return b;
}
__device__ __forceinline__ void xcd_barrier_complete(unsigned* bar, unsigned x, unsigned& nloc, unsigned& nx) {
    const unsigned G = gridDim.x * gridDim.y * gridDim.z;
    unsigned sum, cnt, mine, sp = 0u;
    for (;;) {
        sum = 0u; cnt = 0u; mine = 0u;
#pragma unroll
        for (unsigned j = 0; j < 16; ++j) { const unsigned c = xb_ld(&bar[XB_XCNT(j)]); sum += c; cnt += (c > 0u) ? 1u : 0u; mine = (j == x) ? c : mine; }
        if (sum == G) break;
        __builtin_amdgcn_s_sleep(1);
        if ((++sp & 255u) == 0u) { if (xb_ld(&bar[XB_TMO])) break; if (sp > XB_SPIN_CAP) { atomicAdd(&bar[XB_TMO], 1u); break; } }
    }
    nloc = mine > 0u ? mine : 1u; nx = cnt > 0u ? cnt : 1u;
}

__device__ __forceinline__ void xcd_barrier(const XcdBarrier& b) {
    asm volatile("s_waitcnt vmcnt(0)" ::: "memory");
    __syncthreads();
    if (b.w0 && vlane() == 0u) {
        unsigned* bar = b.bar;
        __builtin_amdgcn_s_waitcnt(0);
        unsigned nloc = b.st[0], nx = b.st[1];
        if (nloc == 0u) { xcd_barrier_complete(bar, b.x, nloc, nx); b.st[0] = nloc; b.st[1] = nx; }
        const unsigned old = xb_add(&bar[XB_XSUB(b.x)], 1u);
        const unsigned gen = old / nloc;
        if (old + 1u == (gen + 1u) * nloc) {
            __builtin_amdgcn_fence(__ATOMIC_RELEASE, "agent");
            asm volatile("s_waitcnt vmcnt(0)" ::: "memory");
            const unsigned og = xb_add(&bar[XB_TOP], 1u);
            const unsigned tg = og / nx;
            if (og + 1u == (tg + 1u) * nx) xb_add(&bar[XB_TOPGEN], 1u);
            else XB_SPIN(xb_ld(&bar[XB_TOPGEN]) == tg, bar);
            __builtin_amdgcn_fence(__ATOMIC_ACQUIRE, "agent");
            xb_add(&bar[XB_XGEN(b.x)], 1u);
            asm volatile("s_waitcnt vmcnt(0)" ::: "memory");
        } else {
            XB_SPIN(xb_ld(&bar[XB_XGEN(b.x)]) == gen, bar);
            __builtin_amdgcn_fence(__ATOMIC_ACQUIRE, "agent");
            asm volatile("s_waitcnt vmcnt(0)" ::: "memory");
        }
    }
    __syncthreads();
}

#ifndef ATT_STAGGER
#define ATT_STAGGER 1
#endif
namespace att {
typedef __attribute__((ext_vector_type(4))) unsigned u32x4;
constexpr int NW = 8, QBLK = 32, KVBLK = 64;
constexpr int SHM_V = KVBLK * 128 * 2, SHM_K = KVBLK * 128 * 2, SHM_KR = KVBLK * 64 * 2;
constexpr int OFF_V = 0;
template <int NVB> struct Off { static constexpr int K = NVB * SHM_V, KR = K + 2 * SHM_K, WS = KR + 2 * SHM_KR, QR = WS + NW * 64 * 4; };
template <int NVB, int QL> constexpr int lds_attn() { return Off<NVB>::QR + NW * QL * 1024; }
#ifndef SWZ_NEW
#define SWZ_NEW 1
#endif
#if SWZ_NEW
#define KSWZ(row, colB) ((row) * 256 + ((colB) ^ ((((row) & 3) | ((((row) >> 3) & 3) << 2)) << 4)))
#else
#define KSWZ(row, colB) ((row) * 256 + ((colB) ^ (((row) & 7) << 4)))
#endif
#if SWZ_NEW
#define KRSWZ(row, colB) ((row) * 128 + ((colB) ^ (((((row) >> 1) & 1) | ((((row) >> 3) & 3) << 1)) << 4)))
#else
#define KRSWZ(row, colB) ((row) * 128 + ((colB) ^ (((row) & 7) << 4)))
#endif
#define SBAR() __builtin_amdgcn_sched_barrier(0)
constexpr float THR = 8.f;
__device__ __forceinline__ int crow(int r, int hi) { return (r & 3) + 8 * (r >> 2) + 4 * hi; }
__device__ __forceinline__ unsigned cvtpk(float lo, float hi) { unsigned r; asm volatile("v_cvt_pk_bf16_f32 %0, %1, %2" : "=v"(r) : "v"(lo), "v"(hi)); return r; }

template <int DQK> __device__ __forceinline__ void partialSM(f32x16& p0, f32x16& p1, float& m_reg, float& mn, float& alpha) {
  constexpr float SCALE = (DQK == 128) ? 0.088388347648318440f : 0.072168783648703220f;
  constexpr float C = SCALE * 1.4426950408889634f;
  float pmax = p0[0];
#pragma unroll
  for (int r = 1; r < 16; ++r) pmax = fmaxf(pmax, p0[r]);
#pragma unroll
  for (int r = 0; r < 16; ++r) pmax = fmaxf(pmax, p1[r]);
  { auto rr = __builtin_amdgcn_permlane32_swap(__float_as_uint(pmax), __float_as_uint(pmax), false, false);
    pmax = fmaxf(__uint_as_float(rr[0]), __uint_as_float(rr[1])); }
  if (__builtin_expect(__all(pmax - m_reg <= THR / SCALE), 1)) { mn = m_reg; alpha = 1.f; }
  else { mn = fmaxf(m_reg, pmax); alpha = __builtin_amdgcn_exp2f((m_reg - mn) * C); m_reg = mn; }
  float mnC = -mn * C;
#pragma unroll
  for (int r = 0; r < 16; ++r) p0[r] = fmaf(p0[r], C, mnC);
#pragma unroll
  for (int r = 0; r < 16; ++r) p1[r] = fmaf(p1[r], C, mnC);
#pragma unroll
  for (int r = 0; r < 16; ++r) p0[r] = __builtin_amdgcn_exp2f(p0[r]);
}
__device__ __forceinline__ void finishSM(f32x16& p0, f32x16& p1, float alpha, float& l_reg, bf16x8& pa0, bf16x8& pa1, bf16x8& pa2, bf16x8& pa3) {
#pragma unroll
  for (int r = 0; r < 16; ++r) p1[r] = __builtin_amdgcn_exp2f(p1[r]);
  float ps = 0;
#pragma unroll
  for (int r = 0; r < 16; ++r) ps += p0[r];
#pragma unroll
  for (int r = 0; r < 16; ++r) ps += p1[r];
  { auto rr = __builtin_amdgcn_permlane32_swap(__float_as_uint(ps), __float_as_uint(ps), false, false);
    ps = __uint_as_float(rr[0]) + __uint_as_float(rr[1]); }
  l_reg = l_reg * alpha + ps;
#define PK4(P, BASE, OUT) do { unsigned a0 = cvtpk(P[BASE + 0], P[BASE + 1]), a1 = cvtpk(P[BASE + 2], P[BASE + 3]);   \
    unsigned b0 = cvtpk(P[BASE + 4], P[BASE + 5]), b1 = cvtpk(P[BASE + 6], P[BASE + 7]);                              \
    auto r0 = __builtin_amdgcn_permlane32_swap(a0, b0, false, false); auto r1 = __builtin_amdgcn_permlane32_swap(a1, b1, false, false); \
    u32x4 w = {r0[0], r1[0], r0[1], r1[1]}; OUT = *reinterpret_cast<bf16x8*>(&w); } while (0)
  PK4(p0, 0, pa0); PK4(p0, 8, pa1); PK4(p1, 0, pa2); PK4(p1, 8, pa3);
#undef PK4
}
template <int DR, int NQR> __device__ __forceinline__ void qkt(f32x16& p0, f32x16& p1, const char* Ks, const char* KRs, const bf16x8* qr, const char* qrl, int r32, int hi) {
  p0 = f32x16{}; p1 = f32x16{};
#pragma unroll
  for (int d0 = 0; d0 < 8; ++d0) { int cb = (d0 * 16 + hi * 8) * 2;
    bf16x8 b0 = *reinterpret_cast<const bf16x8*>(Ks + KSWZ(r32, cb));
    bf16x8 b1 = *reinterpret_cast<const bf16x8*>(Ks + KSWZ(32 + r32, cb));
    bf16x8 qf; if constexpr (true) { if (d0 < NQR) qf = qr[d0]; else qf = *reinterpret_cast<const bf16x8*>(qrl + (d0 - NQR) * 1024); }
    p0 = __builtin_amdgcn_mfma_f32_32x32x16_bf16(b0, qf, p0, 0, 0, 0);
    p1 = __builtin_amdgcn_mfma_f32_32x32x16_bf16(b1, qf, p1, 0, 0, 0); }
  if constexpr (DR > 0) {
#pragma unroll
    for (int d0 = 0; d0 < DR / 16; ++d0) { int cb = (d0 * 16 + hi * 8) * 2;
      bf16x8 b0 = *reinterpret_cast<const bf16x8*>(KRs + KRSWZ(r32, cb));
      bf16x8 b1 = *reinterpret_cast<const bf16x8*>(KRs + KRSWZ(32 + r32, cb));
      const bf16x8 qf = *reinterpret_cast<const bf16x8*>(qrl + (8 - NQR + d0) * 1024);
      p0 = __builtin_amdgcn_mfma_f32_32x32x16_bf16(b0, qf, p0, 0, 0, 0);
      p1 = __builtin_amdgcn_mfma_f32_32x32x16_bf16(b1, qf, p1, 0, 0, 0); }
  }
}
__device__ __forceinline__ int v_st(int k, int c) { const int kk = (k & ~0xC) | ((k & 4) << 1) | ((k & 8) >> 1); return ((kk >> 3) * 4 + (c >> 5)) * 512 + ((kk & 7) * 32 + (c & 31)) * 2; }
__device__ __forceinline__ int v_rd_base(int lane) { return ((lane & 3) << 3) | (((lane >> 2) & 3) << 6) | (((lane >> 4) & 1) << 5) | (((lane >> 5) & 1) << 8); }
constexpr int v_rd_off(int d0, int ks, int half) { return d0 * 512 + ks * 4096 + half * 2048; }
template <int OFF> __device__ __forceinline__ s16x4 tr_read(int vb) {
  s16x4 r; asm volatile("ds_read_b64_tr_b16 %0, %1 offset:%2" : "=&v"(r) : "v"(vb), "i"(OFF) : "memory"); return r;
}
template <int D0> __device__ __forceinline__ void pv_one(f32x16& od, int vb, bf16x8 pa0, bf16x8 pa1, bf16x8 pa2, bf16x8 pa3) {
  const s16x4 l0 = tr_read<v_rd_off(D0, 0, 0)>(vb), h0 = tr_read<v_rd_off(D0, 0, 1)>(vb), l1 = tr_read<v_rd_off(D0, 1, 0)>(vb), h1 = tr_read<v_rd_off(D0, 1, 1)>(vb);
  const s16x4 l2 = tr_read<v_rd_off(D0, 2, 0)>(vb), h2 = tr_read<v_rd_off(D0, 2, 1)>(vb), l3 = tr_read<v_rd_off(D0, 3, 0)>(vb), h3 = tr_read<v_rd_off(D0, 3, 1)>(vb);
  asm volatile("s_waitcnt lgkmcnt(0)" ::: "memory"); SBAR();
#define PK(L, H) (bf16x8){L[0], L[1], L[2], L[3], H[0], H[1], H[2], H[3]}
  od = __builtin_amdgcn_mfma_f32_32x32x16_bf16(pa0, PK(l0, h0), od, 0, 0, 0);
  od = __builtin_amdgcn_mfma_f32_32x32x16_bf16(pa1, PK(l1, h1), od, 0, 0, 0);
  od = __builtin_amdgcn_mfma_f32_32x32x16_bf16(pa2, PK(l2, h2), od, 0, 0, 0);
  od = __builtin_amdgcn_mfma_f32_32x32x16_bf16(pa3, PK(l3, h3), od, 0, 0, 0);
#undef PK
}
__device__ __forceinline__ void pv_d0(f32x16* o, int vb, bf16x8 pa0, bf16x8 pa1, bf16x8 pa2, bf16x8 pa3) {
  pv_one<0>(o[0], vb, pa0, pa1, pa2, pa3); pv_one<1>(o[1], vb, pa0, pa1, pa2, pa3); pv_one<2>(o[2], vb, pa0, pa1, pa2, pa3); pv_one<3>(o[3], vb, pa0, pa1, pa2, pa3);
}

template <int DR, int SD, int NQR, int STG, int LDQ, int LDK, int LDKR, int LDV, int LDO>
__device__ __forceinline__ void attn_body(const bf16* __restrict__ Qb, const bf16* __restrict__ Kh, const bf16* __restrict__ KRh, const bf16* __restrict__ Vh,
                                          bf16* __restrict__ Ob, int seq, char* lds, const int wave_id) {
  constexpr int DQK = 128 + DR, NQ = NQR, QL = (8 - NQR) + DR / 16;
  constexpr int NVB = STG ? 3 : 2; typedef Off<NVB> OF; static_assert(lds_attn<NVB, QL>() <= RING_BYTES, "attention LDS");
  const int tid = ltid(wave_id), wid = tid >> 6, lane = tid & 63, r32 = lane & 31, hi = lane >> 5;
  char* V_lds = lds + OFF_V; char* K_lds = lds + OF::K; char* KR_lds = lds + OF::KR;
  float* ws = (float*)(lds + OF::WS) + wid * 64; float* li_l = ws; float* al_l = ws + 32;
  float m_reg = -1e30f, l_reg = 0; f32x16 o[4] = {}; bf16x8 qr[NQ];
  const bf16* Qw = Qb + (long)(wid * QBLK + r32) * LDQ + hi * 8;
#pragma unroll
  for (int d0 = 0; d0 < NQ; ++d0) qr[d0] = *reinterpret_cast<const bf16x8*>(Qw + d0 * 16);
  char* qrl = lds + OF::QR + wid * (QL * 1024) + lane * 16;
#pragma unroll
  for (int d0 = 0; d0 < QL; ++d0) *reinterpret_cast<bf16x8*>(qrl + d0 * 1024) = *reinterpret_cast<const bf16x8*>(Qw + (NQR + d0) * 16);
  const int sr = tid >> 4, sc = (tid & 15) * 8, vst0 = v_st(sr, sc), vst1 = v_st(32 + sr, sc);
  const int rr = tid >> 3, rc = (tid & 7) * 8;
  const int vb0 = (int)(uintptr_t)V_lds + v_rd_base(lane);
  struct { bf16x8 vs0, vs1, ks0, ks1, kr; } sr_[SD];
#define SLOAD(i, k0) do { sr_[i].vs0 = *reinterpret_cast<const bf16x8*>(&Vh[(long)((k0) + sr) * LDV + sc]); sr_[i].vs1 = *reinterpret_cast<const bf16x8*>(&Vh[(long)((k0) + 32 + sr) * LDV + sc]); \
    sr_[i].ks0 = *reinterpret_cast<const bf16x8*>(&Kh[(long)((k0) + sr) * LDK + sc]); sr_[i].ks1 = *reinterpret_cast<const bf16x8*>(&Kh[(long)((k0) + 32 + sr) * LDK + sc]); \
    if constexpr (DR > 0) sr_[i].kr = *reinterpret_cast<const bf16x8*>(&KRh[(long)((k0) + rr) * LDKR + rc]); } while (0)
#define SWRITE(b, i) do { *(bf16x8*)(V_lds + (b) * SHM_V + vst0) = sr_[i].vs0;          \
    *(bf16x8*)(V_lds + (b) * SHM_V + vst1) = sr_[i].vs1; int kc = sc * 2;               \
    *(bf16x8*)(K_lds + (b) * SHM_K + KSWZ(sr, kc)) = sr_[i].ks0;                       \
    *(bf16x8*)(K_lds + (b) * SHM_K + KSWZ(32 + sr, kc)) = sr_[i].ks1;                  \
    if constexpr (DR > 0) *(bf16x8*)(KR_lds + (b) * SHM_KR + KRSWZ(rr, rc * 2)) = sr_[i].kr; } while (0)
#define SWAIT() do { if constexpr (SD == 1) asm volatile("s_waitcnt vmcnt(0)" ::: "memory"); else if constexpr (DR > 0) asm volatile("s_waitcnt vmcnt(5)" ::: "memory"); else asm volatile("s_waitcnt vmcnt(4)" ::: "memory"); } while (0)
#define RESC(a) do { if (__any((a) < 1.f)) { if (hi == 0) al_l[r32] = (a); asm volatile("s_waitcnt lgkmcnt(0)" ::: "memory"); \
    _Pragma("unroll") for (int d = 0; d < 4; ++d) _Pragma("unroll") for (int r = 0; r < 16; ++r) o[d][r] *= al_l[crow(r, hi)]; } } while (0)
  f32x16 pA0, pA1, pB0, pB1; float mnA, mnB, alA, alB; bf16x8 pa0, pa1, pa2, pa3; const int NT = seq / KVBLK;
  constexpr int SE = 0, SO = SD - 1;
  SLOAD(SE, 0); asm volatile("s_waitcnt vmcnt(0)" ::: "memory"); SWRITE(0, SE); __syncthreads();
  qkt<DR, NQR>(pA0, pA1, K_lds, KR_lds, qr, qrl, r32, hi); partialSM<DQK>(pA0, pA1, m_reg, mnA, alA);
  SLOAD(SO, KVBLK); if constexpr (SD == 2) { if (2 < NT) SLOAD(SE, 2 * KVBLK); }
  SWAIT(); SWRITE(1, SO); __syncthreads();
  if constexpr (STG != 0) {
    int vp = 0, vc = (int)SHM_V, vn = 2 * (int)SHM_V;
    const bool hiw = wave_id >= 4;
#define HALFBAR() do { asm volatile("s_waitcnt lgkmcnt(0)" ::: "memory"); __builtin_amdgcn_s_barrier(); asm volatile("" ::: "memory"); } while (0)
#define SWRITE3(kb, voff, i) do { *(bf16x8*)(V_lds + (voff) + vst0) = sr_[i].vs0; *(bf16x8*)(V_lds + (voff) + vst1) = sr_[i].vs1; int kc = sc * 2;               \
    *(bf16x8*)(K_lds + (kb) * SHM_K + KSWZ(sr, kc)) = sr_[i].ks0; *(bf16x8*)(K_lds + (kb) * SHM_K + KSWZ(32 + sr, kc)) = sr_[i].ks1;                  \
    if constexpr (DR > 0) *(bf16x8*)(KR_lds + (kb) * SHM_KR + KRSWZ(rr, rc * 2)) = sr_[i].kr; } while (0)
    for (int j = 1; j + 1 < NT; j += 2) {
      SBAR(); qkt<DR, NQR>(pB0, pB1, K_lds + SHM_K, KR_lds + SHM_KR, qr, qrl, r32, hi);
      finishSM(pA0, pA1, alA, l_reg, pa0, pa1, pa2, pa3); SBAR();
      SLOAD(SO, (j + SD) * KVBLK); SBAR();
      if constexpr (STG == 2) {
        pv_d0(o, vb0 + vp, pa0, pa1, pa2, pa3); SBAR();
        SWAIT(); SWRITE3(0, vn, SE);
        if (hiw) HALFBAR();
        partialSM<DQK>(pB0, pB1, m_reg, mnB, alB); RESC(alB);
        if (!hiw) HALFBAR();
      } else {
      pv_d0(o, vb0 + vp, pa0, pa1, pa2, pa3); partialSM<DQK>(pB0, pB1, m_reg, mnB, alB);
      SWAIT(); SWRITE3(0, vn, SE);
      RESC(alB); __syncthreads(); }
      { const int t = vp; vp = vc; vc = vn; vn = t; }
      SBAR(); qkt<DR, NQR>(pA0, pA1, K_lds, KR_lds, qr, qrl, r32, hi);
      finishSM(pB0, pB1, alB, l_reg, pa0, pa1, pa2, pa3); SBAR();
      if (SD == 1 || j + 3 < NT) SLOAD(SE, (j + 1 + SD) * KVBLK); SBAR();
      if constexpr (STG == 2) {
        pv_d0(o, vb0 + vp, pa0, pa1, pa2, pa3); SBAR();
        SWAIT(); SWRITE3(1, vn, SO);
        if (hiw) HALFBAR();
        partialSM<DQK>(pA0, pA1, m_reg, mnA, alA); RESC(alA);
        if (!hiw) HALFBAR();
      } else {
      pv_d0(o, vb0 + vp, pa0, pa1, pa2, pa3); partialSM<DQK>(pA0, pA1, m_reg, mnA, alA);
      SWAIT(); SWRITE3(1, vn, SO);
      RESC(alA); __syncthreads(); }
      { const int t = vp; vp = vc; vc = vn; vn = t; }
    }
#undef SWRITE3
#undef HALFBAR
    SBAR(); qkt<DR, NQR>(pB0, pB1, K_lds + SHM_K, KR_lds + SHM_KR, qr, qrl, r32, hi);
    finishSM(pA0, pA1, alA, l_reg, pa0, pa1, pa2, pa3); SBAR();
    pv_d0(o, vb0 + vp, pa0, pa1, pa2, pa3); partialSM<DQK>(pB0, pB1, m_reg, mnB, alB);
    RESC(alB);
    finishSM(pB0, pB1, alB, l_reg, pa0, pa1, pa2, pa3); SBAR();
    pv_d0(o, vb0 + vc, pa0, pa1, pa2, pa3);
  } else {
  for (int j = 1; j + 1 < NT; j += 2) {
    SBAR(); qkt<DR, NQR>(pB0, pB1, K_lds + SHM_K, KR_lds + SHM_KR, qr, qrl, r32, hi);
    finishSM(pA0, pA1, alA, l_reg, pa0, pa1, pa2, pa3); SBAR();
    SLOAD(SO, (j + SD) * KVBLK); SBAR();
    pv_d0(o, vb0, pa0, pa1, pa2, pa3); partialSM<DQK>(pB0, pB1, m_reg, mnB, alB);
    __syncthreads(); SWAIT(); SWRITE(0, SE);
    RESC(alB); __syncthreads();
    SBAR(); qkt<DR, NQR>(pA0, pA1, K_lds, KR_lds, qr, qrl, r32, hi);
    finishSM(pB0, pB1, alB, l_reg, pa0, pa1, pa2, pa3); SBAR();
    if (SD == 1 || j + 3 < NT) SLOAD(SE, (j + 1 + SD) * KVBLK); SBAR();
    pv_d0(o, vb0 + (int)SHM_V, pa0, pa1, pa2, pa3); partialSM<DQK>(pA0, pA1, m_reg, mnA, alA);
    __syncthreads(); SWAIT(); SWRITE(1, SO);
    RESC(alA); __syncthreads();
  }
  SBAR(); qkt<DR, NQR>(pB0, pB1, K_lds + SHM_K, KR_lds + SHM_KR, qr, qrl, r32, hi);
    finishSM(pA0, pA1, alA, l_reg, pa0, pa1, pa2, pa3); SBAR();
    pv_d0(o, vb0, pa0, pa1, pa2, pa3); partialSM<DQK>(pB0, pB1, m_reg, mnB, alB);
    __syncthreads(); RESC(alB);
    finishSM(pB0, pB1, alB, l_reg, pa0, pa1, pa2, pa3); SBAR();
    pv_d0(o, vb0 + (int)SHM_V, pa0, pa1, pa2, pa3);
  }
  if (hi == 0) li_l[r32] = l_reg; asm volatile("s_waitcnt lgkmcnt(0)" ::: "memory");
  float rli[16];
#pragma unroll
  for (int r = 0; r < 16; ++r) rli[r] = __builtin_amdgcn_rcpf(li_l[crow(r, hi)]);
  bf16* Ow = Ob + (long)(wid * QBLK) * LDO;
#pragma unroll
  for (int r = 0; r < 16; ++r) { int orow = crow(r, hi);
#pragma unroll
    for (int d0 = 0; d0 < 4; ++d0) Ow[(long)orow * LDO + d0 * 32 + r32] = (bf16)f2bf(o[d0][r] * rli[r]); }
  __syncthreads();
#undef SLOAD
#undef SWRITE
#undef SWAIT
#undef RESC
}
}
#ifndef LB_TAG
#define LB_TAG 1
#endif
#ifndef LB_SPLIT
#define LB_SPLIT 0
#endif
#ifndef LB_BATCH
#define LB_BATCH 8
#endif
#ifndef LRU_STAMPS
#define LRU_STAMPS 0
#define LS_A 0
#define LS_B 0
#define LS_NB 1
#endif
#ifndef LRU_LOOKBACK
#define LRU_LOOKBACK 1
#endif
#ifndef GQA_STG
#define GQA_STG 0
#endif
#ifndef MLA_STG
#define MLA_STG 0
#endif
#ifndef GQA_NQR
#define GQA_NQR 8
#endif
#ifndef GQA_SD
#define GQA_SD 2
#endif
#ifndef MLA_NQR
#define MLA_NQR 5
#endif
#ifndef MLA_SD
#define MLA_SD 2
#endif

struct Args { const float* in[N_IN]; float* out; unsigned char* ws; int ph_lo, ph_hi; };
constexpr int PH_PER_LAYER = 10, PH_PRE = 3, PH_TOTAL = PH_PRE + DEPTH * PH_PER_LAYER;
typedef const __attribute__((address_space(4))) Args* KArgs;
__device__ __forceinline__ KArgs launder(KArgs p) { asm volatile("" : "+s"(p)); return p; }

template <bool FFNUP = false>
__device__ __forceinline__ void transpose_item(const float* W, int K, int N, bf16* WT, LAS float* scr, int item, int lane) {
    const int nblk = N / 32, kb = item / nblk, nb = item % nblk, k0 = 64 * kb, n0 = 32 * nb;
    const int d0 = FFNUP ? ((n0 % DFF) / 128) * 256 + (n0 / DFF) * 128 + (n0 % DFF) % 128 : n0;
    { f32x4 v[8];
#pragma unroll
      for (int i = 0; i < 8; ++i) v[i] = __builtin_nontemporal_load((const f32x4*)&W[(size_t)(k0 + 8 * i + (lane >> 3)) * N + n0 + 4 * (lane & 7)]);
#pragma unroll
      for (int i = 0; i < 8; ++i) { LAS float* q = scr + (8 * i + (lane >> 3)) * 33 + 4 * (lane & 7); q[0] = v[i].x; q[1] = v[i].y; q[2] = v[i].z; q[3] = v[i].w; } }
    LDS_WAIT(); asm volatile("" ::: "memory");
    const int c = lane & 7;
#pragma unroll
    for (int j = 0; j < 4; ++j) { const int n = (lane >> 3) + 8 * j; const LAS float* s = scr + (8 * c) * 33 + n;
        v4u o; o.x = pk2(s[0 * 33], s[1 * 33]); o.y = pk2(s[2 * 33], s[3 * 33]); o.z = pk2(s[4 * 33], s[5 * 33]); o.w = pk2(s[6 * 33], s[7 * 33]);
        *(v4u*)(WT + (size_t)(d0 + n) * K + k0 + 8 * c) = o; }
    LDS_WAIT(); asm volatile("" ::: "memory");
}

struct TItem { const float* W; bf16* WT; int K, N, item, ffnup; };
__device__ __forceinline__ void ti_load(const TItem& d, f32x4 (&v)[8], int lane) {
    const int nblk = d.N / 32, kb = d.item / nblk, nb = d.item % nblk, k0 = 64 * kb, n0 = 32 * nb;
#pragma unroll
    for (int i = 0; i < 8; ++i) v[i] = __builtin_nontemporal_load((const f32x4*)&d.W[(size_t)(k0 + 8 * i + (lane >> 3)) * d.N + n0 + 4 * (lane & 7)]);
}
__device__ __forceinline__ void ti_to_lds(const f32x4 (&v)[8], LAS float* scr, int lane) {
#pragma unroll
    for (int i = 0; i < 8; ++i) { LAS float* q = scr + (8 * i + (lane >> 3)) * 33 + 4 * (lane & 7); q[0] = v[i].x; q[1] = v[i].y; q[2] = v[i].z; q[3] = v[i].w; }
}
__device__ __forceinline__ void ti_store(const TItem& d, LAS float* scr, int lane) {
    const int nblk = d.N / 32, kb = d.item / nblk, nb = d.item % nblk, k0 = 64 * kb, n0 = 32 * nb;
    const int d0 = d.ffnup ? ((n0 % DFF) / 128) * 256 + (n0 / DFF) * 128 + (n0 % DFF) % 128 : n0;
    LDS_WAIT(); asm volatile("" ::: "memory");
    const int c = lane & 7;
#pragma unroll
    for (int j = 0; j < 4; ++j) { const int n = (lane >> 3) + 8 * j; const LAS float* q = scr + (8 * c) * 33 + n;
        v4u o; o.x = pk2(q[0 * 33], q[1 * 33]); o.y = pk2(q[2 * 33], q[3 * 33]); o.z = pk2(q[4 * 33], q[5 * 33]); o.w = pk2(q[6 * 33], q[7 * 33]);
        *(v4u*)(d.WT + (size_t)(d0 + n) * d.K + k0 + 8 * c) = o; }
    LDS_WAIT(); asm volatile("" ::: "memory");
}

#ifndef TAILCONV
#define TAILCONV 1
#endif
constexpr int I_IN = 32 * 138, I_OUT = 32 * 64, I_UP = 32 * 352, I_DN = 88 * 64, I_KV = 2 * 128, I_G = 256;
constexpr int I_LAYER = I_IN + I_OUT + I_UP + I_DN + I_KV + I_G;
#ifndef TC_R1
#define TC_R1 7168
#endif
#ifndef TC_R2
#define TC_R2 10240
#endif
#ifndef TC_P0
#define TC_P0 8000
#endif
static_assert(TC_P0 >= I_IN && TC_P0 + TC_R2 >= I_IN + I_OUT + I_KV + I_G + I_UP && TC_R1 <= TC_R2 && TC_R2 <= I_LAYER && I_IN + I_OUT + I_KV + I_G <= TC_P0 + TC_R1, "conversion deadlines");
__device__ __forceinline__ TItem conv_decode(KArgs a, int it) {
    unsigned char* ws = a->ws;
    const int l = it / I_LAYER; int r = it % I_LAYER;
    if (r < I_IN) return TItem{a->in[I_WIN] + (size_t)l * DM * DIN, (bf16*)(ws + WS_WIN) + (size_t)l * NPROJ * DM, DM, DIN, r, 0}; r -= I_IN;
    if (r < I_OUT) return TItem{a->in[I_WOUT] + (size_t)l * DM * DM, (bf16*)(ws + WS_WOUT) + (size_t)l * DM * DM, DM, DM, r, 0}; r -= I_OUT;
    if (r < I_KV) { const int which = r / 128;
        return TItem{a->in[which ? I_WUV : I_WUK] + (size_t)l * 512 * 512, (bf16*)(ws + WS_WKV) + (size_t)l * 1024 * 512 + (size_t)which * 512 * 512, 512, 512, r % 128, 0}; } r -= I_KV;
    if (r < I_G) { const int mat = r / 8, sub = r % 8;
        const int ty = mat & 1, dir = (mat >> 1) & 1, n = mat >> 2;
        return TItem{a->in[ty ? I_LWX : I_LWA] + ((size_t)((l * 2 + dir) * 8 + n)) * 128 * 128, (bf16*)(ws + WS_WG) + (size_t)l * 32 * 16384 + (size_t)mat * 16384, 128, 128, sub, 0}; } r -= I_G;
    if (r < I_UP) return TItem{a->in[I_WUP] + (size_t)l * DM * NUP, (bf16*)(ws + WS_WUP) + (size_t)l * NUP * DM, DM, NUP, r, 1}; r -= I_UP;
    return TItem{a->in[I_WDN] + (size_t)l * DFF * DM, (bf16*)(ws + WS_WDN) + (size_t)l * DM * DFF, DFF, DM, r, 0};
}
__device__ __forceinline__ void convert_items(KArgs a, char* lds, int g0, int g1, int widx, int nw, int wave, int lane) {
    LAS float* scr = (LAS float*)(lds + wave * 16384);
    if (g1 > DEPTH * I_LAYER) g1 = DEPTH * I_LAYER;
    int it = g0 + widx;
    if (it >= g1) return;
    TItem d = conv_decode(a, it); f32x4 v[8]; ti_load(d, v, lane);
    for (;;) {
        ti_to_lds(v, scr, lane);
        const int itn = it + nw; TItem dn = d;
        if (itn < g1) { dn = conv_decode(a, itn); ti_load(dn, v, lane); }
        ti_store(d, scr, lane);
        if (itn >= g1) break;
        d = dn; it = itn;
    }
}
__device__ __forceinline__ void tail_convert(KArgs a, char* lds, int g0, int g1, int nwg, int G, int bx, int wave, int lane) {
    const int used = nwg % G;
    if (bx < used) return;
    convert_items(a, lds, g0, g1, (bx - used) * NWAVES + wave, (G - used) * NWAVES, wave, lane);
}
#ifndef MODSHIFT
#define MODSHIFT 0
#endif
static_assert(!MODSHIFT || TAILCONV, "MODSHIFT runs in the TAILCONV tail rounds");
constexpr size_t WS_MODP2 = WS_DBG;
__device__ __forceinline__ void modp_items(KArgs a, int l, float* MODP, int widx, int nw, int lane) {
      for (int it = widx; it < 32 * 48; it += nw) {
        const int kc = it / 48, jb = it % 48, j = jb * 256 + 4 * lane, k = kc * 64 + lane;
        float cv[5];
#pragma unroll
        for (int cr = 0; cr < 4; ++cr) cv[cr] = siluf_(a->in[I_C][cr * DM + k]);
        cv[4] = siluf_(a->in[I_CCTX][k]);
        f32x4 acc[5];
#pragma unroll
        for (int cr = 0; cr < 5; ++cr) acc[cr] = (f32x4){0.f, 0.f, 0.f, 0.f};
        const float* wp = a->in[I_WMOD] + ((size_t)l * DM + (size_t)kc * 64) * 12288 + j;
#pragma unroll 16
        for (int kk = 0; kk < 64; ++kk) { const f32x4 w = __builtin_nontemporal_load((const f32x4*)(wp + (size_t)kk * 12288));
#pragma unroll
            for (int cr = 0; cr < 5; ++cr) { const float s = __int_as_float(__builtin_amdgcn_readlane(__float_as_int(cv[cr]), kk)); acc[cr] += w * s; } }
        if (kc == 0) { const f32x4 b = *(const f32x4*)(a->in[I_BMOD] + (size_t)l * 12288 + j);
#pragma unroll
            for (int cr = 0; cr < 5; ++cr) acc[cr] += b; }
#pragma unroll
        for (int cr = 0; cr < 5; ++cr) *(f32x4*)(MODP + ((size_t)kc * 5 + cr) * 12288 + j) = acc[cr];
      }
}
__device__ __forceinline__ void mod_reduce_layer(KArgs a, int l, const float* MODP, int tidx, int nthr) {
    float* MOD = (float*)(a->ws + WS_MOD) + (size_t)l * 5 * 12288;
    for (int i = tidx; i < 5 * 12288 / 4; i += nthr) {
        f32x4 s = (f32x4){0.f, 0.f, 0.f, 0.f};
#pragma unroll 8
        for (int kc = 0; kc < 32; ++kc) s += *((const f32x4*)(MODP + (size_t)kc * 5 * 12288) + i);
        *((f32x4*)MOD + i) = s; }
}
__device__ __forceinline__ void phase_prologue(KArgs a, char* lds, int gw, int NGW, int wave, int lane) {
    unsigned char* ws = a->ws;
    convert_items(a, lds, 0, TAILCONV ? TC_P0 : DEPTH * I_LAYER, gw, NGW, wave, lane);
    if (LB_TAG) { const int gt = gw * 64 + lane, NT = NGW * 64;
      for (int i = gt; i < 2 * 64 * LRU_W / 2; i += NT) ((v4u*)(ws + WS_SUMM))[i] = (v4u){0u, 0u, 0u, 0u}; }
    { const int gt = gw * 64 + lane, NT = NGW * 64; constexpr int PER = (NPROJ - DIN) * DM / 8;
      for (int i = gt; i < DEPTH * PER; i += NT) { const int l = i / PER, j = i % PER; *((v4u*)((bf16*)(ws + WS_WIN) + (size_t)l * NPROJ * DM + (size_t)DIN * DM) + j) = (v4u){0u, 0u, 0u, 0u}; } }
    if (MODSHIFT) modp_items(a, 0, (float*)(ws + WS_MODP), gw, NGW, lane);
    else for (int l = 0; l < DEPTH; ++l) modp_items(a, l, (float*)(ws + WS_MODP) + (size_t)l * 32 * 5 * 12288, gw, NGW, lane);
    { const int gt = gw * 64 + lane;
      if (gt < 64 * 32 + 64 * 16) { const bool big = gt < 2048; const int e = big ? gt : gt - 2048, nf = big ? 32 : 16, pos = e / nf, f = e % nf;
        const float inv = exp2f(-(float)f / (float)nf * 13.287712379549449f);
        const float ang = (float)pos * inv;
        double rev = (double)ang * 0.15915494309189535; rev -= floor(rev);
        const float rf = (float)rev; const float sn = __builtin_amdgcn_sinf(rf), cs = __builtin_amdgcn_cosf(rf);
        float2* tab = (float2*)(ws + WS_ROPE + (big ? 0 : 32768)); tab[e] = make_float2(cs, sn); } }
}

__device__ __forceinline__ void phase_mod_reduce(KArgs a, int gtid, int NTHR) {
    for (int l = 0; l < (MODSHIFT ? 1 : DEPTH); ++l) mod_reduce_layer(a, l, (const float*)(a->ws + WS_MODP) + (size_t)l * 32 * 5 * 12288, gtid, NTHR);
}

#ifndef MO_NT
#define MO_NT 1
#endif
#ifndef R_NT
#define R_NT 1
#endif
#ifndef XBF16
#define XBF16 1
#endif
__device__ __forceinline__ f32x4 ld4bf(const bf16* p) { const unsigned long long w = *(const unsigned long long*)p; const unsigned lo = (unsigned)w, hi = (unsigned)(w >> 32);
    return (f32x4){__builtin_bit_cast(float, lo << 16), __builtin_bit_cast(float, lo & 0xffff0000u), __builtin_bit_cast(float, hi << 16), __builtin_bit_cast(float, hi & 0xffff0000u)}; }
__device__ __forceinline__ f32x4 ld4bf_nt(const bf16* p) { const unsigned long long w = __builtin_nontemporal_load((const unsigned long long*)p); const unsigned lo = (unsigned)w, hi = (unsigned)(w >> 32);
    return (f32x4){__builtin_bit_cast(float, lo << 16), __builtin_bit_cast(float, lo & 0xffff0000u), __builtin_bit_cast(float, hi << 16), __builtin_bit_cast(float, hi & 0xffff0000u)}; }
__device__ __forceinline__ void st4bf(bf16* p, const f32x4 h) { *(unsigned long long*)p = (unsigned long long)pk2(h.x, h.y) | ((unsigned long long)pk2(h.z, h.w) << 32); }
__device__ __forceinline__ void row_update(const float* xsrc, const bf16* xsrc_b, const bf16* msrc, float* xdst, bf16* xdst_b, const float* g_post, const float* gate,
                                           const float* g_pre, const float* sc, const float* sh, bf16* hdst, int lane) {
    f32x4 x[8];
    if (xsrc) {
#pragma unroll
        for (int j = 0; j < 8; ++j) x[j] = R_NT ? __builtin_nontemporal_load((const f32x4*)xsrc + lane + 64 * j) : *((const f32x4*)xsrc + lane + 64 * j);
    } else {
#pragma unroll
        for (int j = 0; j < 8; ++j) x[j] = ld4bf(xsrc_b + 4 * (lane + 64 * j));
    }
    if (msrc) {
        f32x4 m[8]; float ss = 0.f;
#pragma unroll
        for (int j = 0; j < 8; ++j) { m[j] = R_NT ? ld4bf_nt(msrc + 4 * (lane + 64 * j)) : ld4bf(msrc + 4 * (lane + 64 * j)); ss += (m[j].x * m[j].x + m[j].y * m[j].y) + (m[j].z * m[j].z + m[j].w * m[j].w); }
        const float rs = rsqrtf(wave_sum(ss) * (1.0f / DM) + NORM_EPS);
#pragma unroll
        for (int j = 0; j < 8; ++j) { const f32x4 g = *((const f32x4*)g_post + lane + 64 * j), gt = *((const f32x4*)gate + lane + 64 * j); x[j] = x[j] + gt * (m[j] * rs * g); }
    }
    if (xdst) {
#pragma unroll
        for (int j = 0; j < 8; ++j) { if (R_NT) __builtin_nontemporal_store(x[j], (f32x4*)xdst + lane + 64 * j); else *((f32x4*)xdst + lane + 64 * j) = x[j]; }
    }
    if (xdst_b) {
#pragma unroll
        for (int j = 0; j < 8; ++j) st4bf(xdst_b + 4 * (lane + 64 * j), x[j]);
    }
    if (hdst) {
        float ss = 0.f;
#pragma unroll
        for (int j = 0; j < 8; ++j) ss += (x[j].x * x[j].x + x[j].y * x[j].y) + (x[j].z * x[j].z + x[j].w * x[j].w);
        const float rs = rsqrtf(wave_sum(ss) * (1.0f / DM) + NORM_EPS);
#pragma unroll
        for (int j = 0; j < 8; ++j) { const f32x4 g = *((const f32x4*)g_pre + lane + 64 * j), s1 = *((const f32x4*)sc + lane + 64 * j), s0 = *((const f32x4*)sh + lane + 64 * j);
            st4bf(hdst + 4 * (lane + 64 * j), x[j] * rs * g * (1.0f + s1) + s0); }
    }
}
__device__ __forceinline__ int cond_row(int r) { return r < M_C ? 4 : (r - M_C) / S_L; }
__device__ __forceinline__ const float* mod_ptr(KArgs a, int l, int cr, int which) { return (const float*)(a->ws + WS_MOD) + ((size_t)(l * 5 + cr) * 6 + which) * DM; }

__device__ __forceinline__ void phase_first_norm(KArgs a, char* lds, int wg, int G, int tid) {
    const int lane = tid & 63, wave = __builtin_amdgcn_readfirstlane(tid >> 6);
    const int rows_per = (MTOK + G - 1) / G, r0 = wg * rows_per, r1 = (r0 + rows_per < MTOK) ? r0 + rows_per : MTOK;
    float* V = (float*)lds;
    const int cr0 = r0 < MTOK ? cond_row(r0) : 0, cr1 = r1 > r0 ? cond_row(r1 - 1) : cr0;
    if (r0 < r1) {
#pragma unroll
        for (int s = 0; s < 2; ++s) { const int cr = s ? cr1 : cr0; const int c4 = 4 * tid;
            const f32x4 gpre = *(const f32x4*)(a->in[I_GPM] + c4), sc = *(const f32x4*)(mod_ptr(a, 0, cr, 1) + c4), sh = *(const f32x4*)(mod_ptr(a, 0, cr, 0) + c4);
            *(f32x4*)(V + (s * 2 + 0) * DM + c4) = gpre * (1.0f + sc); *(f32x4*)(V + (s * 2 + 1) * DM + c4) = sh; } }
    __syncthreads();
    for (int r = r0 + wave; r < r1; r += NWAVES) {
        const int set = cond_row(r) == cr0 ? 0 : 1; const float* gp = V + (set * 2 + 0) * DM; const float* shv = V + (set * 2 + 1) * DM;
        const float* xs = r < M_C ? a->in[I_XP] + (size_t)r * DM : a->in[I_XS] + (size_t)(r - M_C) * DM; bf16* hr = (bf16*)(a->ws + WS_H) + (size_t)r * DM;
        float x[4][8]; float ss = 0.f;
#pragma unroll
        for (int j = 0; j < 4; ++j) { const f32x4 a0 = __builtin_nontemporal_load((const f32x4*)(xs + 8 * (lane + 64 * j))), a1 = __builtin_nontemporal_load((const f32x4*)(xs + 8 * (lane + 64 * j) + 4));
            x[j][0] = a0.x; x[j][1] = a0.y; x[j][2] = a0.z; x[j][3] = a0.w; x[j][4] = a1.x; x[j][5] = a1.y; x[j][6] = a1.z; x[j][7] = a1.w;
#pragma unroll
            for (int e = 0; e < 8; ++e) ss += x[j][e] * x[j][e]; }
        const float rs = rsqrtf(wave_sum(ss) * (1.0f / DM) + NORM_EPS);
#pragma unroll
        for (int j = 0; j < 4; ++j) { float g[8], s0[8], h[8]; ld8f(gp + 8 * (lane + 64 * j), g); ld8f(shv + 8 * (lane + 64 * j), s0);
#pragma unroll
            for (int e = 0; e < 8; ++e) h[e] = x[j][e] * rs * g[e] + s0[e];
            st8bf(hr + 8 * (lane + 64 * j), h); }
    }
    __syncthreads();
}
__device__ __forceinline__ void phase_residual(KArgs a, int l, int which, char* lds, int wg, int G, int tid) {
    const bf16* MO = (const bf16*)(a->ws + WS_MO);
    const int lane = tid & 63, wave = __builtin_amdgcn_readfirstlane(tid >> 6);
    const int rows_per = (MTOK + G - 1) / G, r0 = wg * rows_per, r1 = (r0 + rows_per < MTOK) ? r0 + rows_per : MTOK;
    const bool last = (which == 1) && (l + 1 == DEPTH);
    float* V = (float*)lds;
    const int cr0 = r0 < MTOK ? cond_row(r0) : 0, cr1 = r1 > r0 ? cond_row(r1 - 1) : cr0;
    if (r0 < r1) {
#pragma unroll
        for (int s = 0; s < 2; ++s) { const int cr = s ? cr1 : cr0; const int c4 = 4 * tid;
            const f32x4 gt = *(const f32x4*)(mod_ptr(a, l, cr, which ? 5 : 2) + c4), gpo = *(const f32x4*)(a->in[which ? I_GPOF : I_GPOM] + l * DM + c4);
            *(f32x4*)(V + (s * 3 + 0) * DM + c4) = gt * gpo;
            if (!last) { const int ln = which ? l + 1 : l;
                const f32x4 gpre = *(const f32x4*)(a->in[which ? I_GPM : I_GPF] + ln * DM + c4), sc = *(const f32x4*)(mod_ptr(a, ln, cr, which ? 1 : 4) + c4), sh = *(const f32x4*)(mod_ptr(a, ln, cr, which ? 0 : 3) + c4);
                *(f32x4*)(V + (s * 3 + 1) * DM + c4) = gpre * (1.0f + sc); *(f32x4*)(V + (s * 3 + 2) * DM + c4) = sh; } }
    }
    __syncthreads();
    for (int r = r0 + wave; r < r1; r += NWAVES) {
        const int set = cond_row(r) == cr0 ? 0 : 1; const float* gg = V + (set * 3 + 0) * DM; const float* gp = V + (set * 3 + 1) * DM; const float* shv = V + (set * 3 + 2) * DM;
        float* xr = a->out + (size_t)r * DM; bf16* hr = (bf16*)(a->ws + WS_H) + (size_t)r * DM;
        const float* xin = r < M_C ? a->in[I_XP] + (size_t)r * DM : a->in[I_XS] + (size_t)(r - M_C) * DM;
        const float* xs = (l == 0 && which == 0) ? xin : xr; bf16* xb = (bf16*)(a->ws + WS_XB) + (size_t)r * DM;
        float x[4][8], m[4][8]; float ss = 0.f;
        if (XBF16 && !(l == 0 && which == 0)) {
#pragma unroll
            for (int j = 0; j < 4; ++j) unpk8(__builtin_nontemporal_load((const v4u*)(xb + 8 * (lane + 64 * j))), x[j]);
        } else {
#pragma unroll
            for (int j = 0; j < 4; ++j) { const f32x4 a0 = __builtin_nontemporal_load((const f32x4*)(xs + 8 * (lane + 64 * j))), a1 = __builtin_nontemporal_load((const f32x4*)(xs + 8 * (lane + 64 * j) + 4));
                x[j][0] = a0.x; x[j][1] = a0.y; x[j][2] = a0.z; x[j][3] = a0.w; x[j][4] = a1.x; x[j][5] = a1.y; x[j][6] = a1.z; x[j][7] = a1.w; }
        }
#pragma unroll
        for (int j = 0; j < 4; ++j) { unpk8(__builtin_nontemporal_load((const v4u*)(MO + (size_t)r * DM + 8 * (lane + 64 * j))), m[j]);
#pragma unroll
            for (int e = 0; e < 8; ++e) ss += m[j][e] * m[j][e]; }
        const float rs = rsqrtf(wave_sum(ss) * (1.0f / DM) + NORM_EPS);
        float s2 = 0.f;
#pragma unroll
        for (int j = 0; j < 4; ++j) { float g[8]; ld8f(gg + 8 * (lane + 64 * j), g);
#pragma unroll
            for (int e = 0; e < 8; ++e) { x[j][e] = x[j][e] + g[e] * (m[j][e] * rs); s2 += x[j][e] * x[j][e]; }
            if (XBF16 && !last) st8bf(xb + 8 * (lane + 64 * j), x[j]);
            else { __builtin_nontemporal_store((f32x4){x[j][0], x[j][1], x[j][2], x[j][3]}, (f32x4*)(xr + 8 * (lane + 64 * j))); __builtin_nontemporal_store((f32x4){x[j][4], x[j][5], x[j][6], x[j][7]}, (f32x4*)(xr + 8 * (lane + 64 * j) + 4)); } }
        if (!last) { const float rs2 = rsqrtf(wave_sum(s2) * (1.0f / DM) + NORM_EPS);
#pragma unroll
            for (int j = 0; j < 4; ++j) { float g[8], s0[8], h[8]; ld8f(gp + 8 * (lane + 64 * j), g); ld8f(shv + 8 * (lane + 64 * j), s0);
#pragma unroll
                for (int e = 0; e < 8; ++e) h[e] = x[j][e] * rs2 * g[e] + s0[e];
                st8bf(hr + 8 * (lane + 64 * j), h); } }
    }
    __syncthreads();
}

__device__ __forceinline__ void rope8(float (&y)[8], int pxor, bool first, const float2* tab) {
#pragma unroll
    for (int i = 0; i < 8; ++i) { const float yp = shfl_xor_(y[i], pxor); const float2 cs = tab[i]; y[i] = first ? y[i] * cs.x - yp * cs.y : y[i] * cs.x + yp * cs.y; }
}

__device__ __forceinline__ void phase_postproj(KArgs a, int l, int gw, int NGW, int lane, char* lds, int tid) {
    unsigned char* ws = a->ws;
    float* LCW = (float*)lds; float* LCB = LCW + 4 * LRU_W; float* LGQ = LCB + LRU_W; float* LGK = LGQ + 128; float* LGKV = LGK + 128;
    { const float* s0 = a->in[I_LCW] + (size_t)l * 4 * LRU_W;
      for (int i = tid; i < 4 * LRU_W / 4; i += NTHREADS) *((f32x4*)LCW + i) = *((const f32x4*)s0 + i);
      if (tid < LRU_W / 4) *((f32x4*)LCB + tid) = *((const f32x4*)(a->in[I_LCB] + l * LRU_W) + tid);
      if (tid < 32) *((f32x4*)LGQ + tid) = *((const f32x4*)(a->in[I_GQ] + l * 128) + tid);
      else if (tid < 64) *((f32x4*)LGK + (tid - 32)) = *((const f32x4*)(a->in[I_GK] + l * 128) + (tid - 32));
      else if (tid < 192) *((f32x4*)LGKV + (tid - 64)) = *((const f32x4*)(a->in[I_GKV] + l * 512) + (tid - 64)); }
    __syncthreads();
    const bf16* PROJ = (const bf16*)(ws + WS_PROJ);
    float2* R128 = (float2*)(LGKV + 512); float2* R64 = R128 + 64 * 32;
    { const float2* g128 = (const float2*)(ws + WS_ROPE); const float2* g64 = (const float2*)(ws + WS_ROPE + 32768);
      for (int i = tid; i < 64 * 32 / 2; i += NTHREADS) *((f32x4*)R128 + i) = *((const f32x4*)g128 + i);
      for (int i = tid; i < 64 * 16 / 2; i += NTHREADS) *((f32x4*)R64 + i) = *((const f32x4*)g64 + i); }
    __syncthreads();
    bf16* QA = (bf16*)(ws + WS_QA); bf16* QM = (bf16*)(ws + WS_QM); bf16* XC = (bf16*)(ws + WS_XC);
    bf16* KAL = (bf16*)(ws + WS_KAL); bf16* VAL = (bf16*)(ws + WS_VAL); bf16* KAC = (bf16*)(ws + WS_KAC); bf16* VAC = (bf16*)(ws + WS_VAC);
    bf16* CKV = (bf16*)(ws + WS_CKV); bf16* KR = (bf16*)(ws + WS_KR);
    for (int job = gw; job < NB_L * PAST; job += NGW) {
            const int cb = job / PAST, p = job % PAST; float x[8];
            const size_t crow_ = ((size_t)(cb * DEPTH + l) * PAST + p);
            if (lane < 32) { ld8f(a->in[I_CK] + crow_ * 256 + 8 * lane, x); st8bf(KAL + ((size_t)cb * SKV_L + p) * 256 + 8 * lane, x);
                             ld8f(a->in[I_CV] + crow_ * 256 + 8 * lane, x); st8bf(VAL + ((size_t)cb * SKV_L + p) * 256 + 8 * lane, x); }
            const size_t krow = (size_t)M_C + (size_t)cb * SKV_L + p;
            ld8f(a->in[I_CCKV] + crow_ * 512 + 8 * lane, x); st8bf(CKV + krow * 512 + 8 * lane, x);
            if (lane < 8) { ld8f(a->in[I_CKR] + crow_ * 64 + 8 * lane, x); st8bf(KR + krow * 64 + 8 * lane, x); }
    }
    const int rpw = (MTOK + NGW - 1) / NGW, rbeg = gw * rpw, rend = (rbeg + rpw < MTOK) ? rbeg + rpw : MTOK;
    const v4u z4u = (v4u){0u, 0u, 0u, 0u};
    v4u win[2][4];
#pragma unroll
    for (int k = 0; k < 2; ++k)
#pragma unroll
        for (int j = 0; j < 4; ++j) { const int q = rbeg + j - 1; win[k][j] = (rbeg < rend && q >= 0 && q < MTOK) ? *(const v4u*)(PROJ + (size_t)q * NPROJ + C_XR + 8 * lane + 512 * k) : z4u; }
    v4u cur6[6];
#define PP_LOAD6(dst, rowi) do { const bf16* p_ = PROJ + (size_t)(rowi) * NPROJ; const bool ok_ = (rowi) < rend; \
      dst[0] = ok_ ? __builtin_nontemporal_load((const v4u*)(p_ + C_QA + 8 * lane)) : z4u; dst[1] = ok_ ? __builtin_nontemporal_load((const v4u*)(p_ + C_KA + 8 * lane)) : z4u; \
      dst[2] = ok_ ? __builtin_nontemporal_load((const v4u*)(p_ + C_CKV + 8 * lane)) : z4u; dst[3] = ok_ ? __builtin_nontemporal_load((const v4u*)(p_ + C_KR + 8 * (lane & 7))) : z4u; \
      dst[4] = ok_ ? __builtin_nontemporal_load((const v4u*)(p_ + C_QM + 8 * lane)) : z4u; dst[5] = (ok_ && lane < 32) ? __builtin_nontemporal_load((const v4u*)(p_ + C_QM + 8 * (64 + lane))) : z4u; } while (0)
    PP_LOAD6(cur6, rbeg);
    for (int job = rbeg; job < rend; ++job) {
        const int r = job; const bool lat = r >= M_C;
        const int b = lat ? (r - M_C) / S_L : r / S_C, t = lat ? (r - M_C) % S_L : r % S_C, slen = lat ? S_L : S_C;
        const int prow = t >> 6, pcol = t & 63;
        const bf16* pr = PROJ + (size_t)r * NPROJ;
        const size_t krow = lat ? (size_t)M_C + (size_t)b * SKV_L + PAST + t : (size_t)r;
        const size_t orow = ((size_t)(b * DEPTH + l) * S_C + t);
        float x[8];
        const v4u rq = cur6[0], rkv = cur6[1], rckv = cur6[2], rkr = cur6[3], rqm0 = cur6[4], rqm1 = cur6[5];
        PP_LOAD6(cur6, job + 1);
        v4u nxt[2];
#pragma unroll
        for (int k = 0; k < 2; ++k) nxt[k] = (job + 1 < rend && r + 3 < MTOK) ? *(const v4u*)(pr + (ptrdiff_t)3 * NPROJ + C_XR + 8 * lane + 512 * k) : z4u;
        v4u rx[2][4];
#pragma unroll
        for (int k = 0; k < 2; ++k)
#pragma unroll
            for (int j = 0; j < 4; ++j) { const int tt = t + j - 1; rx[k][j] = (tt >= 0 && tt < slen) ? win[k][j] : z4u; }
#pragma unroll
        for (int k = 0; k < 2; ++k) { win[k][0] = win[k][1]; win[k][1] = win[k][2]; win[k][2] = win[k][3]; win[k][3] = nxt[k]; }
        { unpk8(rq, x); float ss = 0.f;
#pragma unroll
          for (int i = 0; i < 8; ++i) ss += x[i] * x[i];
          ss += shfl_xor_(ss, 1); ss += shfl_xor_(ss, 2); ss += shfl_xor_(ss, 4); ss += shfl_xor_(ss, 8);
          const float rs = rsqrtf(ss * (1.0f / 128.0f) + NORM_EPS); float g[8]; ld8f(LGQ + 8 * (lane & 15), g);
#pragma unroll
          for (int i = 0; i < 8; ++i) x[i] = x[i] * rs * g[i];
          if (lat) { const int s = lane & 15; rope8(x, 4, (s & 7) < 4, R128 + ((s >> 3) ? pcol : prow) * 32 + 8 * (s & 3)); }
          st8bf(QA + (size_t)r * 512 + 8 * lane, x); }
        { unpk8(rkv, x); float ss = 0.f;
#pragma unroll
          for (int i = 0; i < 8; ++i) ss += x[i] * x[i];
          ss += shfl_xor_(ss, 1); ss += shfl_xor_(ss, 2); ss += shfl_xor_(ss, 4); ss += shfl_xor_(ss, 8);
          const float rs = rsqrtf(ss * (1.0f / 128.0f) + NORM_EPS); float g[8]; ld8f(LGK + 8 * (lane & 15), g);
          float y[8];
#pragma unroll
          for (int i = 0; i < 8; ++i) y[i] = x[i] * rs * g[i];
          if (lat) { const int s = lane & 15; rope8(y, 4, (s & 7) < 4, R128 + ((s >> 3) ? pcol : prow) * 32 + 8 * (s & 3)); }
          if (lane < 32) {
              if (lat) st8bf(KAL + ((size_t)b * SKV_L + PAST + t) * 256 + 8 * lane, y);
              else { st8bf(KAC + (size_t)r * 256 + 8 * lane, y); st8f_nt(a->out + O_K + orow * 256 + 8 * lane, y); }
          } else { const int c = 8 * (lane - 32);
              if (lat) st8bf(VAL + ((size_t)b * SKV_L + PAST + t) * 256 + c, x);
              else { st8bf(VAC + (size_t)r * 256 + c, x); st8f_nt(a->out + O_V + orow * 256 + c, x); }
          } }
#pragma unroll
        for (int k = 0; k < 2; ++k) { const int c = 8 * lane + 512 * k; float acc[8]; ld8f(LCB + c, acc);
#pragma unroll
          for (int j = 0; j < 4; ++j) { float xv[8], w[8]; unpk8(rx[k][j], xv); ld8f(LCW + j * LRU_W + c, w);
#pragma unroll
              for (int i = 0; i < 8; ++i) acc[i] += w[i] * xv[i]; }
          st8bf(XC + (size_t)r * LRU_W + c, acc); }
#pragma unroll
        for (int ps = 0; ps < 2; ++ps) { const int s = 64 * ps + lane; const bool act = (ps == 0) || lane < 32; const int s24 = s % 24;
          unpk8(ps == 0 ? rqm0 : rqm1, x);
          if (lat) { float y[8];
#pragma unroll
              for (int i = 0; i < 8; ++i) y[i] = x[i];
              const int sr = (s24 - 16) & 7; rope8(y, 2, (sr & 3) < 2, R64 + ((sr >> 2) ? pcol : prow) * 16 + 8 * (sr & 1));
              if (s24 >= 16) {
#pragma unroll
                  for (int i = 0; i < 8; ++i) x[i] = y[i]; } }
          if (act) st8bf(QM + (size_t)r * 768 + 8 * s, x); }
        { unpk8(rckv, x); float ss = 0.f;
#pragma unroll
          for (int i = 0; i < 8; ++i) ss += x[i] * x[i];
          const float rs = rsqrtf(wave_sum(ss) * (1.0f / 512.0f) + NORM_EPS); float g[8]; ld8f(LGKV + 8 * lane, g);
#pragma unroll
          for (int i = 0; i < 8; ++i) x[i] = x[i] * rs * g[i];
          st8bf(CKV + krow * 512 + 8 * lane, x); if (!lat) st8f_nt(a->out + O_CKV + orow * 512 + 8 * lane, x); }
        { const int ll = lane & 7; unpk8(rkr, x);
          if (lat) rope8(x, 2, (ll & 3) < 2, R64 + ((ll >> 2) ? pcol : prow) * 16 + 8 * (ll & 1));
          if (lane < 8) { st8bf(KR + krow * 64 + 8 * lane, x); if (!lat) st8f_nt(a->out + O_KR + orow * 64 + 8 * lane, x); } }
    }
}

namespace lru {
__device__ __forceinline__ void swap2(float x, float& lo, float& hh) { auto rr = __builtin_amdgcn_permlane32_swap(__float_as_uint(x), __float_as_uint(x), false, false); lo = __uint_as_float(rr[0]); hh = __uint_as_float(rr[1]); }
template <int DIR> __device__ __forceinline__ void compose(const f32x16& av, const f32x16& uv, float (&Aq)[4], float (&Bq)[4]) {
#pragma unroll
    for (int q = 0; q < 4; ++q) {
        if (DIR == 0) { float A = av[4 * q], B = uv[4 * q];
#pragma unroll
            for (int i = 1; i < 4; ++i) { B = B * av[4 * q + i] + uv[4 * q + i]; A *= av[4 * q + i]; }
            Aq[q] = A; Bq[q] = B; }
        else { float A = av[4 * q + 3], B = uv[4 * q + 3];
#pragma unroll
            for (int i = 2; i >= 0; --i) { B = B * av[4 * q + i] + uv[4 * q + i]; A *= av[4 * q + i]; }
            Aq[q] = A; Bq[q] = B; }
    }
}
template <int DIR> __device__ __forceinline__ float chain(const float (&Aq)[4], const float (&Bq)[4], float h0, int hi, float (&hin)[4]) {
    float hcur = h0;
#pragma unroll
    for (int qq = 0; qq < 4; ++qq) { const int q = DIR == 0 ? qq : 3 - qq;
        float lo, hh; const float t0 = Aq[q] * hcur + Bq[q]; swap2(t0, lo, hh);
        const float x0 = DIR == 0 ? lo : hh;
        const float t1 = Aq[q] * x0 + Bq[q]; swap2(t1, lo, hh);
        const bool first = DIR == 0 ? (hi == 0) : (hi == 1);
        hin[q] = first ? hcur : x0;
        hcur = DIR == 0 ? hh : lo; }
    return hcur;
}
template <int DIR> __device__ __forceinline__ void expand(const f32x16& av, const f32x16& uv, const float (&hin)[4], f32x16& h) {
#pragma unroll
    for (int q = 0; q < 4; ++q) { float s = hin[q];
        if (DIR == 0) {
#pragma unroll
            for (int i = 0; i < 4; ++i) { s = av[4 * q + i] * s + uv[4 * q + i]; h[4 * q + i] = s; } }
        else {
#pragma unroll
            for (int i = 3; i >= 0; --i) { s = av[4 * q + i] * s + uv[4 * q + i]; h[4 * q + i] = s; } }
    }
}
constexpr int LDS_W = 0, LDS_S = 131072, LDS_TIN = LDS_S + 8192, LDS_LC = LDS_TIN + 2048, LDS_LRU = LDS_LC + 4096;
static_assert(LDS_LRU <= RING_BYTES, "LRU LDS");
}

template <bool FINAL, bool LOOKBACK = false>
__device__ __forceinline__ void phase_lru(KArgs a, int l, char* lds, int wg, int G, int tid) {
    unsigned char* ws = a->ws; const bf16* XC = (const bf16*)(ws + WS_XC); const bf16* WGl = (const bf16*)(ws + WS_WG) + (size_t)l * 32 * 16384;
    const bf16* PROJ = (const bf16*)(ws + WS_PROJ); bf16* MIX = (bf16*)(ws + WS_MIX); float2* SUMM = (float2*)(ws + WS_SUMM);
    const int lane = tid & 63, w = __builtin_amdgcn_readfirstlane(tid >> 6), r32 = lane & 31, hi = lane >> 5;
    float2* S = (float2*)(lds + lru::LDS_S); float* TIN = (float*)(lds + lru::LDS_TIN);
    bf16x8 idb[2];
#pragma unroll
    for (int s = 0; s < 2; ++s)
#pragma unroll
        for (int i = 0; i < 8; ++i) idb[s][i] = (r32 - 16 * s - 8 * hi == i) ? (short)0x3F80 : (short)0;
#if LRU_STAMPS
    unsigned long long* lts = (unsigned long long*)(ws + WS_DBG); const bool lst = FINAL && l == 1 && wg == 0 && tid == 0;
#define LSTAMP(k) do { if (lst) lts[k] = __builtin_amdgcn_s_memrealtime(); } while (0)
#else
#define LSTAMP(k) do { } while (0)
#endif
    LSTAMP(0);
    const int nunits = FINAL ? 96 * 8 : 64 * 8;
    const bool staged = (G & 7) == 0;
    if (staged) { const bf16* src = WGl + (size_t)(wg & 7) * 4 * 16384;
#pragma unroll 4
        for (int i = 0; i < 16; ++i) { const int q = tid + 512 * i, mat = q >> 11, row = (q >> 4) & 127, c16 = q & 15;
            *(bf16x8*)(lds + lru::LDS_W + mat * 32768 + KSWZ(row, c16 * 16)) = *(const bf16x8*)(src + (size_t)q * 8); }
        if (tid < 256) { const int dir = tid >> 7, ch = tid & 127, c = (wg & 7) * 128 + ch; const float lam = a->in[I_LLAM][(l * 2 + dir) * LRU_W + c];
            ((f32x4*)(lds + lru::LDS_LC))[tid] = (f32x4){a->in[I_LBA][(l * 2 + dir) * LRU_W + c], a->in[I_LBX][(l * 2 + dir) * LRU_W + c], -log1pf(__expf(-lam)) * (8.0f * 1.4426950408889634f), 0.f}; }
        __syncthreads(); }
    LSTAMP(1);
    int par = 0;
    for (int u = wg; u < nunits; u += G, par ^= 1) {
        const int n = u & 7, tile = FINAL ? (u >> 3) : 32 + (u >> 3); const bool lat = tile >= 32;
        const size_t row0 = (size_t)tile * 256 + (size_t)w * 32;
        if (FINAL && !LOOKBACK && tid < 256) {
            const int dir = tid >> 7, ch = tid & 127, c = n * 128 + ch; float h = 0.f;
            if (lat) { const int b = (tile - 32) >> 4, jt = (tile - 32) & 15; h = a->in[I_ST][((size_t)(b * DEPTH + l) * 2 + dir) * LRU_W + c];
                float2 sv[15];
#pragma unroll
                for (int k = 0; k < 15; ++k) { const int jj = dir == 0 ? k : 15 - k; const bool use = dir == 0 ? (jj < jt) : (jj > jt);
                    sv[k] = use ? SUMM[(size_t)(dir * 64 + b * 16 + jj) * LRU_W + c] : make_float2(1.f, 0.f); }
#pragma unroll
                for (int k = 0; k < 15; ++k) h = sv[k].x * h + sv[k].y; }
            TIN[(par * 2 + dir) * 128 + ch] = h; }
        bf16x8 af[8];
        { const bf16* ap = XC + (row0 + r32) * LRU_W + n * 128 + hi * 8;
#pragma unroll
          for (int ks = 0; ks < 8; ++ks) af[ks] = *(const bf16x8*)(ap + ks * 16); }
#pragma unroll 1
        for (int nb = 0; nb < 4; ++nb) {
            if (u == wg && nb == LS_NB) LSTAMP(2);
            const int c = n * 128 + nb * 32 + r32, buf = nb & 1;
            f32x16 av[2], uv[2];
            bf16x8 gf0, gf1;
            if (FINAL) { const bf16* gp = PROJ + (row0 + r32) * NPROJ + C_GR + n * 128 + hi * 8; gf0 = *(const bf16x8*)(gp + (2 * nb) * 16); gf1 = *(const bf16x8*)(gp + (2 * nb + 1) * 16); }
            {
                f32x16 xv = f32x16{};
#pragma unroll
                for (int ks = 0; ks < 8; ++ks) { if ((ks >> 1) == nb) xv = __builtin_amdgcn_mfma_f32_32x32x16_bf16(af[ks], idb[ks & 1], xv, 0, 0, 0); }
#pragma unroll
                for (int dir = 0; dir < 2; ++dir) {
                    f32x16 ga = f32x16{}, gx = f32x16{};
                    const bf16* bp0 = WGl + (size_t)((n * 2 + dir) * 2 + 0) * 16384 + (size_t)(nb * 32 + r32) * 128 + hi * 8; const bf16* bp1 = bp0 + 16384;
                    if (staged) { const char* lw = lds + lru::LDS_W + (dir * 2) * 32768; const int rw = nb * 32 + r32;
#pragma unroll
                        for (int kh = 0; kh < 4; ++kh) {
                            bf16x8 b0[2], b1[2];
#pragma unroll
                            for (int k4 = 0; k4 < 2; ++k4) { const int cb = ((kh * 2 + k4) * 16 + hi * 8) * 2; b0[k4] = *(const bf16x8*)(lw + KSWZ(rw, cb)); b1[k4] = *(const bf16x8*)(lw + 32768 + KSWZ(rw, cb)); }
                            __builtin_amdgcn_sched_barrier(0);
#pragma unroll
                            for (int k4 = 0; k4 < 2; ++k4) { ga = __builtin_amdgcn_mfma_f32_32x32x16_bf16(af[kh * 2 + k4], b0[k4], ga, 0, 0, 0); gx = __builtin_amdgcn_mfma_f32_32x32x16_bf16(af[kh * 2 + k4], b1[k4], gx, 0, 0, 0); }
                            __builtin_amdgcn_sched_barrier(0); }
                    } else {
#pragma unroll
                        for (int ks = 0; ks < 8; ++ks) { const bf16x8 b0 = *(const bf16x8*)(bp0 + ks * 16), b1 = *(const bf16x8*)(bp1 + ks * 16);
                            ga = __builtin_amdgcn_mfma_f32_32x32x16_bf16(af[ks], b0, ga, 0, 0, 0); gx = __builtin_amdgcn_mfma_f32_32x32x16_bf16(af[ks], b1, gx, 0, 0, 0); } }
                    float ba, bx, lsg;
                    if (staged) { const f32x4 lc = ((const f32x4*)(lds + lru::LDS_LC))[dir * 128 + nb * 32 + r32]; ba = lc.x; bx = lc.y; lsg = lc.z; }
                    else { const float lam = a->in[I_LLAM][(l * 2 + dir) * LRU_W + c]; ba = a->in[I_LBA][(l * 2 + dir) * LRU_W + c]; bx = a->in[I_LBX][(l * 2 + dir) * LRU_W + c]; lsg = -log1pf(__expf(-lam)) * (8.0f * 1.4426950408889634f); }
                    {
                        typedef float f32x2 __attribute__((ext_vector_type(2)));
                        const float nL = -1.4426950408889634f, nbaL = ba * nL, nbxL = bx * nL;
#pragma unroll
                        for (int r = 0; r < 16; r += 2) {
                            const f32x2 g1 = (f32x2){ga[r], ga[r + 1]}, g2 = (f32x2){gx[r], gx[r + 1]}, x2 = (f32x2){xv[r], xv[r + 1]};
                            const f32x2 t1 = g1 * nL + nbaL, t2 = g2 * nL + nbxL;
                            const f32x2 d1 = (f32x2){__builtin_amdgcn_exp2f(t1.x), __builtin_amdgcn_exp2f(t1.y)} + 1.0f, d2 = (f32x2){__builtin_amdgcn_exp2f(t2.x), __builtin_amdgcn_exp2f(t2.y)} + 1.0f;
                            const f32x2 pr = d1 * d2; const f32x2 rr = (f32x2){__builtin_amdgcn_rcpf(pr.x), __builtin_amdgcn_rcpf(pr.y)};
                            const f32x2 rg = rr * d2, ig = rr * d1, ta = rg * lsg;
                            const f32x2 aa = (f32x2){__builtin_amdgcn_exp2f(ta.x), __builtin_amdgcn_exp2f(ta.y)};
                            f32x2 om = 1.0f - aa * aa; om.x = fmaxf(om.x, 0.f); om.y = fmaxf(om.y, 0.f);
                            const f32x2 uu = (f32x2){__builtin_amdgcn_sqrtf(om.x), __builtin_amdgcn_sqrtf(om.y)} * (ig * x2);
                            av[dir][r] = aa.x; av[dir][r + 1] = aa.y; uv[dir][r] = uu.x; uv[dir][r + 1] = uu.y; } }
                    float Aq[4], Bq[4], hin[4]; float Bsb;
                    if (dir == 0) { lru::compose<0>(av[0], uv[0], Aq, Bq); Bsb = lru::chain<0>(Aq, Bq, 0.f, hi, hin); }
                    else { lru::compose<1>(av[1], uv[1], Aq, Bq); Bsb = lru::chain<1>(Aq, Bq, 0.f, hi, hin); }
                    float lo, hh; lru::swap2((Aq[0] * Aq[1]) * (Aq[2] * Aq[3]), lo, hh);
                    if (hi == 0) S[((buf * 2 + dir) * 8 + w) * 32 + r32] = make_float2(lo * hh, Bsb);
                }
            }
            if (u == wg && nb == LS_NB) LSTAMP(3);
            __syncthreads();
            if (FINAL && LOOKBACK) {
                if (lat) {
#if LB_TAG == 2
                    if (w < 2) {
                        const int dir = w, half = lane >> 5, chl = lane & 31, cc = n * 128 + nb * 32 + chl, lt = tile - 32, b = lt >> 4, jt = lt & 15;
                        float hA = 0.f, PA = 1.f;
                        if (dir == 0) { for (int ww = 0; ww < 8; ++ww) { const float2 s = S[((buf * 2 + 0) * 8 + ww) * 32 + chl]; hA = s.x * hA + s.y; PA *= s.x; } }
                        else { for (int ww = 7; ww >= 0; --ww) { const float2 s = S[((buf * 2 + 1) * 8 + ww) * 32 + chl]; hA = s.x * hA + s.y; PA *= s.x; } }
                        unsigned long long* AGG = (unsigned long long*)SUMM;
                        const unsigned tag = (unsigned)(l + 1);
                        if (half == 0) __hip_atomic_store(AGG + (size_t)(dir * 64 + lt) * LRU_W + cc, ((unsigned long long)__float_as_uint(hA) << 32) | ((__float_as_uint(PA) & ~7u) | tag), __ATOMIC_RELAXED, __HIP_MEMORY_SCOPE_AGENT);
                        float H = half == 0 ? a->in[I_ST][((size_t)(b * DEPTH + l) * 2 + dir) * LRU_W + cc] : 0.f, P = 1.f;
                        {   unsigned long long sv[8]; unsigned spins = 0; const int kb = half * 8;
                            for (;;) { bool ok = true;
#pragma unroll
                                for (int k = 0; k < 8; ++k) { const int kk = kb + k, jj = dir == 0 ? kk : 15 - kk; const bool use = (kk < 15) && (dir == 0 ? (jj < jt) : (jj > jt));
                                    sv[k] = use ? __hip_atomic_load(AGG + (size_t)(dir * 64 + b * 16 + jj) * LRU_W + cc, __ATOMIC_RELAXED, __HIP_MEMORY_SCOPE_AGENT) : (unsigned long long)(0x3f800000u | tag);
                                    ok = ok && (((unsigned)sv[k] & 7u) == tag); }
                                if (__all(ok)) break;
                                __builtin_amdgcn_s_sleep(1);
                                if (++spins > (1u << 20)) { if (lane == 0) __hip_atomic_store((unsigned*)(ws + WS_CTL) + CW_TMO, 0x1b00u, __ATOMIC_RELAXED, __HIP_MEMORY_SCOPE_AGENT); break; } }
#pragma unroll
                            for (int k = 0; k < 8; ++k) { const float pk = __uint_as_float((unsigned)sv[k] & ~7u); H = pk * H + __uint_as_float((unsigned)(sv[k] >> 32)); P *= pk; } }
                        const float Pb = shfl_xor_(P, 32), Hb = shfl_xor_(H, 32);
                        if (half == 0) TIN[(par * 2 + dir) * 128 + nb * 32 + chl] = Pb * H + Hb;
                    }
                    __syncthreads();
#else
                    float hseg = 0.f; (void)hseg;
                    if (w == 0) {
                        const int dir = lane >> 5, chl = lane & 31, cc = n * 128 + nb * 32 + chl, lt = tile - 32, b = lt >> 4, jt = lt & 15;
                        float hA = 0.f, PA = 1.f;
                        if (dir == 0) { for (int ww = 0; ww < 8; ++ww) { const float2 s = S[((buf * 2 + 0) * 8 + ww) * 32 + chl]; hA = s.x * hA + s.y; PA *= s.x; } }
                        else { for (int ww = 7; ww >= 0; --ww) { const float2 s = S[((buf * 2 + 1) * 8 + ww) * 32 + chl]; hA = s.x * hA + s.y; PA *= s.x; } }
                        unsigned long long* AGG = (unsigned long long*)SUMM;
#if LB_TAG == 1
                        const unsigned tag = (unsigned)(l + 1);
                        __hip_atomic_store(AGG + (size_t)(dir * 64 + lt) * LRU_W + cc, ((unsigned long long)__float_as_uint(hA) << 32) | ((__float_as_uint(PA) & ~7u) | tag), __ATOMIC_RELAXED, __HIP_MEMORY_SCOPE_AGENT);
                        float h = a->in[I_ST][((size_t)(b * DEPTH + l) * 2 + dir) * LRU_W + cc];
#pragma unroll 1
                        for (int k0 = 0; k0 < 15; k0 += 8) {
                            unsigned long long sv[8]; unsigned spins = 0;
                            for (;;) { bool ok = true;
#pragma unroll
                                for (int k = 0; k < 8; ++k) { const int jj = dir == 0 ? k0 + k : 15 - (k0 + k); const bool use = (k0 + k < 15) && (dir == 0 ? (jj < jt) : (jj > jt));
                                    sv[k] = use ? __hip_atomic_load(AGG + (size_t)(dir * 64 + b * 16 + jj) * LRU_W + cc, __ATOMIC_RELAXED, __HIP_MEMORY_SCOPE_AGENT) : (unsigned long long)(0x3f800000u | tag);
                                    ok = ok && (((unsigned)sv[k] & 7u) == tag); }
                                if (__all(ok)) break;
                                __builtin_amdgcn_s_sleep(1);
                                if (++spins > (1u << 20)) { if (lane == 0) __hip_atomic_store((unsigned*)(ws + WS_CTL) + CW_TMO, 0x1b00u, __ATOMIC_RELAXED, __HIP_MEMORY_SCOPE_AGENT); break; } }
#pragma unroll
                            for (int k = 0; k < 8; ++k) h = __uint_as_float((unsigned)sv[k] & ~7u) * h + __uint_as_float((unsigned)(sv[k] >> 32)); }
                        TIN[(par * 2 + dir) * 128 + nb * 32 + chl] = h;
                    }
                    __syncthreads();
#else
                        __hip_atomic_store(AGG + (size_t)(dir * 64 + lt) * LRU_W + cc, ((unsigned long long)__float_as_uint(hA) << 32) | __float_as_uint(PA), __ATOMIC_RELAXED, __HIP_MEMORY_SCOPE_AGENT);
                        asm volatile("s_waitcnt vmcnt(0)" ::: "memory");
                        unsigned* FLG = (unsigned*)(ws + WS_CTL) + CW_LRUF;
                        if (lane == 0) __hip_atomic_store(FLG + (size_t)((lt * 8 + n) * 4 + nb) * 16, (unsigned)(l + 1), __ATOMIC_RELAXED, __HIP_MEMORY_SCOPE_AGENT);
                        {   unsigned spins = 0; const unsigned* fp = FLG + (size_t)(((b * 16 + (lane & 15)) * 8 + n) * 4 + nb) * 16;
                            while (!__all(__hip_atomic_load(fp, __ATOMIC_RELAXED, __HIP_MEMORY_SCOPE_AGENT) >= (unsigned)(l + 1))) {
                                __builtin_amdgcn_s_sleep(1);
                                if (++spins > (1u << 20)) { if (lane == 0) __hip_atomic_store((unsigned*)(ws + WS_CTL) + CW_TMO, 0x1b00u, __ATOMIC_RELAXED, __HIP_MEMORY_SCOPE_AGENT); break; } } }
                        __builtin_amdgcn_fence(__ATOMIC_ACQUIRE, "agent");
                        float h = a->in[I_ST][((size_t)(b * DEPTH + l) * 2 + dir) * LRU_W + cc];
#if LB_SPLIT
                        {   unsigned long long sv[8];
#pragma unroll
                            for (int k = 0; k < 8; ++k) { const int jj = dir == 0 ? k : 15 - k; const bool use = dir == 0 ? (jj < jt) : (jj > jt);
                                sv[k] = use ? __hip_atomic_load(AGG + (size_t)(dir * 64 + b * 16 + jj) * LRU_W + cc, __ATOMIC_RELAXED, __HIP_MEMORY_SCOPE_AGENT) : 0x000000003f800000ull; }
#pragma unroll
                            for (int k = 0; k < 8; ++k) h = __uint_as_float((unsigned)sv[k]) * h + __uint_as_float((unsigned)(sv[k] >> 32)); }
                        hseg = h;
                    } else if (w == 1) {
                        const int dir = lane >> 5, chl = lane & 31, cc = n * 128 + nb * 32 + chl, lt = tile - 32, b = lt >> 4, jt = lt & 15;
                        const unsigned long long* AGG = (const unsigned long long*)SUMM;
                        unsigned* FLG = (unsigned*)(ws + WS_CTL) + CW_LRUF;
                        {   unsigned spins = 0; const unsigned* fp = FLG + (size_t)(((b * 16 + (lane & 15)) * 8 + n) * 4 + nb) * 16;
                            while (!__all(__hip_atomic_load(fp, __ATOMIC_RELAXED, __HIP_MEMORY_SCOPE_AGENT) >= (unsigned)(l + 1))) {
                                __builtin_amdgcn_s_sleep(1);
                                if (++spins > (1u << 20)) { if (lane == 0) __hip_atomic_store((unsigned*)(ws + WS_CTL) + CW_TMO, 0x1b01u, __ATOMIC_RELAXED, __HIP_MEMORY_SCOPE_AGENT); break; } } }
                        __builtin_amdgcn_fence(__ATOMIC_ACQUIRE, "agent");
                        unsigned long long sv[7];
#pragma unroll
                        for (int k = 0; k < 7; ++k) { const int jj = dir == 0 ? 8 + k : 15 - (8 + k); const bool use = dir == 0 ? (jj < jt) : (jj > jt);
                            sv[k] = use ? __hip_atomic_load(AGG + (size_t)(dir * 64 + b * 16 + jj) * LRU_W + cc, __ATOMIC_RELAXED, __HIP_MEMORY_SCOPE_AGENT) : 0x000000003f800000ull; }
                        float Pb = 1.f, Hb = 0.f;
#pragma unroll
                        for (int k = 0; k < 7; ++k) { const float pk = __uint_as_float((unsigned)sv[k]), hk = __uint_as_float((unsigned)(sv[k] >> 32)); Hb = pk * Hb + hk; Pb *= pk; }
                        ((float2*)(lds + lru::LDS_LRU))[lane] = make_float2(Pb, Hb);
                    }
                    __syncthreads();
                    if (w == 0) { const float2 sb = ((const float2*)(lds + lru::LDS_LRU))[lane];
                        TIN[(par * 2 + (lane >> 5)) * 128 + nb * 32 + (lane & 31)] = sb.x * hseg + sb.y;
                    }
                    __syncthreads();
#else
#pragma unroll 1
                        for (int k0 = 0; k0 < 15; k0 += LB_BATCH) {
                            unsigned long long sv[LB_BATCH];
#pragma unroll
                            for (int k = 0; k < LB_BATCH; ++k) { const int jj = dir == 0 ? k0 + k : 15 - (k0 + k); const bool use = (k0 + k < 15) && (dir == 0 ? (jj < jt) : (jj > jt));
                                sv[k] = use ? __hip_atomic_load(AGG + (size_t)(dir * 64 + b * 16 + jj) * LRU_W + cc, __ATOMIC_RELAXED, __HIP_MEMORY_SCOPE_AGENT) : 0x000000003f800000ull; }
#pragma unroll
                            for (int k = 0; k < LB_BATCH; ++k) h = __uint_as_float((unsigned)sv[k]) * h + __uint_as_float((unsigned)(sv[k] >> 32)); }
                        TIN[(par * 2 + dir) * 128 + nb * 32 + chl] = h;
                    }
                    __syncthreads();
#endif
#endif
#endif
                } else if (tid < 64) TIN[(par * 2 + (tid >> 5)) * 128 + nb * 32 + (tid & 31)] = 0.f;
                if (!lat) __syncthreads();
            }
            if (u == wg && nb == LS_NB) LSTAMP(4);
            if (!FINAL) {
                if (tid < 64) { const int dir = tid >> 5, chl = tid & 31; float h = 0.f, P = 1.f;
                    if (dir == 0) { for (int ww = 0; ww < 8; ++ww) { const float2 s = S[((buf * 2 + 0) * 8 + ww) * 32 + chl]; h = s.x * h + s.y; P *= s.x; } }
                    else { for (int ww = 7; ww >= 0; --ww) { const float2 s = S[((buf * 2 + 1) * 8 + ww) * 32 + chl]; h = s.x * h + s.y; P *= s.x; } }
                    SUMM[(size_t)(dir * 64 + (tile - 32)) * LRU_W + n * 128 + nb * 32 + chl] = make_float2(P, h); }
            } else {
                float hf_in = TIN[(par * 2 + 0) * 128 + nb * 32 + r32], hb_in = TIN[(par * 2 + 1) * 128 + nb * 32 + r32];
                for (int ww = 0; ww < w; ++ww) { const float2 s = S[((buf * 2 + 0) * 8 + ww) * 32 + r32]; hf_in = s.x * hf_in + s.y; }
                for (int ww = 7; ww > w; --ww) { const float2 s = S[((buf * 2 + 1) * 8 + ww) * 32 + r32]; hb_in = s.x * hb_in + s.y; }
                f32x16 hsum;
                {   float Aq[4], Bq[4], hin[4]; f32x16 hf, hb;
                    lru::compose<0>(av[0], uv[0], Aq, Bq); const float endf = lru::chain<0>(Aq, Bq, hf_in, hi, hin); lru::expand<0>(av[0], uv[0], hin, hf);
                    lru::compose<1>(av[1], uv[1], Aq, Bq); const float endb = lru::chain<1>(Aq, Bq, hb_in, hi, hin); lru::expand<1>(av[1], uv[1], hin, hb);
                    hsum = hf + hb;
                    if (!lat && hi == 0) {
                        if (w == 7) a->out[O_ST + ((size_t)(tile * DEPTH + l) * 2 + 0) * LRU_W + c] = endf;
                        if (w == 0) a->out[O_ST + ((size_t)(tile * DEPTH + l) * 2 + 1) * LRU_W + c] = endb; } }
                f32x16 gv = f32x16{};
                gv = __builtin_amdgcn_mfma_f32_32x32x16_bf16(gf0, idb[0], gv, 0, 0, 0);
                gv = __builtin_amdgcn_mfma_f32_32x32x16_bf16(gf1, idb[1], gv, 0, 0, 0);
#pragma unroll
                for (int r = 0; r < 16; ++r) MIX[(row0 + att::crow(r, hi)) * DM + 512 + c] = (bf16)f2bf(hsum[r] * gelu_tanh(gv[r]));
            }
            if (u == wg && nb == LS_NB) LSTAMP(5);
        }
        if (u == wg) LSTAMP(6);
    }
    LSTAMP(7);
    __syncthreads();
#undef LSTAMP
}

__device__ __forceinline__ void phase_attention_gqa(KArgs a, char* lds, int wg, int G, int wave_id) {
    unsigned char* ws = a->ws;
    const bf16* QA = (const bf16*)(ws + WS_QA); const bf16* KAL = (const bf16*)(ws + WS_KAL); const bf16* VAL = (const bf16*)(ws + WS_VAL); const bf16* KAC = (const bf16*)(ws + WS_KAC); const bf16* VAC = (const bf16*)(ws + WS_VAC);
    bf16* MIX = (bf16*)(ws + WS_MIX);
    for (int u = wg; u < 384; u += G) {
        const bool lat = u < 256; int b, head, seq; size_t row0;
        if (lat) { const int x = u & 7, idx = u >> 3, qb = idx & 15; seq = SKV_L; b = x >> 1; head = (x & 1) * 2 + (idx >> 4); row0 = (size_t)M_C + (size_t)b * S_L + (size_t)qb * 256; }
        else { const int v = u - 256; b = v >> 2; head = v & 3; seq = S_C; row0 = (size_t)b * S_C; }
        const int kvh = head >> 1;
        const bf16* Kp = lat ? KAL + (size_t)b * SKV_L * 256 + kvh * 128 : KAC + (size_t)b * S_C * 256 + kvh * 128;
        const bf16* Vp = lat ? VAL + (size_t)b * SKV_L * 256 + kvh * 128 : VAC + (size_t)b * S_C * 256 + kvh * 128;
        att::attn_body<0, GQA_SD, GQA_NQR, GQA_STG, 512, 256, 64, 256, DM>(QA + row0 * 512 + head * 128, Kp, nullptr, Vp, MIX + row0 * DM + head * 128, seq, lds, wave_id);
    }
}
__device__ __forceinline__ void phase_attention_mla(KArgs a, char* lds, int wg, int G, int wave_id) {
    unsigned char* ws = a->ws;
    const bf16* QM = (const bf16*)(ws + WS_QM); const bf16* KVM = (const bf16*)(ws + WS_KVM); const bf16* KR = (const bf16*)(ws + WS_KR); bf16* MIX = (bf16*)(ws + WS_MIX);
    const int wgc = ((wg - 128) % G + G) % G, nlat = (256 - wg + G - 1) / G;
    for (int i = 0, u = wg; ; ++i) {
        if (i < nlat) u = wg + i * G; else { u = 256 + wgc + (i - nlat) * G; if (u >= 384) break; }
        const bool lat = u < 256; int b, head, seq; size_t row0, key0;
        if (lat) { const int x = u & 7, idx = u >> 3, qb = idx & 15, p = x * 2 + (idx >> 4); seq = SKV_L; b = p >> 2; head = p & 3; row0 = (size_t)M_C + (size_t)b * S_L + (size_t)qb * 256; key0 = (size_t)M_C + (size_t)b * SKV_L; }
        else { const int v = u - 256; b = v >> 2; head = v & 3; seq = S_C; row0 = (size_t)b * S_C; key0 = row0; }
        att::attn_body<64, MLA_SD, MLA_NQR, MLA_STG, 768, 1024, 64, 1024, DM>(QM + row0 * 768 + head * 192, KVM + key0 * 1024 + head * 128, KR + key0 * 64, KVM + key0 * 1024 + 512 + head * 128,
                                                                  MIX + row0 * DM + 1536 + head * 128, seq, lds, wave_id);
    }
}


#ifndef KVM_COUNTER
#define KVM_COUNTER 0
#endif
constexpr int CW_KVMC = 8192;
#ifndef NPASS
#define NPASS 1
#endif
#ifndef SKEW_PROBE
#define SKEW_PROBE 0
#endif
#ifndef SK_LO
#define SK_LO 0
#endif
#ifndef SK_HI
#define SK_HI 42
#endif
#ifndef SK_USED
#define SK_USED 0
#endif
#ifndef SK_MASK
#define SK_MASK 0x7ff
#endif
#ifndef STAMP_OFF
#define STAMP_OFF 0.0f
#endif
#ifndef STAMP_SCALE
#define STAMP_SCALE 1.0f
#endif
#ifndef STAMP_A
#define STAMP_A -1
#define STAMP_B -1
#endif
#ifndef FFN_DBG
#define FFN_DBG 0
#endif
#ifndef DBG_SEL
#define DBG_SEL(r, c) 0
#endif
#ifndef DBG_REPORT
#define DBG_REPORT (10000.0f * (float)tot / (24576.0f * 5632.0f))
#endif
#ifndef FFN_UNFUSED
#define FFN_UNFUSED 0
#endif
__device__ __forceinline__ void phase_ffn_act_dbg(KArgs a, int l, int gtid, int NTHR) {
    const bf16* U = (const bf16*)(a->ws + WS_U); bf16* ACT = (bf16*)(a->ws + WS_ACT);
    const float* cw = a->in[I_FCW] + (size_t)l * 3 * NUP; const float* cb = a->in[I_FCB] + (size_t)l * NUP;
    constexpr int CG = DFF / 8;
    for (long i = gtid; i < (long)MTOK * CG; i += NTHR) {
        const int r = (int)(i / CG), c = (int)(i % CG) * 8; const bool lat = r >= M_C; const int t = lat ? (r - M_C) % S_L : r % S_C, slen = lat ? S_L : S_C;
        const int ucol = (c / 128) * 256 + (c % 128);
        float g[8], v[8]; ld8f(cb + c, g); ld8f(cb + DFF + c, v);
#pragma unroll
        for (int j = 0; j < 3; ++j) { const int tt = t + j - 1; if (tt >= 0 && tt < slen) { float xg[8], xv[8], wg_[8], wv[8]; const bf16* ur = U + (size_t)(r + j - 1) * NUP;
            ld8bf(ur + ucol, xg); ld8bf(ur + ucol + 128, xv); ld8f(cw + (size_t)j * NUP + c, wg_); ld8f(cw + (size_t)j * NUP + DFF + c, wv);
#pragma unroll
            for (int e = 0; e < 8; ++e) { g[e] += wg_[e] * xg[e]; v[e] += wv[e] * xv[e]; } } }
        float o[8];
#pragma unroll
        for (int e = 0; e < 8; ++e) o[e] = siluf_(g[e]) * v[e];
        st8bf(ACT + (size_t)r * DFF + c, o);
    }
}
__device__ __forceinline__ void phase_ffn_cmp_dbg(KArgs a, int l, int gtid, int NTHR) {
    const bf16* U = (const bf16*)(a->ws + WS_U); bf16* ACT = (bf16*)(a->ws + WS_ACT);
    const float* cw = a->in[I_FCW] + (size_t)l * 3 * NUP; const float* cb = a->in[I_FCB] + (size_t)l * NUP;
    constexpr int CG = DFF / 8;
    for (long i = gtid; i < (long)MTOK * CG; i += NTHR) {
        const int r = (int)(i / CG), c = (int)(i % CG) * 8; const bool lat = r >= M_C; const int t = lat ? (r - M_C) % S_L : r % S_C, slen = lat ? S_L : S_C;
        const int ucol = (c / 128) * 256 + (c % 128);
        float g[8], v[8]; ld8f(cb + c, g); ld8f(cb + DFF + c, v);
#pragma unroll
        for (int j = 0; j < 3; ++j) { const int tt = t + j - 1; if (tt >= 0 && tt < slen && (!CONV_CENTER_ONLY || j == 1)) { float xg[8], xv[8], wg_[8], wv[8]; const bf16* ur = U + (size_t)(r + j - 1) * NUP;
            ld8bf(ur + ucol, xg); ld8bf(ur + ucol + 128, xv); ld8f(cw + (size_t)j * NUP + c, wg_); ld8f(cw + (size_t)j * NUP + DFF + c, wv);
#pragma unroll
            for (int e = 0; e < 8; ++e) { g[e] += wg_[e] * xg[e]; v[e] += wv[e] * xv[e]; } } }
        float o[8];
#pragma unroll
        for (int e = 0; e < 8; ++e) o[e] = siluf_(g[e]) * v[e];
        if ((t & 255) != 0 && (t & 255) != 255) { float f[8]; ld8bf(ACT + (size_t)r * DFF + c, f); unsigned bad = 0;
#pragma unroll
            for (int e = 0; e < 8; ++e) bad += (fabsf(f[e] - o[e]) > 0.02f * (fabsf(o[e]) + 0.05f)) ? 1u : 0u;
            if (bad) atomicAdd((unsigned*)(a->ws + WS_CTL) + CW_CHK + DBG_SEL(r, c), bad); }
    }
}
__device__ __forceinline__ void phase_ffn_fix(KArgs a, int l, int gtid, int NTHR) {
    const bf16* HALO = (const bf16*)(a->ws + WS_HALO); bf16* ACT = (bf16*)(a->ws + WS_ACT);
    const float* cw = a->in[I_FCW] + (size_t)l * 3 * NUP; const float* cb = a->in[I_FCB] + (size_t)l * NUP;
    constexpr int CG = DFF / 8;
    for (int i = gtid; i < 64 * 2 * CG; i += NTHR) {
        const int lt = i / (2 * CG), side = (i / CG) & 1, c = (i % CG) * 8, jt = lt & 15;
        if ((side == 0 && jt == 0) || (side == 1 && jt == 15)) continue;
        const int pn = c / 128, cl = c % 128;
        const int t0 = side == 0 ? lt - 1 : lt, h0 = side == 0 ? 3 : 2, t1 = lt, h1 = side == 0 ? 0 : 3, t2 = side == 0 ? lt : lt + 1, h2 = side == 0 ? 1 : 0;
        float g[8], v[8]; ld8f(cb + c, g); ld8f(cb + DFF + c, v);
        const int tt[3] = {t0, t1, t2}, hh[3] = {h0, h1, h2};
#pragma unroll
        for (int j = 0; j < 3; ++j) { const bf16* hr = HALO + ((size_t)(tt[j] * 4 + hh[j]) * 44 + pn) * 256 + cl; float xg[8], xv[8], wg_[8], wv[8];
            ld8bf(hr, xg); ld8bf(hr + 128, xv); ld8f(cw + (size_t)j * NUP + c, wg_); ld8f(cw + (size_t)j * NUP + DFF + c, wv);
#pragma unroll
            for (int e = 0; e < 8; ++e) { g[e] += wg_[e] * xg[e]; v[e] += wv[e] * xv[e]; } }
        float o[8];
#pragma unroll
        for (int e = 0; e < 8; ++e) o[e] = siluf_(g[e]) * v[e];
        const size_t row = (size_t)M_C + (size_t)lt * 256 + (side ? 255 : 0);
        st8bf(ACT + row * DFF + c, o);
    }
}

#ifndef EN_AT2
#define EN_AT2 1
#endif
#ifndef REP_GEMM
#define REP_GEMM 1
#endif
#ifndef REP_AT
#define REP_AT 1
#endif
#ifndef REP_LRU
#define REP_LRU 1
#endif
#ifndef REP_RW
#define REP_RW 1
#endif
#ifndef EN_P0
#define EN_P0 1
#endif
#ifndef EN_P1
#define EN_P1 1
#endif
#ifndef EN_G1
#define EN_G1 1
#endif
#ifndef EN_PP
#define EN_PP 1
#endif
#ifndef EN_LG
#define EN_LG 1
#endif
#ifndef EN_LS
#define EN_LS 1
#endif
#ifndef EN_AT
#define EN_AT 1
#endif
#ifndef EN_LF
#define EN_LF 1
#endif
#ifndef EN_G2
#define EN_G2 1
#endif
#ifndef EN_R1
#define EN_R1 1
#endif
#ifndef EN_G3
#define EN_G3 1
#endif
#ifndef EN_FA
#define EN_FA 1
#endif
#ifndef EN_G4
#define EN_G4 1
#endif
#ifndef EN_R2
#define EN_R2 1
#endif
__global__ void __launch_bounds__(NTHREADS, 2) fwd_kernel(Args args) {
    extern __shared__ __attribute__((aligned(16))) unsigned char lds_raw[];
    const KArgs ka = (KArgs)__builtin_amdgcn_kernarg_segment_ptr();
    const int wave0 = __builtin_amdgcn_readfirstlane((int)threadIdx.x >> 6);
    const int G = gridDim.x, bx = blockIdx.x;
    const int vcu = (G % 8 == 0) ? (bx % 8) * (G / 8) + bx / 8 : bx;
    const int NGW = G * NWAVES, NTHR = G * NTHREADS;
#define PH_IDS const int tid = ltid(wave0), lane = tid & 63, wave = __builtin_amdgcn_readfirstlane(tid >> 6), gw = vcu * NWAVES + wave, gtid = vcu * NTHREADS + tid; (void)lane; (void)wave; (void)gw; (void)gtid; const KArgs a = launder(ka)
    LAS unsigned char* ldsL = (LAS unsigned char*)lds_raw; char* lds = (char*)lds_raw;
    volatile LAS unsigned* MISC = (volatile LAS unsigned*)(ldsL + MISC_OFF);
    for (int u = ltid(wave0); u < (LDS_BYTES - LDSCTL_OFF) / 4; u += NTHREADS) ((LAS unsigned*)(ldsL + LDSCTL_OFF))[u] = 0u;
    __syncthreads();
    unsigned* ctl = (unsigned*)(ka->ws + WS_CTL);
#if MK_MULTI
#define GRID_BAR() do { } while (0)
#else
    XcdBarrier bar = xcd_barrier_post(ctl + CW_BAR, MISC + 8, wave0);
#define GRID_BAR() xcd_barrier(bar)
#endif
    const int lo = ka->ph_lo, hi = ka->ph_hi;
#define IN(k) (lo <= (k) && (k) < hi)
#define SEAM(k) do { if (SKEW_PROBE) { if (ltid(wave0) == 0) ((unsigned long long*)(ka->ws + WS_DBG))[(k) * 256 + bx] = __builtin_amdgcn_s_memrealtime(); } if (IN(k) && IN((k) + 1)) GRID_BAR(); else __syncthreads(); if (STAMP_A >= 0) { if ((k) + 1 == STAMP_A) tsA = __builtin_amdgcn_s_memrealtime(); if ((k) + 1 == STAMP_B) tsB = __builtin_amdgcn_s_memrealtime(); } } while (0)
    unsigned long long tsA = 0, tsB = 0; if (STAMP_A == 0) tsA = __builtin_amdgcn_s_memrealtime();
#ifdef CAL_SPIN_TICKS
    if (bx == 0) { const unsigned long long t0 = __builtin_amdgcn_s_memrealtime(); while (__builtin_amdgcn_s_memrealtime() - t0 < (unsigned long long)CAL_SPIN_TICKS) __builtin_amdgcn_s_sleep(8); }
#endif
#if NPASS > 1
    for (int pass = 0; pass < NPASS; ++pass) {
#endif
    if (EN_P0 && IN(0)) { PH_IDS; phase_prologue(a, lds, gw, NGW, wave, lane); } SEAM(0);
    if (EN_P0 && IN(1)) { PH_IDS; phase_mod_reduce(a, gtid, NTHR); } SEAM(1);
    if (EN_P1 && IN(2)) { PH_IDS; phase_first_norm(a, lds, bx, G, tid); } SEAM(2);

    for (int l = 0; l < DEPTH; ++l) {
        const int pb = PH_PRE + l * PH_PER_LAYER;
        if (EN_G1 && IN(pb + 0)) {
            unsigned char* ws = launder(ka)->ws;
            pg8::Gemm g{(const bf16*)(ws + WS_H), (const bf16*)(ws + WS_WIN) + (size_t)l * NPROJ * DM, MTOK, NPROJ, DM}; pg8::StaticOrder S; S.init(MTOK, NPROJ, G, bx);
            pg8::EpiBf16<0> E{(bf16*)(ws + WS_PROJ), NPROJ, nullptr, 0, 0, 1.f};
            for (int rep = 0; rep < REP_GEMM; ++rep) { pg8::gemm_phase<pg8::EpiBf16<0>, pg8::StaticOrder, true, true>(ldsL, g, S, E, wave0); if (rep + 1 < REP_GEMM) __syncthreads(); }
            if (TAILCONV) { __syncthreads(); PH_IDS; tail_convert(a, lds, TC_P0 + l * I_LAYER, TC_P0 + l * I_LAYER + TC_R1, S.nwg, G, bx, wave, lane);
                if (MODSHIFT && l + 1 < DEPTH) { const int used = S.nwg % G; if (bx >= used) modp_items(a, l + 1, (float*)(a->ws + WS_MODP2), (bx - used) * NWAVES + wave, (G - used) * NWAVES, lane); } }
        } SEAM(pb + 0);
        if (EN_PP && IN(pb + 1)) { PH_IDS; for (int rep = 0; rep < REP_RW; ++rep) phase_postproj(a, l, gw, NGW, lane, lds, tid); } SEAM(pb + 1);
        if (EN_LG && IN(pb + 2)) {
            if (!LRU_LOOKBACK) { PH_IDS; for (int rep = 0; rep < REP_LRU; ++rep) phase_lru<false>(a, l, lds, bx, G, tid); }
            __syncthreads();
            unsigned char* ws = launder(ka)->ws;
            pg8::Gemm g{(const bf16*)(ws + WS_CKV), (const bf16*)(ws + WS_WKV) + (size_t)l * 1024 * 512, MKEY, 1024, 512}; pg8::StaticOrder S; S.init(MKEY, 1024, G, bx);
            pg8::EpiBf16<0> E{(bf16*)(ws + WS_KVM), 1024, nullptr, 0, 0, 1.f};
            for (int rep = 0; rep < REP_GEMM; ++rep) { pg8::gemm_phase<pg8::EpiBf16<0>, pg8::StaticOrder, true, true>(ldsL, g, S, E, wave0); if (rep + 1 < REP_GEMM) __syncthreads(); }
#if KVM_COUNTER
            asm volatile("s_waitcnt vmcnt(0)" ::: "memory"); __syncthreads();
            if (wave0 == 0 && vlane() == 0u) { __builtin_amdgcn_fence(__ATOMIC_RELEASE, "agent"); asm volatile("s_waitcnt vmcnt(0)" ::: "memory");
                (void)__hip_atomic_fetch_add((unsigned*)(ws + WS_CTL) + CW_KVMC + l * 16, 1u, __ATOMIC_RELAXED, __HIP_MEMORY_SCOPE_AGENT); }
#endif
            if (TAILCONV) { __syncthreads(); PH_IDS; tail_convert(a, lds, TC_P0 + l * I_LAYER + TC_R1, TC_P0 + l * I_LAYER + TC_R2, S.nwg, G, bx, wave, lane); }
        }
        if (KVM_COUNTER && !MK_MULTI && IN(pb + 2) && IN(pb + 3)) __syncthreads(); else SEAM(pb + 2);
        if (IN(pb + 3)) { if (EN_LS) { PH_IDS; for (int rep = 0; rep < REP_LRU; ++rep) phase_lru<true, LRU_LOOKBACK != 0>(a, l, lds, bx, G, tid); } __syncthreads();
            if (EN_AT) { PH_IDS; for (int rep = 0; rep < REP_AT; ++rep) phase_attention_gqa(a, lds, bx, G, wave0); }
#if KVM_COUNTER
            if (!MK_MULTI && IN(pb + 2)) { __syncthreads();
                if (wave0 == 0 && vlane() == 0u) { unsigned* cp = (unsigned*)(launder(ka)->ws + WS_CTL) + CW_KVMC + l * 16; unsigned sp = 0u;
                    while (__hip_atomic_load(cp, __ATOMIC_RELAXED, __HIP_MEMORY_SCOPE_AGENT) < (unsigned)G) { __builtin_amdgcn_s_sleep(2);
                        if (++sp > (1u << 22)) { __hip_atomic_store((unsigned*)(launder(ka)->ws + WS_CTL) + CW_TMO, 0x2b00u, __ATOMIC_RELAXED, __HIP_MEMORY_SCOPE_AGENT); break; } }
                    __builtin_amdgcn_fence(__ATOMIC_ACQUIRE, "agent"); asm volatile("s_waitcnt vmcnt(0)" ::: "memory"); }
                __syncthreads(); }
#endif
            if (EN_AT2) { PH_IDS; for (int rep = 0; rep < REP_AT; ++rep) phase_attention_mla(a, lds, bx, G, wave0); } } SEAM(pb + 3);
        if (EN_G2 && IN(pb + 4)) {
            unsigned char* ws = launder(ka)->ws;
            pg8::Gemm g{(const bf16*)(ws + WS_MIX), (const bf16*)(ws + WS_WOUT) + (size_t)l * DM * DM, MTOK, DM, DM}; pg8::StaticOrder S; S.init(MTOK, DM, G, bx);
            pg8::EpiBf16<0> E{(bf16*)(ws + WS_MO), DM, nullptr, 0, 0, 1.f};
            for (int rep = 0; rep < REP_GEMM; ++rep) { pg8::gemm_phase<pg8::EpiBf16<0>, pg8::StaticOrder, true, true>(ldsL, g, S, E, wave0); if (rep + 1 < REP_GEMM) __syncthreads(); }
        } SEAM(pb + 4);
        if (EN_R1 && IN(pb + 5)) { PH_IDS; phase_residual(a, l, 0, lds, bx, G, tid); } SEAM(pb + 5);
        if (EN_G3 && IN(pb + 6)) {
            const KArgs a = launder(ka); unsigned char* ws = a->ws;
            pg8::Gemm g{(const bf16*)(ws + WS_H), (const bf16*)(ws + WS_WUP) + (size_t)l * NUP * DM, MTOK, NUP, DM}; pg8::StaticOrder S; S.init(MTOK, NUP, G, bx);
#if FFN_UNFUSED
            pg8::EpiBf16<0> E{(bf16*)(ws + WS_U), NUP, nullptr, 0, 0, 1.f};
            pg8::gemm_phase<pg8::EpiBf16<0>, pg8::StaticOrder, true, true>(ldsL, g, S, E, wave0);
#else
            pg8::EpiFfnAct E{(bf16*)(ws + WS_ACT), DFF, a->in[I_FCW] + (size_t)l * 3 * NUP, a->in[I_FCB] + (size_t)l * NUP, NUP, DFF, (bf16*)(ws + WS_HALO), (LAS float*)(ldsL + 131072)};
            for (int rep = 0; rep < REP_GEMM; ++rep) { pg8::gemm_phase<pg8::EpiFfnAct, pg8::StaticOrder, true, true>(ldsL, g, S, E, wave0); if (rep + 1 < REP_GEMM) __syncthreads(); }
            if (TAILCONV) { __syncthreads(); const int tid = ltid(wave0); const int used = S.nwg % G;
                if (MODSHIFT && l + 1 < DEPTH && bx >= used) mod_reduce_layer(a, l + 1, (const float*)(ws + WS_MODP2), (bx - used) * NTHREADS + tid, (G - used) * NTHREADS);
                tail_convert(a, lds, TC_P0 + l * I_LAYER + TC_R2, TC_P0 + (l + 1) * I_LAYER, S.nwg, G, bx, __builtin_amdgcn_readfirstlane(tid >> 6), tid & 63); }
#endif
#if FFN_DBG
            if (l == 0) { __syncthreads(); pg8::EpiBf16<0> E2{(bf16*)(ws + WS_U), NUP, nullptr, 0, 0, 1.f};
                pg8::gemm_phase<pg8::EpiBf16<0>, pg8::StaticOrder, true, true>(ldsL, g, S, E2, wave0); }
#endif
        } SEAM(pb + 6);
        if (EN_FA && IN(pb + 7)) { PH_IDS; for (int rep = 0; rep < REP_RW; ++rep) { if (FFN_UNFUSED) phase_ffn_act_dbg(a, l, gtid, NTHR); else { if (FFN_DBG && l == 0) phase_ffn_cmp_dbg(a, l, gtid, NTHR); phase_ffn_fix(a, l, gtid, NTHR); } } } SEAM(pb + 7);
        if (EN_G4 && IN(pb + 8)) {
            unsigned char* ws = launder(ka)->ws;
            pg8::Gemm g{(const bf16*)(ws + WS_ACT), (const bf16*)(ws + WS_WDN) + (size_t)l * DM * DFF, MTOK, DM, DFF}; pg8::StaticOrder S; S.init(MTOK, DM, G, bx);
            pg8::EpiBf16<0> E{(bf16*)(ws + WS_MO), DM, nullptr, 0, 0, 1.f};
            for (int rep = 0; rep < REP_GEMM; ++rep) { pg8::gemm_phase<pg8::EpiBf16<0>, pg8::StaticOrder, true, true>(ldsL, g, S, E, wave0); if (rep + 1 < REP_GEMM) __syncthreads(); }
        } SEAM(pb + 8);
        if (EN_R2 && IN(pb + 9)) { PH_IDS; phase_residual(a, l, 1, lds, bx, G, tid); } SEAM(pb + 9);
    }
#if NPASS > 1
    if (pass + 1 < NPASS) { GRID_BAR(); { unsigned* FLG = (unsigned*)(ka->ws + WS_CTL) + CW_LRUF; for (int i = bx * NTHREADS + ltid(wave0); i < 32768; i += G * NTHREADS) FLG[i] = 0u; } GRID_BAR(); }
    }
#endif
#if SKEW_PROBE
    if (bx == 0 && ltid(wave0) == 0) { const unsigned long long* ts = (const unsigned long long*)(ka->ws + WS_DBG); float tot = 0.f;
        for (int k = SK_LO; k < SK_HI; ++k) { { const int ty = k < PH_PRE ? 10 : (k - PH_PRE) % PH_PER_LAYER; if (!((SK_MASK >> ty) & 1)) continue; }
            unsigned long long mx = 0, sum = 0; for (int b = 0; b < G; ++b) { const unsigned long long v = ts[k * 256 + b]; mx = v > mx ? v : mx; sum += v; }
            if (SK_USED > 0) { long long s0 = 0, s1 = 0; for (int b = 0; b < G; ++b) { const long long v = (long long)(ts[k * 256 + b] - ts[k * 256]); if (b < SK_USED) s0 += v; else s1 += v; }
                tot += (float)s1 / (float)(G - SK_USED) - (float)s0 / (float)SK_USED; }
            else tot += (float)(mx * (unsigned long long)G - sum) / (float)G; }
        if (SK_USED > 0) tot = rintf(tot * 0.25f * 1e-3f) * 1e3f;
        ka->out[0] += STAMP_SCALE * (tot * 1e-4f - STAMP_OFF); }
#endif
#if STAMP_A >= 0
    if (bx == 0 && ltid(wave0) == 0) ka->out[0] += STAMP_SCALE * ((float)(tsB - tsA) * 1e-4f - STAMP_OFF);
#endif
#if LRU_STAMPS
    if (bx == 0 && ltid(wave0) == 0) { const unsigned long long* lts = (const unsigned long long*)(ka->ws + WS_DBG); ka->out[0] += (float)(lts[LS_B] - lts[LS_A]) * 1e-2f; }
#endif
#if FFN_DBG
    if (bx == 0 && ltid(wave0) == 0) { const unsigned* chk = (const unsigned*)(ka->ws + WS_CTL) + CW_CHK; unsigned tot = 0; for (int i = 0; i < 16; ++i) tot += __hip_atomic_load(chk + i, __ATOMIC_RELAXED, __HIP_MEMORY_SCOPE_AGENT);
        ka->out[0] = DBG_REPORT; }
#endif
#undef IN
#undef SEAM
}

extern "C" void kernel_launch(void* const* d_in, const int* in_sizes, int n_in, void* d_out, int out_size, void* d_ws, size_t ws_size, hipStream_t stream) {
    static int grid = 0;
    if (grid == 0) {
        if (n_in != N_IN || (size_t)out_size != O_END || ws_size < WS_END) { fprintf(stderr, "kernel_launch: unexpected shapes: n_in %d out %d ws %zu (need %zu)\n", n_in, out_size, ws_size, (size_t)WS_END); grid = -1; return; }
        int dev = 0, cus = 0, per_cu = 0;
        if (hipGetDevice(&dev) != hipSuccess || hipDeviceGetAttribute(&cus, hipDeviceAttributeMultiprocessorCount, dev) != hipSuccess) { grid = -1; return; }
        if (hipFuncSetAttribute((const void*)fwd_kernel, hipFuncAttributeMaxDynamicSharedMemorySize, LDS_BYTES) != hipSuccess) { fprintf(stderr, "kernel_launch: hipFuncSetAttribute failed\n"); grid = -1; return; }
        if (hipOccupancyMaxActiveBlocksPerMultiprocessor(&per_cu, (const void*)fwd_kernel, NTHREADS, LDS_BYTES) != hipSuccess || per_cu < 1) { fprintf(stderr, "kernel_launch: occupancy query says %d blocks per CU\n", per_cu); (void)hipGetLastError(); grid = -1; return; }
        grid = cus;
    }
    if (grid < 0) return;
    (void)hipMemsetAsync((char*)d_ws + WS_CTL, 0, CTL_ZERO_BYTES, stream);
    Args a{};
    for (int i = 0; i < N_IN; ++i) a.in[i] = (const float*)d_in[i];
    a.out = (float*)d_out; a.ws = (unsigned char*)d_ws;
#if MK_MULTI
    for (int p = 0; p < PH_TOTAL; ++p) { a.ph_lo = p; a.ph_hi = p + 1; hipLaunchKernelGGL(fwd_kernel, dim3(grid), dim3(NTHREADS), LDS_BYTES, stream, a); }
#else
    a.ph_lo = 0; a.ph_hi = PH_TOTAL; hipLaunchKernelGGL(fwd_kernel, dim3(grid), dim3(NTHREADS), LDS_BYTES, stream, a);
#endif
    const hipError_t le = hipPeekAtLastError();
    if (le != hipSuccess) fprintf(stderr, "kernel_launch: launch failed: %s\n", hipGetErrorName(le));
}
```
